# Optimizing an MI355X kernel written in HIP

```python
import jax, jax.numpy as jnp
from jax import lax
import numpy as np

D_MODEL = 2048
BATCH = 4
SEQ = 2048
DEPTH = 1

D_MIX = D_MODEL
MLA_HEADS = 8
QK_NOPE_DIM = 128
QK_ROPE_DIM = 64
V_HEAD_DIM = 128
Q_LORA_RANK = 768
KV_LORA_RANK = 512
ROPE_THETA = 10000.0
MLA_WIDTH = MLA_HEADS * V_HEAD_DIM
CONV_CHANNELS = D_MIX - MLA_WIDTH
CONV_WIDTH = 31
Q_BLOCK = 128
IN_COLS = Q_LORA_RANK + KV_LORA_RANK + QK_ROPE_DIM + 2 * CONV_CHANNELS
N_EXPERT_GROUPS = 8
EXPERTS_PER_GROUP = 8
N_EXPERTS = N_EXPERT_GROUPS * EXPERTS_PER_GROUP
TOP_K = 2
D_EXPERT = 512
MOE_BLOCK = 128
EPS = 1e-6

kernel_name = 'hymba_mla_conformer_hiermoe_encoder'


def rms_norm(x, g):
    xf = x.astype(jnp.float32)
    y = xf * lax.rsqrt(jnp.mean(xf * xf, axis=-1, keepdims=True) + EPS)
    return (y * g.astype(jnp.float32)).astype(x.dtype)


def layer_norm(x, g, b):
    xf = x.astype(jnp.float32)
    mu = jnp.mean(xf, axis=-1, keepdims=True)
    var = jnp.mean(jnp.square(xf - mu), axis=-1, keepdims=True)
    y = (xf - mu) * lax.rsqrt(var + EPS)
    return (y * g.astype(jnp.float32) + b.astype(jnp.float32)).astype(x.dtype)


def rope_tables(seq):
    pos = jnp.arange(seq, dtype=jnp.float32)
    inv_freq = ROPE_THETA ** (-jnp.arange(0, QK_ROPE_DIM, 2, dtype=jnp.float32) / QK_ROPE_DIM)
    ang = pos[:, None] * inv_freq[None, :]
    return jnp.cos(ang), jnp.sin(ang)


def apply_rope(x, cos, sin):
    cos = cos.astype(x.dtype)
    sin = sin.astype(x.dtype)
    x1, x2 = jnp.split(x, 2, axis=-1)
    return jnp.concatenate([x1 * cos - x2 * sin, x2 * cos + x1 * sin], axis=-1)


def bidirectional_mla_attention(q_nope, q_rope, k_nope, k_rope, v):
    b, s, h, _ = q_nope.shape
    nb = s // Q_BLOCK
    scale = (QK_NOPE_DIM + QK_ROPE_DIM) ** -0.5

    def to_blocks(t):
        return t.reshape(b, nb, Q_BLOCK, *t.shape[2:]).swapaxes(0, 1)

    def block(args):
        qn, qr = args
        sc = jnp.einsum('bqhd,bkhd->bhqk', qn, k_nope) + jnp.einsum('bqhr,bkr->bhqk', qr, k_rope)
        p = jax.nn.softmax(sc.astype(jnp.float32) * scale, axis=-1).astype(v.dtype)
        return jnp.einsum('bhqk,bkhd->bqhd', p, v)

    o = lax.map(block, (to_blocks(q_nope), to_blocks(q_rope)))
    return o.swapaxes(0, 1).reshape(b, s, h * V_HEAD_DIM)


def conformer_conv_group(u, b_glu, w_dw, b_dw, ln_g, ln_b):
    u = u + b_glu
    a, gte = jnp.split(u, 2, axis=-1)
    c = a * jax.nn.sigmoid(gte)
    c = lax.conv_general_dilated(
        c, w_dw[:, None, :].astype(c.dtype), window_strides=(1,),
        padding=[(CONV_WIDTH // 2, CONV_WIDTH // 2)],
        dimension_numbers=('NWC', 'WIO', 'NWC'),
        feature_group_count=CONV_CHANNELS) + b_dw
    c = layer_norm(c, ln_g, ln_b)
    return jax.nn.silu(c)


def hierarchical_moe(h, w_group, b_group, w_router, b_router, w_gate, w_up, w_down):
    b, s, d = h.shape
    t = b * s
    xt = h.reshape(t, d)
    g_prob = jax.nn.softmax((xt @ w_group).astype(jnp.float32) + b_group.astype(jnp.float32), axis=-1)
    p_g, g_sel = lax.top_k(g_prob, 1)
    e_logits = ((xt @ w_router).astype(jnp.float32) + b_router.astype(jnp.float32)).reshape(t, N_EXPERT_GROUPS, EXPERTS_PER_GROUP)
    e_logits = jnp.take_along_axis(e_logits, g_sel[:, :, None], axis=1)[:, 0]
    e_prob = jax.nn.softmax(e_logits, axis=-1)
    top_w, top_i = lax.top_k(e_prob, TOP_K)
    top_w = top_w / jnp.sum(top_w, axis=-1, keepdims=True)
    gates = (p_g * top_w).reshape(-1)
    expert_ids = (g_sel * EXPERTS_PER_GROUP + top_i).reshape(-1)
    token_ids = jnp.repeat(jnp.arange(t, dtype=jnp.int32), TOP_K)
    n_assign = t * TOP_K
    n_blocks = (n_assign + N_EXPERTS * (MOE_BLOCK - 1) + MOE_BLOCK - 1) // MOE_BLOCK
    n_rows = n_blocks * MOE_BLOCK
    order = jnp.argsort(expert_ids)
    sorted_e = expert_ids[order]
    counts = jnp.bincount(expert_ids, length=N_EXPERTS)
    padded = (counts + MOE_BLOCK - 1) // MOE_BLOCK * MOE_BLOCK
    pad_end = jnp.cumsum(padded)
    pad_start = pad_end - padded
    start = jnp.cumsum(counts) - counts
    dest = pad_start[sorted_e] + jnp.arange(n_assign, dtype=jnp.int32) - start[sorted_e]
    row_token = jnp.full((n_rows,), t, jnp.int32).at[dest].set(token_ids[order])
    row_gate = jnp.zeros((n_rows,), gates.dtype).at[dest].set(gates[order])
    block_expert = jnp.minimum(
        jnp.searchsorted(pad_end, jnp.arange(n_blocks, dtype=pad_end.dtype) * MOE_BLOCK, side='right'),
        N_EXPERTS - 1)
    x_pad = jnp.concatenate([xt, jnp.zeros((1, d), xt.dtype)], axis=0)

    def expert_block(args):
        tok, gate, e = args
        xb = x_pad[tok]
        hb = jax.nn.silu(xb @ w_gate[e]) * (xb @ w_up[e])
        return (hb @ w_down[e]) * gate[:, None].astype(xb.dtype)

    y = lax.map(expert_block, (row_token.reshape(n_blocks, MOE_BLOCK),
                               row_gate.reshape(n_blocks, MOE_BLOCK), block_expert))
    out = jnp.zeros((t + 1, d), y.dtype).at[row_token].add(y.reshape(n_rows, d))[:t]
    return out.reshape(b, s, d).astype(h.dtype)


def setup_inputs(seed: int = 0) -> dict:
    key = jax.random.key(seed)
    ks = jax.random.split(key, 24)

    def w(k, shape, fan_in):
        return jax.random.normal(k, shape, jnp.float32) * (fan_in ** -0.5)

    def gain(k, shape):
        return 1.0 + 0.02 * jax.random.normal(k, shape, jnp.float32)

    def bias(k, shape, s=0.02):
        return s * jax.random.normal(k, shape, jnp.float32)

    L = DEPTH
    return {
        'x': jax.random.normal(ks[0], (BATCH, SEQ, D_MODEL), jnp.float32),
        'ln1_g': gain(ks[1], (L, D_MODEL)),
        'w_in': w(ks[2], (L, D_MODEL, IN_COLS), D_MODEL),
        'b_glu': bias(ks[3], (L, 2 * CONV_CHANNELS)),
        'q_norm_g': gain(ks[4], (L, Q_LORA_RANK)),
        'w_uq': w(ks[5], (L, Q_LORA_RANK, MLA_HEADS * (QK_NOPE_DIM + QK_ROPE_DIM)), Q_LORA_RANK),
        'kv_norm_g': gain(ks[6], (L, KV_LORA_RANK)),
        'w_ukv': w(ks[7], (L, KV_LORA_RANK, MLA_HEADS * (QK_NOPE_DIM + V_HEAD_DIM)), KV_LORA_RANK),
        'w_dw': w(ks[8], (L, CONV_WIDTH, CONV_CHANNELS), CONV_WIDTH),
        'b_dw': bias(ks[9], (L, CONV_CHANNELS)),
        'conv_ln_g': gain(ks[10], (L, CONV_CHANNELS)),
        'conv_ln_b': bias(ks[11], (L, CONV_CHANNELS)),
        'w_o': w(ks[12], (L, D_MIX, D_MODEL), D_MIX),
        'ln2_g': gain(ks[13], (L, D_MODEL)),
        'w_group': w(ks[14], (L, D_MODEL, N_EXPERT_GROUPS), D_MODEL),
        'b_group': bias(ks[15], (L, N_EXPERT_GROUPS), 0.01),
        'w_router': w(ks[16], (L, D_MODEL, N_EXPERTS), D_MODEL),
        'b_router': bias(ks[17], (L, N_EXPERTS), 0.01),
        'w_gate': w(ks[18], (L, N_EXPERTS, D_MODEL, D_EXPERT), D_MODEL),
        'w_up': w(ks[19], (L, N_EXPERTS, D_MODEL, D_EXPERT), D_MODEL),
        'w_down': w(ks[20], (L, N_EXPERTS, D_EXPERT, D_MODEL), D_EXPERT),
        'final_g': gain(ks[21], (D_MODEL,)),
    }


def reference(x, ln1_g, w_in, b_glu, q_norm_g, w_uq, kv_norm_g, w_ukv, w_dw, b_dw,
              conv_ln_g, conv_ln_b, w_o, ln2_g, w_group, b_group, w_router, b_router,
              w_gate, w_up, w_down, final_g):
    b, s, _ = x.shape
    cos, sin = rope_tables(s)
    split_at = [Q_LORA_RANK, Q_LORA_RANK + KV_LORA_RANK, Q_LORA_RANK + KV_LORA_RANK + QK_ROPE_DIM]
    h = x
    for l in range(DEPTH):
        n = rms_norm(h, ln1_g[l])
        proj = n @ w_in[l]
        q_lat, kv_lat, k_rope, u = jnp.split(proj, split_at, axis=-1)
        q = (rms_norm(q_lat, q_norm_g[l]) @ w_uq[l]).reshape(b, s, MLA_HEADS, QK_NOPE_DIM + QK_ROPE_DIM)
        q_nope, q_rope = jnp.split(q, [QK_NOPE_DIM], axis=-1)
        q_rope = apply_rope(q_rope, cos[:, None, :], sin[:, None, :])
        kv = (rms_norm(kv_lat, kv_norm_g[l]) @ w_ukv[l]).reshape(b, s, MLA_HEADS, QK_NOPE_DIM + V_HEAD_DIM)
        k_nope, v = jnp.split(kv, [QK_NOPE_DIM], axis=-1)
        k_rope = apply_rope(k_rope, cos, sin)
        attn = bidirectional_mla_attention(q_nope, q_rope, k_nope, k_rope, v)
        conv = conformer_conv_group(u, b_glu[l], w_dw[l], b_dw[l], conv_ln_g[l], conv_ln_b[l])
        h = h + jnp.concatenate([attn, conv], axis=-1) @ w_o[l]
        h = h + hierarchical_moe(rms_norm(h, ln2_g[l]), w_group[l], b_group[l], w_router[l],
                                 b_router[l], w_gate[l], w_up[l], w_down[l])
    return rms_norm(h, final_g)
```

```cpp
#include <hip/hip_runtime.h>
#include <cstdint>
#include <cstdio>
#include <type_traits>

typedef unsigned short bf16_t;

constexpr int T = 8192, D = 2048, S = 2048, NB = 4, H = 8;
constexpr int QL = 768, KVL = 512, RD = 64, CC = 1024, INC = 3392;
constexpr int QW = 1536  , KVW = 2048  ;
constexpr int NE = 64, DE = 512, NG = 8, EPG = 8, NRL = 72  ;
constexpr int CW = 31;
constexpr float EPS = 1e-6f;
constexpr int RSLABS = 8, RLD = 128;
constexpr int LCAP = T;
constexpr int MAXTILES = 128;

__device__ __forceinline__ float bf2f(bf16_t v) { return __uint_as_float(((unsigned)v) << 16); }
__device__ __forceinline__ bf16_t f2bf(float f) { unsigned u = __float_as_uint(f); u += 0x7fffu + ((u >> 16) & 1u); return (bf16_t)(u >> 16); }
__device__ __forceinline__ float sigmoidf_(float x) { return __builtin_amdgcn_rcpf(1.f + __builtin_amdgcn_exp2f(-1.4426950408889634f * x)); }
__device__ __forceinline__ float siluf_(float x) { return x * sigmoidf_(x); }

struct P {
  const float *x, *ln1_g, *w_in, *b_glu, *q_norm_g, *w_uq, *kv_norm_g, *w_ukv, *w_dw, *b_dw, *conv_ln_g, *conv_ln_b, *w_o, *ln2_g,
      *w_group, *b_group, *w_router, *b_router, *w_gate, *w_up, *w_down, *final_g;
  float* out;
  bf16_t *xn, *qlat, *kvlat, *krope, *cglu, *q, *kv, *mix, *hn, *hb, *y;
  float *ssq_q, *ssq_kv, *h, *rlog, *convtmp, *ropetab, *list_gate;
  int *cnt, *list_tok;
  bf16_t *WinT, *WuqT, *WukvT, *WoT, *WrT;
  unsigned* bar;
  unsigned* moe_done;
  float *ssq_h, *rstd_h;
  bf16_t* h16;
};

__device__ __forceinline__ float wave_sum(float v) {
#pragma unroll
  for (int o = 32; o > 0; o >>= 1) v += __shfl_xor(v, o);
  return v;
}
#define LAS __attribute__((address_space(3)))
typedef LAS unsigned char* ldsp;
typedef short bf16x8 __attribute__((ext_vector_type(8)));
typedef short s16x4 __attribute__((ext_vector_type(4)));
typedef float f32x4 __attribute__((ext_vector_type(4)));
typedef unsigned u32x2 __attribute__((ext_vector_type(2)));
typedef unsigned u32x4 __attribute__((ext_vector_type(4)));
constexpr int NTHR = 512, BM = 256, BK = 64, TILE_B = BM * BK * 2, STAGE_B = 2 * TILE_B, LDS_BYTES = 150528;
constexpr int NP1 = 3584;

__device__ __forceinline__ unsigned pk_bf16(float lo, float hi) { unsigned r; asm("v_cvt_pk_bf16_f32 %0, %1, %2" : "=v"(r) : "v"(lo), "v"(hi)); return r; }
__device__ __forceinline__ int lds_byte(int r, int c) { const int st = (r >> 4) * 2 + (c >> 5), ob = (r & 15) * 64 + (c & 31) * 2; return st * 1024 + (ob ^ (((ob >> 9) & 1) << 5)); }
__device__ __forceinline__ void stage_rc(int b, int& R, int& C) { const int st = b >> 10, sb = b & 1023, swz = sb ^ (((sb >> 9) & 1) << 5); R = (st >> 1) * 16 + swz / 64; C = (st & 1) * 32 + (swz % 64) / 2; }
__device__ __forceinline__ int trf(int k) { return ((k & 3) << 2) | ((k >> 2) & 3); }
__device__ __forceinline__ int tr_byte(int k, int n) { return (n >> 7) * 16384 + 256 * k + 16 * ((((n & 127) >> 3)) ^ trf(k)) + (n & 7) * 2; }

struct ColSrc { const float* src; int ld; int c; };
template <int WHICH> __device__ __forceinline__ ColSrc colmap(const P& p, int q) {
  ColSrc r; r.src = nullptr; r.ld = 0; r.c = -1;
  if (WHICH == 0) { r.src = p.w_in; r.ld = INC;
    if (q < 1280) r.c = q;
    else if (q < 3328) { const int pl = q - 1280, t = pl >> 8, j = pl & 255; r.c = 1344 + (j >> 7) * 1024 + t * 128 + (j & 127); }
    else { const int j = q - 3328; if (j < 32) r.c = 1280 + j; else if (j >= 128 && j < 160) r.c = 1280 + 32 + (j - 128); } }
  else if (WHICH == 1) { r.src = p.w_uq; r.ld = QW;
    if (q < 1024) { const int t = q >> 8, j = q & 255; r.c = (2 * t + (j >> 7)) * 192 + (j & 127); }
    else { const int t = (q - 1024) >> 8, j = q & 255, bj = j >> 7, wcc = (j >> 5) & 3, d = j & 31; r.c = (t * 4 + wcc) * 192 + 128 + bj * 32 + d; } }
  else if (WHICH == 2) { r.src = p.w_ukv; r.ld = KVW; r.c = q; }
  else if (WHICH == 3) { r.src = p.w_o; r.ld = D; r.c = q; }
  else { if (q < NG) { r.src = p.w_group; r.ld = NG; r.c = q; } else if (q < NRL) { r.src = p.w_router; r.ld = NE; r.c = q - NG; } }
  return r;
}
struct PrepDesc { bf16_t* dst; const float* gain; int K, kt, pt, which; };
__device__ __forceinline__ ColSrc colmap_rt(const P& p, int which, int q) {
  switch (which) { case 0: return colmap<0>(p, q); case 1: return colmap<1>(p, q); case 2: return colmap<2>(p, q); case 3: return colmap<3>(p, q); default: return colmap<4>(p, q); }
}
constexpr int PU0 = (D / 64) * (NP1 / 64), PU1 = (QL / 64) * (QW / 64), PU2 = (KVL / 64) * (KVW / 64), PU3 = (D / 64) * (D / 64), PU4 = (D / 64) * (256 / 64), PUT = PU0 + PU1 + PU2 + PU3 + PU4;
__device__ __forceinline__ PrepDesc prep_desc(const P& p, int u) {
  PrepDesc d; int v = u;
  if (v < PU0) { d.dst = p.WinT; d.gain = nullptr; d.K = D; d.kt = v % (D / 64); d.pt = v / (D / 64); d.which = 0; return d; } v -= PU0;
  if (v < PU1) { d.dst = p.WuqT; d.gain = p.q_norm_g; d.K = QL; d.kt = v % (QL / 64); d.pt = v / (QL / 64); d.which = 1; return d; } v -= PU1;
  if (v < PU2) { d.dst = p.WukvT; d.gain = p.kv_norm_g; d.K = KVL; d.kt = v % (KVL / 64); d.pt = v / (KVL / 64); d.which = 2; return d; } v -= PU2;
  if (v < PU3) { d.dst = p.WoT; d.gain = nullptr; d.K = D; d.kt = v % (D / 64); d.pt = v / (D / 64); d.which = 3; return d; } v -= PU3;
  d.dst = p.WrT; d.gain = nullptr; d.K = D; d.kt = v % (D / 64); d.pt = v / (D / 64); d.which = 4; return d;
}
__device__ __forceinline__ void phase_prep(const P& p, ldsp lds, int bid, int nb) {
  const int t = threadIdx.x, nl = t & 63, ksub = t >> 6, pl = t >> 3, kc = t & 7;
  for (int u0 = bid; u0 < PUT; u0 += 4 * nb) {
    float v[4][8];
#pragma unroll
    for (int b = 0; b < 4; ++b) { const int u = u0 + b * nb;
#pragma unroll
      for (int kk = 0; kk < 8; ++kk) v[b][kk] = 0.f;
      if (u < PUT) { const PrepDesc d = prep_desc(p, u); const ColSrc cs = colmap_rt(p, d.which, d.pt * 64 + nl);
        if (cs.c >= 0) {
#pragma unroll
          for (int kk = 0; kk < 8; ++kk) { const int k = d.kt * 64 + kk * 8 + ksub; float x = cs.src[(size_t)k * cs.ld + cs.c]; if (d.gain) x *= d.gain[k]; v[b][kk] = x; } } } }
#pragma unroll
    for (int b = 0; b < 4; ++b) { LAS float* tl = (LAS float*)(lds + b * 16640);
#pragma unroll
      for (int kk = 0; kk < 8; ++kk) tl[(kk * 8 + ksub) * 65 + nl] = v[b][kk]; }
    __syncthreads();
#pragma unroll
    for (int b = 0; b < 4; ++b) { const int u = u0 + b * nb;
      if (u < PUT) { const PrepDesc d = prep_desc(p, u); const LAS float* tl = (const LAS float*)(lds + b * 16640);
        u32x4 w;
        w.x = pk_bf16(tl[(kc * 8 + 0) * 65 + pl], tl[(kc * 8 + 1) * 65 + pl]); w.y = pk_bf16(tl[(kc * 8 + 2) * 65 + pl], tl[(kc * 8 + 3) * 65 + pl]);
        w.z = pk_bf16(tl[(kc * 8 + 4) * 65 + pl], tl[(kc * 8 + 5) * 65 + pl]); w.w = pk_bf16(tl[(kc * 8 + 6) * 65 + pl], tl[(kc * 8 + 7) * 65 + pl]);
        *(u32x4*)(d.dst + (size_t)(d.pt * 64 + pl) * d.K + d.kt * 64 + kc * 8) = w; } }
    __syncthreads();
  }
  for (int i = bid * NTHR + threadIdx.x; i < S * 32; i += nb * NTHR) { const int pos = i >> 5, f = i & 31;
    const float ang = (float)pos * powf(10000.f, -(float)f / 32.f); p.ropetab[2 * i] = cosf(ang); p.ropetab[2 * i + 1] = sinf(ang); }
  if (bid == 0 && threadIdx.x < 1024) p.cnt[threadIdx.x] = 0;
  if (bid == (nb > 1 ? 1 : 0) && threadIdx.x < 256) p.moe_done[threadIdx.x] = 0u;
}
__device__ __forceinline__ void rmsnorm_rows_dev(const float* __restrict__ in, const float* __restrict__ g, bf16_t* __restrict__ out, int bid, int nb) {
  const int lane = threadIdx.x & 63, w = (bid * NTHR + threadIdx.x) >> 6, nw = nb * (NTHR / 64);
  for (int r = w; r < T; r += 2 * nw) {
    const int r1 = min(r + nw, T - 1); const bool has1 = r + nw < T;
    const float4* s0 = (const float4*)(in + (size_t)r * D); const float4* s1 = (const float4*)(in + (size_t)r1 * D);
    float4 v0[8], v1[8]; float q0 = 0.f, q1 = 0.f;
#pragma unroll
    for (int i = 0; i < 8; ++i) { v0[i] = s0[i * 64 + lane]; v1[i] = s1[i * 64 + lane]; }
#pragma unroll
    for (int i = 0; i < 8; ++i) { q0 += v0[i].x * v0[i].x + v0[i].y * v0[i].y + v0[i].z * v0[i].z + v0[i].w * v0[i].w; q1 += v1[i].x * v1[i].x + v1[i].y * v1[i].y + v1[i].z * v1[i].z + v1[i].w * v1[i].w; }
    q0 = wave_sum(q0); q1 = wave_sum(q1);
    const float rs0 = rsqrtf(q0 * (1.f / D) + EPS), rs1 = rsqrtf(q1 * (1.f / D) + EPS);
#pragma unroll
    for (int i = 0; i < 8; ++i) { const float4 gg = ((const float4*)g)[i * 64 + lane];
      u32x2 o; o.x = pk_bf16(v0[i].x * rs0 * gg.x, v0[i].y * rs0 * gg.y); o.y = pk_bf16(v0[i].z * rs0 * gg.z, v0[i].w * rs0 * gg.w);
      ((u32x2*)(out + (size_t)r * D))[i * 64 + lane] = o;
      if (has1) { u32x2 o1; o1.x = pk_bf16(v1[i].x * rs1 * gg.x, v1[i].y * rs1 * gg.y); o1.y = pk_bf16(v1[i].z * rs1 * gg.z, v1[i].w * rs1 * gg.w);
        ((u32x2*)(out + (size_t)r1 * D))[i * 64 + lane] = o1; } }
  }
}

namespace att {
typedef float f32x16 __attribute__((ext_vector_type(16)));
constexpr int KVBLK = 64, SHM_V = 64 * 128 * 2, SHM_KN = 64 * 128 * 2, SHM_KR = 64 * 64 * 2, SHM_BUF = SHM_V + SHM_KN + SHM_KR;
constexpr float SCALE = 0.07216878364870322f, THR = 8.f;
#define KSWZ(row, colB) ((row) * 256 + ((colB) ^ (((row) & 7) << 4)))
#define KRSWZ(row, colB) ((row) * 128 + ((colB) ^ ((((row) >> 1) & 7) << 4)))
#define SBAR() __builtin_amdgcn_sched_barrier(0)
__device__ __forceinline__ int crow(int r, int hi) { return (r & 3) + 8 * (r >> 2) + 4 * hi; }
__device__ __forceinline__ unsigned cvtpk(float lo, float hi) { unsigned r; asm volatile("v_cvt_pk_bf16_f32 %0, %1, %2" : "=v"(r) : "v"(lo), "v"(hi)); return r; }
__device__ __forceinline__ void partialSM(f32x16& p0, f32x16& p1, float& m_reg, float& mn, float& alpha) {
  constexpr float C = SCALE * 1.4426950408889634f;
  float pmax = p0[0];
#pragma unroll
  for (int r = 1; r < 16; ++r) pmax = fmaxf(pmax, p0[r]);
#pragma unroll
  for (int r = 0; r < 16; ++r) pmax = fmaxf(pmax, p1[r]);
  { auto rr = __builtin_amdgcn_permlane32_swap(__float_as_uint(pmax), __float_as_uint(pmax), false, false);
    pmax = fmaxf(__uint_as_float(rr[0]), __uint_as_float(rr[1])); }
  if (__builtin_expect(__all(pmax - m_reg <= THR / SCALE), 1)) { mn = m_reg; alpha = 1.f; }
  else { mn = fmaxf(m_reg, pmax); alpha = __builtin_amdgcn_exp2f((m_reg - mn) * C); m_reg = mn; }
  const float mnC = -mn * C;
#pragma unroll
  for (int r = 0; r < 16; ++r) p0[r] = fmaf(p0[r], C, mnC);
#pragma unroll
  for (int r = 0; r < 16; ++r) p1[r] = fmaf(p1[r], C, mnC);
#pragma unroll
  for (int r = 0; r < 16; ++r) p0[r] = __builtin_amdgcn_exp2f(p0[r]);
}
__device__ __forceinline__ void finishSM(f32x16& p0, f32x16& p1, float alpha, float& l_reg, bf16x8& pa0, bf16x8& pa1, bf16x8& pa2, bf16x8& pa3) {
#pragma unroll
  for (int r = 0; r < 16; ++r) p1[r] = __builtin_amdgcn_exp2f(p1[r]);
  float ps = 0;
#pragma unroll
  for (int r = 0; r < 16; ++r) ps += p0[r];
#pragma unroll
  for (int r = 0; r < 16; ++r) ps += p1[r];
  { auto rr = __builtin_amdgcn_permlane32_swap(__float_as_uint(ps), __float_as_uint(ps), false, false);
    ps = __uint_as_float(rr[0]) + __uint_as_float(rr[1]); }
  l_reg = l_reg * alpha + ps;
#define PK4(P_, BASE, OUT) do { unsigned a0 = cvtpk(P_[BASE + 0], P_[BASE + 1]), a1 = cvtpk(P_[BASE + 2], P_[BASE + 3]);   \
    unsigned b0 = cvtpk(P_[BASE + 4], P_[BASE + 5]), b1 = cvtpk(P_[BASE + 6], P_[BASE + 7]);                              \
    auto r0 = __builtin_amdgcn_permlane32_swap(a0, b0, false, false); auto r1 = __builtin_amdgcn_permlane32_swap(a1, b1, false, false); \
    u32x4 w = {r0[0], r1[0], r0[1], r1[1]}; OUT = *reinterpret_cast<bf16x8*>(&w); } while (0)
  PK4(p0, 0, pa0); PK4(p0, 8, pa1); PK4(p1, 0, pa2); PK4(p1, 8, pa3);
#undef PK4
}
__device__ __forceinline__ void qkt(f32x16& p0, f32x16& p1, ldsp Kn, ldsp Kr, const bf16x8 (&qr)[8], ldsp qrl, int r32, int hi) {
  asm volatile("" : "+v"(r32), "+v"(hi));
  p0 = f32x16{}; p1 = f32x16{};
#pragma unroll
  for (int d0 = 0; d0 < 8; ++d0) { const int cb = (d0 * 16 + hi * 8) * 2;
    const bf16x8 b0 = *(const LAS bf16x8*)(Kn + KSWZ(r32, cb)); const bf16x8 b1 = *(const LAS bf16x8*)(Kn + KSWZ(32 + r32, cb));
    p0 = __builtin_amdgcn_mfma_f32_32x32x16_bf16(b0, qr[d0], p0, 0, 0, 0); p1 = __builtin_amdgcn_mfma_f32_32x32x16_bf16(b1, qr[d0], p1, 0, 0, 0); }
#pragma unroll
  for (int d0 = 0; d0 < 4; ++d0) { const int cb = (d0 * 16 + hi * 8) * 2;
    const bf16x8 b0 = *(const LAS bf16x8*)(Kr + KRSWZ(r32, cb)); const bf16x8 b1 = *(const LAS bf16x8*)(Kr + KRSWZ(32 + r32, cb));
    const bf16x8 qf = *(const LAS bf16x8*)(qrl + KSWZ(r32, cb + 128));
    p0 = __builtin_amdgcn_mfma_f32_32x32x16_bf16(b0, qf, p0, 0, 0, 0); p1 = __builtin_amdgcn_mfma_f32_32x32x16_bf16(b1, qf, p1, 0, 0, 0); }
}
__device__ __forceinline__ int v_st(int k, int c) { const int kk = (k & ~0xC) | ((k & 4) << 1) | ((k & 8) >> 1); return ((kk >> 3) * 4 + (c >> 5)) * 512 + ((kk & 7) * 32 + (c & 31)) * 2; }
__device__ __forceinline__ int v_rd_base(int lane) { return ((lane & 3) << 3) | (((lane >> 2) & 3) << 6) | (((lane >> 4) & 1) << 5) | (((lane >> 5) & 1) << 8); }
__device__ __forceinline__ s16x4 trr(ldsp vb, int off) { return __builtin_amdgcn_ds_read_tr16_b64_v4i16((LAS s16x4*)(vb + off)); }
__device__ __forceinline__ void pv_one(f32x16& od, ldsp vb, int d0, bf16x8 pa0, bf16x8 pa1, bf16x8 pa2, bf16x8 pa3) {
#define VOFF(ks, half) (d0 * 512 + (ks) * 4096 + (half) * 2048)
  const s16x4 l0 = trr(vb, VOFF(0, 0)), h0 = trr(vb, VOFF(0, 1)), l1 = trr(vb, VOFF(1, 0)), h1 = trr(vb, VOFF(1, 1));
  const s16x4 l2 = trr(vb, VOFF(2, 0)), h2 = trr(vb, VOFF(2, 1)), l3 = trr(vb, VOFF(3, 0)), h3 = trr(vb, VOFF(3, 1));
#undef VOFF
#define PK(L, H_) (bf16x8){L[0], L[1], L[2], L[3], H_[0], H_[1], H_[2], H_[3]}
  od = __builtin_amdgcn_mfma_f32_32x32x16_bf16(pa0, PK(l0, h0), od, 0, 0, 0);
  od = __builtin_amdgcn_mfma_f32_32x32x16_bf16(pa1, PK(l1, h1), od, 0, 0, 0);
  od = __builtin_amdgcn_mfma_f32_32x32x16_bf16(pa2, PK(l2, h2), od, 0, 0, 0);
  od = __builtin_amdgcn_mfma_f32_32x32x16_bf16(pa3, PK(l3, h3), od, 0, 0, 0);
  SBAR();
#undef PK
}
__device__ __forceinline__ void pv_all(f32x16 (&o)[4], ldsp vb, bf16x8 pa0, bf16x8 pa1, bf16x8 pa2, bf16x8 pa3) {
  pv_one(o[0], vb, 0, pa0, pa1, pa2, pa3); pv_one(o[1], vb, 1, pa0, pa1, pa2, pa3); pv_one(o[2], vb, 2, pa0, pa1, pa2, pa3); pv_one(o[3], vb, 3, pa0, pa1, pa2, pa3);
}
__device__ __forceinline__ void attn_unit(const bf16_t* __restrict__ Qb, const bf16_t* __restrict__ Kh, const bf16_t* __restrict__ Krp, bf16_t* __restrict__ Ob, ldsp lds) {
  int tid = threadIdx.x; asm volatile("" : "+v"(tid));
  const int wid = tid >> 6, lane = tid & 63, r32 = lane & 31, hi = lane >> 5;
  LAS float* ws = (LAS float*)(lds + 2 * SHM_BUF) + wid * 64; LAS float* li_l = ws; LAS float* al_l = ws + 32;
  float m_reg = -1e30f, l_reg = 0; f32x16 o[4] = {}; bf16x8 qr[8];
  const bf16_t* Qw = Qb + (size_t)(wid * 32 + r32) * QW + hi * 8;
#pragma unroll
  for (int d0 = 0; d0 < 8; ++d0) qr[d0] = *(const bf16x8*)(Qw + d0 * 16);
  ldsp qrl = lds + 2 * SHM_BUF + 2048 + wid * 8192;
#pragma unroll
  for (int d0 = 0; d0 < 8; ++d0) *(LAS bf16x8*)(qrl + KSWZ(r32, (d0 * 16 + hi * 8) * 2)) = *(const bf16x8*)(Qw + 64 + d0 * 16);
  const int sr = tid >> 4, sc = (tid & 15) * 8, vst0 = v_st(sr, sc), vst1 = v_st(32 + sr, sc);
  const int rr_ = tid >> 3, rc_ = (tid & 7) * 8;
  const int vrb = v_rd_base(lane);
  bf16x8 vs0, vs1, ks0, ks1, krs;
#define VB(b) (lds + (b) * SHM_BUF)
#define KNB(b) (lds + (b) * SHM_BUF + SHM_V)
#define KRB(b) (lds + (b) * SHM_BUF + SHM_V + SHM_KN)
#define SLOAD(k0) do { const bf16_t* kp0 = Kh + (size_t)((k0) + sr) * KVW + sc; const bf16_t* kp1 = Kh + (size_t)((k0) + 32 + sr) * KVW + sc; \
    vs0 = *(const bf16x8*)(kp0 + 128); vs1 = *(const bf16x8*)(kp1 + 128); ks0 = *(const bf16x8*)kp0; ks1 = *(const bf16x8*)kp1; \
    krs = *(const bf16x8*)(Krp + (size_t)((k0) + rr_) * RD + rc_); } while (0)
#define SWRITE(b) do { *(LAS bf16x8*)(VB(b) + vst0) = vs0; *(LAS bf16x8*)(VB(b) + vst1) = vs1; \
    *(LAS bf16x8*)(KNB(b) + KSWZ(sr, sc * 2)) = ks0; *(LAS bf16x8*)(KNB(b) + KSWZ(32 + sr, sc * 2)) = ks1; \
    *(LAS bf16x8*)(KRB(b) + KRSWZ(rr_, rc_ * 2)) = krs; } while (0)
#define RESC(a) do { if (__any((a) < 1.f)) { if (hi == 0) al_l[r32] = (a); asm volatile("s_waitcnt lgkmcnt(0)" ::: "memory"); \
    _Pragma("unroll") for (int d = 0; d < 4; ++d) _Pragma("unroll") for (int r = 0; r < 16; ++r) o[d][r] *= al_l[crow(r, hi)]; } } while (0)
  f32x16 pA0, pA1, pB0, pB1; float mnA, mnB, alA, alB; bf16x8 pa0, pa1, pa2, pa3; constexpr int NT = S / KVBLK;
  SLOAD(0); SWRITE(0); __syncthreads();
  qkt(pA0, pA1, KNB(0), KRB(0), qr, qrl, r32, hi); partialSM(pA0, pA1, m_reg, mnA, alA);
  SLOAD(KVBLK); SWRITE(1); __syncthreads();
  for (int j = 1; j + 1 < NT; j += 2) {
    SBAR(); qkt(pB0, pB1, KNB(1), KRB(1), qr, qrl, r32, hi);
    finishSM(pA0, pA1, alA, l_reg, pa0, pa1, pa2, pa3); SBAR();
    SLOAD((j + 1) * KVBLK); SBAR();
    pv_all(o, VB(0) + vrb, pa0, pa1, pa2, pa3); partialSM(pB0, pB1, m_reg, mnB, alB);
    __syncthreads(); SWRITE(0);
    RESC(alB); __syncthreads();
    SBAR(); qkt(pA0, pA1, KNB(0), KRB(0), qr, qrl, r32, hi);
    finishSM(pB0, pB1, alB, l_reg, pa0, pa1, pa2, pa3); SBAR();
    SLOAD((j + 2) * KVBLK); SBAR();
    pv_all(o, VB(1) + vrb, pa0, pa1, pa2, pa3); partialSM(pA0, pA1, m_reg, mnA, alA);
    __syncthreads(); SWRITE(1);
    RESC(alA); __syncthreads();
  }
  SBAR(); qkt(pB0, pB1, KNB(1), KRB(1), qr, qrl, r32, hi);
  finishSM(pA0, pA1, alA, l_reg, pa0, pa1, pa2, pa3); SBAR();
  pv_all(o, VB(0) + vrb, pa0, pa1, pa2, pa3); partialSM(pB0, pB1, m_reg, mnB, alB);
  __syncthreads(); RESC(alB);
  finishSM(pB0, pB1, alB, l_reg, pa0, pa1, pa2, pa3); SBAR();
  pv_all(o, VB(1) + vrb, pa0, pa1, pa2, pa3);
  if (hi == 0) li_l[r32] = l_reg; asm volatile("s_waitcnt lgkmcnt(0)" ::: "memory");
  float rli[16];
#pragma unroll
  for (int r = 0; r < 16; ++r) rli[r] = __builtin_amdgcn_rcpf(li_l[crow(r, hi)]);
  bf16_t* Ow = Ob + (size_t)(wid * 32) * D;
#pragma unroll
  for (int r = 0; r < 16; ++r) { const int orow = crow(r, hi);
#pragma unroll
    for (int d0 = 0; d0 < 4; ++d0) Ow[(size_t)orow * D + d0 * 32 + r32] = f2bf(o[d0][r] * rli[r]); }
  __syncthreads();
#undef VB
#undef KNB
#undef KRB
#undef SLOAD
#undef SWRITE
#undef RESC
}
}
__device__ __forceinline__ void phase_attn(const P& p, ldsp lds, int bid, int nb) {
  for (int u = bid; u < NB * H * (S / 256); u += nb) {
    const int qb = u & 7, h = (u >> 3) & 7, b = u >> 6;
    const size_t row0 = (size_t)b * S + qb * 256;
    att::attn_unit(p.q + row0 * QW + h * 192, p.kv + (size_t)b * S * KVW + h * 256, p.krope + (size_t)b * S * RD, p.mix + row0 * D + h * 128, lds);
  }
}


__device__ __forceinline__ void phase_conv(const P& p, ldsp lds, int bid, int nb) {
  LAS float* red = (LAS float*)lds;
  for (int u = bid; u < T / 16; u += nb) {
    int tid = threadIdx.x; asm volatile("" : "+v"(tid));
    const int wid = tid >> 6, lane = tid & 63, ch = tid * 2;
    const int t0 = u * 16, b = t0 / S, s0 = t0 % S;
    float w0[CW], w1[CW];
#pragma unroll
    for (int j = 0; j < CW; ++j) { const float2 wv = *(const float2*)(p.w_dw + j * CC + ch); w0[j] = wv.x; w1[j] = wv.y; }
    const float2 bd = *(const float2*)(p.b_dw + ch);
    float a0[16], a1[16];
#pragma unroll
    for (int i = 0; i < 16; ++i) { a0[i] = bd.x; a1[i] = bd.y; }
#pragma unroll
    for (int rr = 0; rr < 46; ++rr) { const int s = s0 - 15 + rr; float v0 = 0.f, v1 = 0.f;
      { const int scl = min(max(s, 0), S - 1); const unsigned raw = *(const unsigned*)(p.cglu + ((size_t)b * S + scl) * CC + ch);
        const bool ok = (s >= 0 && s < S); v0 = ok ? __uint_as_float(raw << 16) : 0.f; v1 = ok ? __uint_as_float(raw & 0xffff0000u) : 0.f; }
#pragma unroll
      for (int i = 0; i < 16; ++i) { const int j = rr - i; if (j >= 0 && j < CW) { a0[i] += w0[j] * v0; a1[i] += w1[j] * v1; } } }
#pragma unroll
    for (int i = 0; i < 16; ++i) { const float sm = wave_sum(a0[i] + a1[i]), sq = wave_sum(a0[i] * a0[i] + a1[i] * a1[i]);
      if (lane == 0) { red[wid * 32 + i] = sm; red[wid * 32 + 16 + i] = sq; } }
    __syncthreads();
    if (tid < 32) { float t = 0.f;
#pragma unroll
      for (int w = 0; w < 8; ++w) t += red[w * 32 + tid];
      red[256 + tid] = t; }
    __syncthreads();
    const float2 lg = *(const float2*)(p.conv_ln_g + ch), lb = *(const float2*)(p.conv_ln_b + ch);
#pragma unroll
    for (int i = 0; i < 16; ++i) { const float mu = red[256 + i] * (1.f / CC), var = red[256 + 16 + i] * (1.f / CC) - mu * mu; const float rs = rsqrtf(fmaxf(var, 0.f) + EPS);
      const float y0 = (a0[i] - mu) * rs * lg.x + lb.x, y1 = (a1[i] - mu) * rs * lg.y + lb.y;
      *(unsigned*)(p.mix + (size_t)(t0 + i) * D + CC + ch) = pk_bf16(siluf_(y0), siluf_(y1)); }
    __syncthreads();
  }
}

__device__ __forceinline__ void phase_route2(const P& p, ldsp lds, int bid, int nb) {
  constexpr int RS = 4096 + 16;
  const int tid = threadIdx.x, wid = tid >> 6, lane = tid & 63, fr = lane & 15, fq = lane >> 4;
  for (int u = bid; u < T / 32; u += nb) {
    const int t0 = u * 32;
    __syncthreads();
#pragma unroll
    for (int i = 0; i < 16; ++i) { const int c = i * 512 + tid, r = c >> 8, pc = c & 255;
      *(LAS u32x4*)(lds + r * RS + pc * 16) = *(const u32x4*)(p.hn + (size_t)(t0 + r) * D + pc * 8); }
    __syncthreads();
    f32x4 acc[2][5];
#pragma unroll
    for (int m = 0; m < 2; ++m)
#pragma unroll
      for (int n = 0; n < 5; ++n) acc[m][n] = (f32x4){0.f, 0.f, 0.f, 0.f};
#pragma unroll 2
    for (int ks = 0; ks < 8; ++ks) { const int k0 = wid * 256 + ks * 32 + fq * 8;
      bf16x8 Bf[5];
#pragma unroll
      for (int n = 0; n < 5; ++n) Bf[n] = *(const bf16x8*)(p.WrT + (size_t)(n * 16 + fr) * D + k0);
      const bf16x8 A0 = *(const LAS bf16x8*)(lds + fr * RS + k0 * 2), A1 = *(const LAS bf16x8*)(lds + (16 + fr) * RS + k0 * 2);
#pragma unroll
      for (int n = 0; n < 5; ++n) { acc[0][n] = __builtin_amdgcn_mfma_f32_16x16x32_bf16(Bf[n], A0, acc[0][n], 0, 0, 0); acc[1][n] = __builtin_amdgcn_mfma_f32_16x16x32_bf16(Bf[n], A1, acc[1][n], 0, 0, 0); } }
    __syncthreads();
    LAS float* part = (LAS float*)lds;
#pragma unroll
    for (int m = 0; m < 2; ++m)
#pragma unroll
      for (int n = 0; n < 5; ++n) *(LAS f32x4*)(part + (wid * 32 + m * 16 + fr) * 80 + n * 16 + fq * 4) = acc[m][n];
    __syncthreads();
    LAS float* lg_ = part + 8 * 32 * 80;
    for (int o = tid; o < 32 * 80; o += NTHR) { float s = 0.f;
#pragma unroll
      for (int w = 0; w < 8; ++w) s += part[w * 2560 + o];
      lg_[o] = s; }
    __syncthreads();
    if (tid < 32) { const int t = t0 + tid; const LAS float* L_ = lg_ + tid * 80;
      float sq = 0.f;
#pragma unroll
      for (int i = 0; i < 32; i += 4) { const float4 v = *(const float4*)(p.ssq_h + (size_t)t * 32 + i); sq += (v.x + v.y) + (v.z + v.w); }
      const float rs = rsqrtf(sq * (1.f / D) + EPS); p.rstd_h[t] = rs;
      float lg[NG];
#pragma unroll
      for (int j = 0; j < NG; ++j) lg[j] = L_[j] * rs + p.b_group[j];
      int gs = 0; float gm = lg[0];
#pragma unroll
      for (int j = 1; j < NG; ++j) if (lg[j] > gm) { gm = lg[j]; gs = j; }
      float gsum = 0.f;
#pragma unroll
      for (int j = 0; j < NG; ++j) gsum += __expf(lg[j] - gm);
      const float pg = 1.f / gsum;
      float el[EPG];
#pragma unroll
      for (int j = 0; j < EPG; ++j) el[j] = L_[NG + gs * EPG + j] * rs + p.b_router[gs * EPG + j];
      int i1 = 0; float m1 = el[0];
#pragma unroll
      for (int j = 1; j < EPG; ++j) if (el[j] > m1) { m1 = el[j]; i1 = j; }
      int i2 = -1; float m2 = -1e30f;
#pragma unroll
      for (int j = 0; j < EPG; ++j) if (j != i1 && el[j] > m2) { m2 = el[j]; i2 = j; }
      const float e2 = __expf(m2 - m1); const float w1 = 1.f / (1.f + e2), w2 = e2 / (1.f + e2);
      const int ea = gs * EPG + i1, eb = gs * EPG + i2;
      const int pa = atomicAdd(&p.cnt[ea], 1); p.list_tok[ea * LCAP + pa] = t * 2; p.list_gate[ea * LCAP + pa] = pg * w1;
      const int pb = atomicAdd(&p.cnt[eb], 1); p.list_tok[eb * LCAP + pb] = t * 2 + 1; p.list_gate[eb * LCAP + pb] = pg * w2;
    }
  }
}
__device__ __forceinline__ int trw(int k, int c) { return (c >> 4) * 2080 + (k >> 4) * 512 + (((k & 15) * 32) ^ (((k >> 3) & 1) << 7)) + (c & 15) * 2; }
struct MoeUnit { int e, m0, count, sl, start, tile; };
template <int MODE, int PROBE = 0>
__device__ __forceinline__ void moe_stream(const P& p, ldsp lds, int bid, int nb) {
  constexpr int NS = MODE == 0 ? 8 : 16, NK = MODE == 0 ? D / BK : DE / BK, MROWS = 320, NFM = 5, MA_B = MROWS * 128, MSTAGE = MA_B + 16640 + 256;
  constexpr int TAB_OFF = 2 * MSTAGE + 1024, TAB_UNIT = MROWS * 8, CAP = (LDS_BYTES - 16 - TAB_OFF) / TAB_UNIT;
  LAS int* ts = (LAS int*)(lds + 2 * MSTAGE);
  LAS int* stt = ts + 80; LAS int* cntl = ts + 160;
  __syncthreads();
  if (threadIdx.x < NE) cntl[threadIdx.x] = p.cnt[threadIdx.x];
  __syncthreads();
  if (threadIdx.x == 0) { int s = 0, r = 0; for (int e = 0; e < NE; ++e) { const int c = cntl[e]; ts[e] = s; stt[e] = r; s += (c + MROWS - 1) / MROWS; r += c; } ts[NE] = s; stt[NE] = r; }
  __syncthreads();
  const int ntile = ts[NE];
  int xcd, slot, nslots, nloc;
  if ((nb & 7) == 0) { xcd = bid & 7; slot = bid >> 3; nslots = nb >> 3; nloc = ((ntile - xcd + 7) >> 3) * NS; }
  else { xcd = 0; slot = bid; nslots = nb; nloc = ntile * NS; }
  int nu_all = nloc > slot ? (nloc - slot + nslots - 1) / nslots : 0, doff = 0;
  if (MODE == 1) {
    const int nlu = nloc / 2, ubase = nlu / nslots, urem = nlu % nslots, Tt = (4 * nlu + nloc + nslots - 1) / nslots;
    int rem = nloc; nu_all = 0;
    for (int k = 0; k < nslots; ++k) { const int sidx = (k + urem) % nslots, U = sidx < urem ? ubase + 1 : ubase; const int d = min(max(0, Tt - 4 * U), rem);
      if (sidx == slot) { doff = nloc - rem; nu_all = d; } rem -= d; }
  }
  int tid = threadIdx.x; asm volatile("" : "+v"(tid));
  const int wid = tid >> 6, lane = tid & 63, wm = wid >> 1, wn = wid & 1, fr = lane & 15, fq = lane >> 4;
  const bf16_t* abase = MODE == 0 ? p.hn : p.hb;
  constexpr int LDB = (PROBE & 1) ? 128 : (MODE == 0 ? DE : D);
  for (int c0 = 0; c0 < nu_all; c0 += CAP) {
    const int nu = min(CAP, nu_all - c0), total = nu * NK;
    auto unit_of = [&](int j) { MoeUnit u; const int l = MODE == 0 ? slot + (c0 + j) * nslots : doff + c0 + j; const int tile = ((nb & 7) == 0) ? (l / NS) * 8 + xcd : l / NS; u.sl = l % NS; u.tile = tile;
      int e = 0;
#pragma unroll 1
      for (int s = 32; s > 0; s >>= 1) if (e + s < NE && ts[e + s] <= tile) e += s;
      u.e = e; u.m0 = (tile - ts[e]) * MROWS; u.count = min(MROWS, cntl[e] - u.m0); u.start = stt[e]; return u; };
    __syncthreads();
    for (int j = 0; j < nu; ++j) { const MoeUnit u = unit_of(j);
      for (int r = threadIdx.x; r < MROWS; r += NTHR) { const int rr = min(r, u.count - 1);
        if (MODE == 0) { const int tk = p.list_tok[u.e * LCAP + u.m0 + rr] >> 1; ((LAS unsigned*)(lds + TAB_OFF + j * TAB_UNIT))[r] = (unsigned)(tk * D); ((LAS float*)(lds + TAB_OFF + j * TAB_UNIT + MROWS * 4))[r] = p.rstd_h[tk]; }
        else { ((LAS int*)(lds + TAB_OFF + j * TAB_UNIT))[r] = p.list_tok[u.e * LCAP + u.m0 + rr]; ((LAS float*)(lds + TAB_OFF + j * TAB_UNIT + MROWS * 4))[r] = p.list_gate[u.e * LCAP + u.m0 + rr]; } } }
    asm volatile("s_waitcnt vmcnt(0)" ::: "memory");
    __syncthreads();
    unsigned ao[NFM]; int a_j = -1, a_tile = -1;
    auto a_setup = [&](int j) { const MoeUnit u = unit_of(j); a_j = j;
      if (MODE == 1 && u.tile != a_tile) {
        if (wid == 0) { unsigned sp = 0; while (__hip_atomic_load(p.moe_done + u.tile, __ATOMIC_RELAXED, __HIP_MEMORY_SCOPE_AGENT) < 8u) { __builtin_amdgcn_s_sleep(8); if (++sp > (1u << 22)) break; }
          __builtin_amdgcn_fence(__ATOMIC_ACQUIRE, "agent"); asm volatile("s_waitcnt vmcnt(0)" ::: "memory"); }
        __syncthreads(); a_tile = u.tile; }
#pragma unroll
      for (int i = 0; i < NFM; ++i) { int R, C; stage_rc(wid * 1024 + i * 8192 + lane * 16, R, C);
        if (MODE == 0) ao[i] = ((const LAS unsigned*)(lds + TAB_OFF + j * TAB_UNIT))[R] + C; else ao[i] = (unsigned)((u.start + u.m0 + min(R, u.count - 1)) * DE + C); } };
    const float* bsrc = nullptr; int b_j = -1;
    auto b_setup = [&](int j) { const MoeUnit u = unit_of(j); b_j = j; const int tc = (lane & 31) * 4;
      if (PROBE & 1) { if (MODE == 0) bsrc = p.w_gate + (size_t)((u.tile * NS + u.sl) & 255) * D * 128 + (size_t)(8 * wid + (lane >> 5)) * 128 + tc; else bsrc = p.w_down + (size_t)((u.tile * NS + u.sl) & 1023) * DE * 128 + (size_t)(8 * wid + (lane >> 5)) * 128 + tc; }
      else if (MODE == 0) { const int jj = tc & 63; bsrc = (jj < 32 ? p.w_gate : p.w_up) + (size_t)u.e * D * DE + (size_t)(8 * wid + (lane >> 5)) * DE + u.sl * 64 + (tc >> 6) * 32 + (jj & 31); }
      else bsrc = p.w_down + (size_t)u.e * DE * D + (size_t)(8 * wid + (lane >> 5)) * D + u.sl * 128 + tc; };
    u32x4 ar0[NFM]; f32x4 br0[4], br1[4];
    f32x4 acc[NFM][4];
#pragma unroll
    for (int i = 0; i < NFM; ++i)
#pragma unroll
      for (int n = 0; n < 4; ++n) acc[i][n] = (f32x4){0.f, 0.f, 0.f, 0.f};
#define A_ISSUE(AR, pos_) do { const int pos = min((pos_), total - 1); const int j_ = pos / NK, kt_ = pos % NK; if (j_ != a_j) a_setup(j_); \
      _Pragma("unroll") for (int i = 0; i < NFM; ++i) AR[i] = *(const u32x4*)(abase + ao[i] + kt_ * BK); } while (0)
#define B_ISSUE(BR, pos_) do { const int pos = min((pos_), total - 1); const int j_ = pos / NK, kt_ = pos % NK; if (j_ != b_j) b_setup(j_); \
      _Pragma("unroll") for (int q = 0; q < 4; ++q) BR[q] = __builtin_nontemporal_load((const f32x4*)(bsrc + (size_t)(kt_ * BK + 2 * q) * LDB)); } while (0)
#define A_WRITE(AR, buf) do { int t_ = tid; asm volatile("" : "+v"(t_)); const int w_i = t_ >> 6, l_i = t_ & 63; \
      _Pragma("unroll") for (int i = 0; i < NFM; ++i) *(LAS u32x4*)(lds + (buf) * MSTAGE + w_i * 1024 + i * 8192 + l_i * 16) = AR[i]; } while (0)
#define B_WRITE(BR, buf) do { int t_ = tid; asm volatile("" : "+v"(t_)); const int w_i = t_ >> 6, l_i = t_ & 63; \
      _Pragma("unroll") for (int q = 0; q < 4; ++q) { u32x2 w_; w_.x = pk_bf16(BR[q][0], BR[q][1]); w_.y = pk_bf16(BR[q][2], BR[q][3]); \
      const int tc_ = (l_i & 31) * 4, ic_ = MODE == 1 ? ((tc_ & 64) | (((tc_ >> 2) & 3) << 4) | (((tc_ >> 4) & 3) << 2)) : tc_;     \
      *(LAS u32x2*)(lds + (buf) * MSTAGE + MA_B + trw(8 * w_i + 2 * q + (l_i >> 5), ic_)) = w_; } } while (0)
    int c_j = 0; MoeUnit cu = unit_of(0); int nvf = max(0, min(NFM, ((cu.count + 15) / 16 - wm + 3) >> 2));
    auto compute_nf = [&](int buf, auto nfc) {
      constexpr int NF = decltype(nfc)::value;
      ldsp sb = lds + buf * MSTAGE;
      int t_ = tid; asm volatile("" : "+v"(t_));
      const int wn_ = (t_ >> 6) & 1, wm_ = t_ >> 7, fr_ = t_ & 15, fq_ = (t_ >> 4) & 3, q_ = fr_ >> 2, pp_ = fr_ & 3;
      const int lp0 = (fq_ >> 1) * 512 + (fq_ & 1) * 256 + ((fq_ & 1) << 7) + q_ * 32 + pp_ * 8;
      const int trb0 = MA_B + wn_ * 4 * 2080 + lp0, trb1 = MA_B + wn_ * 4 * 2080 + (lp0 ^ 128);
      const int afb = lds_byte(wm_ * 16 + fr_, fq_ * 8);
#pragma unroll
      for (int ks = 0; ks < 2; ++ks) {
        bf16x8 Bf[4];
#pragma unroll
        for (int n = 0; n < 4; ++n) {
          const s16x4 lo = __builtin_amdgcn_ds_read_tr16_b64_v4i16((LAS s16x4*)(sb + trb0 + n * 2080 + ks * 1024));
          const s16x4 hi = __builtin_amdgcn_ds_read_tr16_b64_v4i16((LAS s16x4*)(sb + trb1 + n * 2080 + ks * 1024));
          Bf[n] = __builtin_shufflevector(lo, hi, 0, 1, 2, 3, 4, 5, 6, 7); }
        bf16x8 At[NF];
#pragma unroll
        for (int i = 0; i < NF; ++i) At[i] = *(const LAS bf16x8*)(sb + afb + i * 8192 + ks * 1024);
#pragma unroll
        for (int i = 0; i < NF; ++i)
#pragma unroll
          for (int n = 0; n < 4; ++n) acc[i][n] = __builtin_amdgcn_mfma_f32_16x16x32_bf16(Bf[n], At[i], acc[i][n], 0, 0, 0);
        __builtin_amdgcn_sched_barrier(0);
      }
    };
    auto compute = [&](int buf) {
      if (nvf <= 4) compute_nf(buf, std::integral_constant<int, 4>()); else compute_nf(buf, std::integral_constant<int, 5>()); };
    auto epilogue = [&]() {
      int fr2 = fr, fq2 = fq; asm volatile("" : "+v"(fr2), "+v"(fq2));
#pragma unroll
      for (int i = 0; i < NFM; ++i) { const int r = (wm + 4 * i) * 16 + fr2;
        if (r < cu.count) {
          if (MODE == 0) { bf16_t* dst = ((PROBE & 1) ? (bf16_t*)p.convtmp : p.hb) + (size_t)(cu.start + cu.m0 + r) * DE + cu.sl * 64 + wn * 32 + fq2 * 4;
            const float rs = ((const LAS float*)(lds + TAB_OFF + c_j * TAB_UNIT + MROWS * 4))[r];
#pragma unroll
            for (int n = 0; n < 2; ++n) { const f32x4 g = acc[i][n] * rs, uu = acc[i][n + 2] * rs;
              const unsigned lo = pk_bf16(siluf_(g[0]) * uu[0], siluf_(g[1]) * uu[1]), hi = pk_bf16(siluf_(g[2]) * uu[2], siluf_(g[3]) * uu[3]);
              __hip_atomic_store((unsigned long long*)(dst + n * 16), ((unsigned long long)hi << 32) | lo, __ATOMIC_RELAXED, __HIP_MEMORY_SCOPE_AGENT); } }
          else { const int ts2 = ((const LAS int*)(lds + TAB_OFF + c_j * TAB_UNIT))[r]; const float gate = ((const LAS float*)(lds + TAB_OFF + c_j * TAB_UNIT + MROWS * 4))[r];
            bf16_t* dst = p.y + (size_t)ts2 * D + cu.sl * 128 + wn * 64 + fq2 * 16;
            u32x4 w0, w1;
            w0.x = pk_bf16(acc[i][0][0] * gate, acc[i][0][1] * gate); w0.y = pk_bf16(acc[i][0][2] * gate, acc[i][0][3] * gate); w0.z = pk_bf16(acc[i][1][0] * gate, acc[i][1][1] * gate); w0.w = pk_bf16(acc[i][1][2] * gate, acc[i][1][3] * gate);
            w1.x = pk_bf16(acc[i][2][0] * gate, acc[i][2][1] * gate); w1.y = pk_bf16(acc[i][2][2] * gate, acc[i][2][3] * gate); w1.z = pk_bf16(acc[i][3][0] * gate, acc[i][3][1] * gate); w1.w = pk_bf16(acc[i][3][2] * gate, acc[i][3][3] * gate);
            if (!(PROBE & 16)) { *(u32x4*)dst = w0; *(u32x4*)(dst + 8) = w1; } else asm volatile("" :: "v"(w0.x), "v"(w1.x)); }
        }
#pragma unroll
        for (int n = 0; n < 4; ++n) acc[i][n] = (f32x4){0.f, 0.f, 0.f, 0.f};
      }
    };
    A_ISSUE(ar0, 0); B_ISSUE(br0, 0); A_WRITE(ar0, 0); B_WRITE(br0, 0);
    B_ISSUE(br1, 1); A_ISSUE(ar0, 1); B_ISSUE(br0, 2);
    __syncthreads();
#define STEP(s, BRW, ARW) do { \
      if (!(PROBE & 4)) A_WRITE(ar0, ((s) + 1) & 1); if (!(PROBE & 32)) B_WRITE(BRW, ((s) + 1) & 1); else asm volatile("" :: "v"(BRW[0][0]), "v"(BRW[1][0]), "v"(BRW[2][0]), "v"(BRW[3][0])); \
      if (!(PROBE & 4)) A_ISSUE(ar0, (s) + 2); if (!(PROBE & 8)) B_ISSUE(BRW, (s) + 3); \
      if (!(PROBE & 2)) compute((s) & 1); \
      int sig_ = -1; \
      if (((s) + 1) % NK == 0) { epilogue(); __builtin_amdgcn_s_waitcnt(0x0F70); sig_ = cu.tile; if ((s) + 1 < total) { c_j = ((s) + 1) / NK; cu = unit_of(c_j); nvf = max(0, min(NFM, ((cu.count + 15) / 16 - wm + 3) >> 2)); } } \
      asm volatile("s_waitcnt lgkmcnt(0)" ::: "memory"); __builtin_amdgcn_s_barrier(); \
      if (MODE == 0 && !PROBE && sig_ >= 0 && threadIdx.x == 0) __hip_atomic_fetch_add(p.moe_done + sig_, 1u, __ATOMIC_RELAXED, __HIP_MEMORY_SCOPE_AGENT);     \
      } while (0)
    for (int s = 0; s < total; s += 2) { STEP(s, br1, ar1); STEP(s + 1, br0, ar0); }
    asm volatile("s_waitcnt vmcnt(0)" ::: "memory");
#undef STEP
#undef A_ISSUE
#undef B_ISSUE
#undef A_WRITE
#undef B_WRITE
  }
}
__device__ __forceinline__ void phase_final(const P& p, int bid, int nb) {
  const int lane = threadIdx.x & 63, w = (bid * NTHR + threadIdx.x) >> 6, nw = nb * (NTHR / 64);
  for (int r = w; r < T; r += nw) {
    const u32x2* src = (const u32x2*)(p.h16 + (size_t)r * D);
    const u32x2* y0 = (const u32x2*)(p.y + (size_t)(2 * r) * D); const u32x2* y1 = (const u32x2*)(p.y + (size_t)(2 * r + 1) * D);
    float4 v[8]; float ss = 0.f;
#pragma unroll
    for (int i = 0; i < 8; ++i) { const u32x2 hv = src[i * 64 + lane]; v[i].x = __uint_as_float(hv.x << 16); v[i].y = __uint_as_float(hv.x & 0xffff0000u); v[i].z = __uint_as_float(hv.y << 16); v[i].w = __uint_as_float(hv.y & 0xffff0000u);
      const u32x2 a = y0[i * 64 + lane], b = y1[i * 64 + lane];
      v[i].x += __uint_as_float(a.x << 16) + __uint_as_float(b.x << 16); v[i].y += __uint_as_float(a.x & 0xffff0000u) + __uint_as_float(b.x & 0xffff0000u);
      v[i].z += __uint_as_float(a.y << 16) + __uint_as_float(b.y << 16); v[i].w += __uint_as_float(a.y & 0xffff0000u) + __uint_as_float(b.y & 0xffff0000u);
      ss += v[i].x * v[i].x + v[i].y * v[i].y + v[i].z * v[i].z + v[i].w * v[i].w; }
    ss = wave_sum(ss);
    const float rs = rsqrtf(ss * (1.f / D) + EPS);
#pragma unroll
    for (int i = 0; i < 8; ++i) { const float4 gg = ((const float4*)p.final_g)[i * 64 + lane];
      float4 o; o.x = v[i].x * rs * gg.x; o.y = v[i].y * rs * gg.y; o.z = v[i].z * rs * gg.z; o.w = v[i].w * rs * gg.w;
      ((float4*)(p.out + (size_t)r * D))[i * 64 + lane] = o; }
  }
}

namespace pg8 {
#define PG8_LAS __attribute__((address_space(3)))
typedef unsigned short bf16_t;
typedef short bf16x8 __attribute__((ext_vector_type(8)));
typedef float f32x4 __attribute__((ext_vector_type(4)));
constexpr int BM = 256, BK = 64, HALF = 128, HTB = HALF * BK * 2, STAGE_BYTES = 8 * HTB;
__device__ __forceinline__ int lds_byte(int r, int c) { const int st = (r >> 4) * 2 + (c >> 5), rr = r & 15, cc = c & 31, ob = rr * 64 + cc * 2; return st * 1024 + (ob ^ (((ob >> 9) & 1) << 5)); }
__device__ __forceinline__ void stage_rc(int b, int& R, int& C) { const int st = b / 1024, sb = b % 1024, swz = sb ^ (((sb >> 9) & 1) << 5); R = (st >> 1) * 16 + swz / 64; C = (st & 1) * 32 + (swz % 64) / 2; }
__device__ __forceinline__ int perm32(int rho) { const int n = rho >> 4, i = rho & 15; return 8 * (i >> 2) + 4 * n + (i & 3); }
struct Unit { int pm, pn; };
struct Gemm { const bf16_t* A; const bf16_t* Bt; int M, N, K; };
struct ColMajorOrder { int nM, nwg, G, c;
  __device__ __forceinline__ bool next(int i, Unit& u) const { const int L = i * G + c; if (L >= nwg) return false; u.pm = L % nM; u.pn = L / nM; return true; }
  __device__ __forceinline__ void a_ready(const Unit&) const {}
  __device__ __forceinline__ void done(const Unit&) const {} };
template <class Epi, class Sched, bool ALIGN_EPI = false, bool SP2 = false>
__device__ __forceinline__ void gemm_phase(PG8_LAS unsigned char* lds, const Gemm g, const Sched& S, const Epi& E) {
    const int tid = threadIdx.x, wid = __builtin_amdgcn_readfirstlane(tid >> 6), lane = tid & 63, wr = wid >> 2, wc = wid & 3, fr = lane & 15, fq = lane >> 4;
    const int K = g.K, nt = K / BK;
    unsigned voffA[2], voffB[2];
#pragma unroll
    for (int i = 0; i < 2; ++i) { int R, C; stage_rc(tid * 16 + i * 8192, R, C); const int Rb = Epi::PERM ? ((R & ~31) + perm32(R & 31)) : R;
        voffA[i] = (unsigned)(R * K + C) * 2u; voffB[i] = (unsigned)(Rb * K + C) * 2u; }
    const size_t kstep = (size_t)(BK * 2);
    const size_t hstep = (size_t)HALF * K * 2;
    const size_t tstep = 2 * hstep;
    const unsigned ldsw = (unsigned)wid * 1024u;
    const int aoff = lds_byte(wr * 64 + fr, fq * 8), boff = lds_byte(wc * 32 + fr, fq * 8);
#define PG8_SA(b, h) (((b) * 2 + (h)) * HTB)
#define PG8_SB(b, h) ((4 + (b) * 2 + (h)) * HTB)
#define PG8_STAGE(bufoff, gbase, voff) do { _Pragma("unroll") for (int _i = 0; _i < 2; ++_i) \
        __builtin_amdgcn_global_load_lds((const unsigned*)((const char*)(gbase) + (voff)[_i]), (PG8_LAS unsigned*)(lds + (bufoff) + ldsw + _i * 8192), 16, 0, 0); } while (0)
#define PG8_LDA(dst, b, h) do { _Pragma("unroll") for (int m = 0; m < 4; ++m) _Pragma("unroll") for (int k = 0; k < 2; ++k) dst[m][k] = *(const PG8_LAS bf16x8*)(lds + PG8_SA(b, h) + aoff + m * 2048 + k * 1024); } while (0)
#define PG8_LDB(dst, b, h) do { _Pragma("unroll") for (int n = 0; n < 2; ++n) _Pragma("unroll") for (int k = 0; k < 2; ++k) dst[n][k] = *(const PG8_LAS bf16x8*)(lds + PG8_SB(b, h) + boff + n * 2048 + k * 1024); } while (0)
#define PG8_MMA(ai, bj, At, Bt) do { __builtin_amdgcn_s_setprio(1); _Pragma("unroll") for (int m = 0; m < 4; ++m) _Pragma("unroll") for (int n = 0; n < 2; ++n) _Pragma("unroll") for (int k = 0; k < 2; ++k) \
        acc[ai][bj][m][n] = __builtin_amdgcn_mfma_f32_16x16x32_bf16(Bt[n][k], At[m][k], acc[ai][bj][m][n], 0, 0, 0); __builtin_amdgcn_s_setprio(0); } while (0)
#define PG8_WAIT_V(n) asm volatile("s_waitcnt vmcnt(" #n ")" ::: "memory")
#define PG8_WAIT_L(n) asm volatile("s_waitcnt lgkmcnt(" #n ")" ::: "memory")
#define PG8_BAR __builtin_amdgcn_s_barrier()
#define PG8_SCHED __builtin_amdgcn_sched_barrier(0)
    Unit cur, nxt; int ui = 0;
    if (!S.next(0, cur)) return;
    f32x4 acc[2][2][4][2];
#pragma unroll
    for (int a = 0; a < 2; ++a)
#pragma unroll
        for (int b = 0; b < 2; ++b)
#pragma unroll
            for (int m = 0; m < 4; ++m)
#pragma unroll
                for (int n = 0; n < 2; ++n) acc[a][b][m][n] = (f32x4){0.f, 0.f, 0.f, 0.f};
    bf16x8 At[4][2], B0[2][2], B1[2][2];
    const char* cA = (const char*)g.A + (size_t)cur.pm * tstep; const char* cB = (const char*)g.Bt + (size_t)cur.pn * tstep;
    S.a_ready(cur);
    if constexpr (SP2) {
        PG8_STAGE(PG8_SB(0, 0), cB, voffB); PG8_STAGE(PG8_SB(0, 1), cB + hstep, voffB); PG8_STAGE(PG8_SA(0, 0), cA, voffA); PG8_STAGE(PG8_SA(0, 1), cA + hstep, voffA);
        if (wr == 1) PG8_BAR;
        PG8_WAIT_V(2); PG8_BAR;
        PG8_STAGE(PG8_SB(1, 0), cB + kstep, voffB); PG8_STAGE(PG8_SA(1, 0), cA + kstep, voffA); PG8_STAGE(PG8_SB(1, 1), cB + hstep + kstep, voffB);
        PG8_WAIT_V(6); PG8_BAR;
    } else {
        PG8_STAGE(PG8_SB(0, 0), cB, voffB); PG8_STAGE(PG8_SA(0, 0), cA, voffA); PG8_STAGE(PG8_SB(0, 1), cB + hstep, voffB); PG8_STAGE(PG8_SA(0, 1), cA + hstep, voffA);
        if (wr == 1) PG8_BAR;
        PG8_WAIT_V(4); PG8_BAR;
        PG8_STAGE(PG8_SB(1, 0), cB + kstep, voffB); PG8_STAGE(PG8_SA(1, 0), cA + kstep, voffA); PG8_STAGE(PG8_SB(1, 1), cB + hstep + kstep, voffB);
        PG8_WAIT_V(6); PG8_BAR;
    }
    for (;;) {
        const bool has_next = S.next(ui + 1, nxt);
        const char* nA = has_next ? (const char*)g.A + (size_t)nxt.pm * tstep : cA; const char* nB = has_next ? (const char*)g.Bt + (size_t)nxt.pn * tstep : cB;
        for (int t = 0; t < nt; t += 2) {
            const bool last = (t == nt - 2);
            const char* a1 = cA + (size_t)(t + 1) * kstep;
            const char* a2 = last ? nA : cA + (size_t)(t + 2) * kstep; const char* b2 = last ? nB : cB + (size_t)(t + 2) * kstep;
            const char* a3 = a2 + kstep; const char* b3 = b2 + kstep;
            if (last && has_next) S.a_ready(nxt);
            if constexpr (SP2) {
            PG8_LDB(B0, 0, 0); PG8_LDB(B1, 0, 1); PG8_SCHED; PG8_LDA(At, 0, 0); PG8_STAGE(PG8_SA(1, 1), a1 + hstep, voffA);
            PG8_WAIT_V(8); PG8_WAIT_L(0); PG8_BAR; PG8_MMA(0, 0, At, B0); PG8_MMA(0, 1, At, B1); PG8_BAR; PG8_SCHED;
            PG8_LDA(At, 0, 1); PG8_STAGE(PG8_SB(0, 0), b2, voffB); PG8_STAGE(PG8_SB(0, 1), b2 + hstep, voffB); PG8_STAGE(PG8_SA(0, 0), a2, voffA);
            PG8_WAIT_V(8); PG8_WAIT_L(0); PG8_BAR; PG8_MMA(1, 0, At, B0); PG8_MMA(1, 1, At, B1); PG8_BAR; PG8_SCHED;
            PG8_LDB(B0, 1, 0); PG8_LDB(B1, 1, 1); PG8_SCHED; PG8_LDA(At, 1, 0); PG8_STAGE(PG8_SA(0, 1), a2 + hstep, voffA);
            PG8_WAIT_V(8); PG8_WAIT_L(0); PG8_BAR; PG8_MMA(0, 0, At, B0); PG8_MMA(0, 1, At, B1); PG8_BAR; PG8_SCHED;
            PG8_LDA(At, 1, 1); PG8_STAGE(PG8_SB(1, 0), b3, voffB); PG8_STAGE(PG8_SB(1, 1), b3 + hstep, voffB); PG8_STAGE(PG8_SA(1, 0), a3, voffA);
            PG8_WAIT_V(8); PG8_WAIT_L(0); PG8_BAR; PG8_MMA(1, 0, At, B0); PG8_MMA(1, 1, At, B1); PG8_BAR; PG8_SCHED;
            } else {
            PG8_LDB(B0, 0, 0); PG8_SCHED; PG8_LDA(At, 0, 0); PG8_STAGE(PG8_SA(1, 1), a1 + hstep, voffA);
            PG8_WAIT_L(8); PG8_BAR; PG8_WAIT_L(0); PG8_MMA(0, 0, At, B0); PG8_BAR; PG8_SCHED;
            PG8_LDB(B1, 0, 1); PG8_STAGE(PG8_SB(0, 0), b2, voffB);
            PG8_BAR; PG8_WAIT_L(0); PG8_MMA(0, 1, At, B1); PG8_BAR;
            PG8_LDA(At, 0, 1); PG8_STAGE(PG8_SA(0, 0), a2, voffA);
            PG8_BAR; PG8_WAIT_L(0); PG8_MMA(1, 0, At, B0); PG8_BAR; PG8_SCHED;
            PG8_STAGE(PG8_SB(0, 1), b2 + hstep, voffB);
            PG8_WAIT_V(6); PG8_BAR; PG8_MMA(1, 1, At, B1); PG8_BAR;
            PG8_LDB(B0, 1, 0); PG8_SCHED; PG8_LDA(At, 1, 0); PG8_STAGE(PG8_SA(0, 1), a2 + hstep, voffA);
            PG8_WAIT_L(8); PG8_BAR; PG8_WAIT_L(0); PG8_MMA(0, 0, At, B0); PG8_BAR; PG8_SCHED;
            PG8_LDB(B1, 1, 1); PG8_STAGE(PG8_SB(1, 0), b3, voffB);
            PG8_BAR; PG8_WAIT_L(0); PG8_MMA(0, 1, At, B1); PG8_BAR;
            PG8_LDA(At, 1, 1); PG8_STAGE(PG8_SA(1, 0), a3, voffA);
            PG8_BAR; PG8_WAIT_L(0); PG8_MMA(1, 0, At, B0); PG8_BAR; PG8_SCHED;
            PG8_STAGE(PG8_SB(1, 1), b3 + hstep, voffB);
            PG8_WAIT_V(6); PG8_BAR; PG8_MMA(1, 1, At, B1); PG8_BAR;
            }
        }
        if constexpr (ALIGN_EPI) { if (wr == 0) PG8_BAR; }
        if constexpr (!Epi::AFTER_DRAIN) { E(acc, cur, wr, wc, fr, fq); S.done(cur); }
        if (!has_next) break;
#pragma unroll
        for (int a = 0; a < 2; ++a)
#pragma unroll
            for (int b = 0; b < 2; ++b)
#pragma unroll
                for (int m = 0; m < 4; ++m)
#pragma unroll
                    for (int n = 0; n < 2; ++n) acc[a][b][m][n] = (f32x4){0.f, 0.f, 0.f, 0.f};
        cur = nxt; cA = nA; cB = nB; ++ui;
        if constexpr (ALIGN_EPI) { if (wr == 1) PG8_BAR; }
    }
    PG8_WAIT_V(0);
    if constexpr (!ALIGN_EPI) { if (wr == 0) PG8_BAR; }
    PG8_BAR;
    if constexpr (Epi::AFTER_DRAIN) { E.fused(acc, cur, wr, wc, fr, fq, lds, wid, lane); S.done(cur); }
#undef PG8_SA
#undef PG8_SB
#undef PG8_STAGE
#undef PG8_LDA
#undef PG8_LDB
#undef PG8_MMA
#undef PG8_WAIT_V
#undef PG8_WAIT_L
#undef PG8_BAR
#undef PG8_SCHED
}
}

#define EPI_DRAIN() asm volatile("s_waitcnt vmcnt(0)" ::: "memory")
struct Epi1 {
  static constexpr bool PERM = false, AFTER_DRAIN = false; P p;
  __device__ __forceinline__ void operator()(const f32x4 (&acc)[2][2][4][2], const pg8::Unit& u, int wr, int wc, int fr, int fq) const {
    const int pn = u.pn;
    if (pn <= 4) {
      bf16_t* dst; int ld, c0; float* ssq; int sst;
      if (pn < 3) { dst = p.qlat; ld = QL; c0 = pn * 256; ssq = p.ssq_q + pn * 4 + wc; sst = 12; } else { dst = p.kvlat; ld = KVL; c0 = (pn - 3) * 256; ssq = p.ssq_kv + (pn - 3) * 4 + wc; sst = 8; }
#pragma unroll
      for (int ai = 0; ai < 2; ++ai)
#pragma unroll
        for (int m = 0; m < 4; ++m) { const int row = u.pm * 256 + ai * 128 + wr * 64 + m * 16 + fr; float s = 0.f;
#pragma unroll
          for (int bj = 0; bj < 2; ++bj)
#pragma unroll
            for (int n = 0; n < 2; ++n) { const f32x4 a = acc[ai][bj][m][n]; s += a[0] * a[0] + a[1] * a[1] + a[2] * a[2] + a[3] * a[3];
              u32x2 w; w.x = pk_bf16(a[0], a[1]); w.y = pk_bf16(a[2], a[3]); *(u32x2*)(dst + (size_t)row * ld + c0 + bj * 128 + wc * 32 + n * 16 + fq * 4) = w; }
          s += __shfl_xor(s, 16); s += __shfl_xor(s, 32);
          if (fq == 0) ssq[(size_t)row * sst] = s; }
    } else if (pn <= 12) {
#pragma unroll
      for (int n = 0; n < 2; ++n) { const int ch = (pn - 5) * 128 + wc * 32 + n * 16 + fq * 4; const float4 ba = *(const float4*)(p.b_glu + ch), bg = *(const float4*)(p.b_glu + 1024 + ch);
#pragma unroll
        for (int ai = 0; ai < 2; ++ai)
#pragma unroll
          for (int m = 0; m < 4; ++m) { const int row = u.pm * 256 + ai * 128 + wr * 64 + m * 16 + fr; const f32x4 a = acc[ai][0][m][n], g = acc[ai][1][m][n];
            u32x2 w; w.x = pk_bf16((a[0] + ba.x) * sigmoidf_(g[0] + bg.x), (a[1] + ba.y) * sigmoidf_(g[1] + bg.y));
            w.y = pk_bf16((a[2] + ba.z) * sigmoidf_(g[2] + bg.z), (a[3] + ba.w) * sigmoidf_(g[3] + bg.w));
            *(u32x2*)(p.cglu + (size_t)row * CC + ch) = w; } }
    } else if (wc == 0) {
#pragma unroll
      for (int ai = 0; ai < 2; ++ai)
#pragma unroll
        for (int m = 0; m < 4; ++m) { const int row = u.pm * 256 + ai * 128 + wr * 64 + m * 16 + fr; const int pos = row & (S - 1);
#pragma unroll
          for (int n = 0; n < 2; ++n) { const int j = n * 16 + fq * 4; const f32x4 x1 = acc[ai][0][m][n], x2 = acc[ai][1][m][n];
            const float4 cs0 = *(const float4*)(p.ropetab + (pos * 32 + j) * 2), cs1 = *(const float4*)(p.ropetab + (pos * 32 + j) * 2 + 4);
            u32x2 lo, hi;
            lo.x = pk_bf16(x1[0] * cs0.x - x2[0] * cs0.y, x1[1] * cs0.z - x2[1] * cs0.w); lo.y = pk_bf16(x1[2] * cs1.x - x2[2] * cs1.y, x1[3] * cs1.z - x2[3] * cs1.w);
            hi.x = pk_bf16(x2[0] * cs0.x + x1[0] * cs0.y, x2[1] * cs0.z + x1[1] * cs0.w); hi.y = pk_bf16(x2[2] * cs1.x + x1[2] * cs1.y, x2[3] * cs1.z + x1[3] * cs1.w);
            *(u32x2*)(p.krope + (size_t)row * RD + j) = lo; *(u32x2*)(p.krope + (size_t)row * RD + 32 + j) = hi; } }
    }
    EPI_DRAIN();
  }
};
struct Epi2q {
  static constexpr bool PERM = false, AFTER_DRAIN = false; P p;
  __device__ __forceinline__ void operator()(const f32x4 (&acc)[2][2][4][2], const pg8::Unit& u, int wr, int wc, int fr, int fq) const {
    const int pn = u.pn;
#pragma unroll
    for (int ai = 0; ai < 2; ++ai)
#pragma unroll
      for (int m = 0; m < 4; ++m) { const int row = u.pm * 256 + ai * 128 + wr * 64 + m * 16 + fr;
        float sq = 0.f;
#pragma unroll
        for (int i = 0; i < 12; i += 4) { const float4 v = *(const float4*)(p.ssq_q + (size_t)row * 12 + i); sq += v.x + v.y + v.z + v.w; }
        const float rs = rsqrtf(sq * (1.f / QL) + EPS);
        if (pn < 4) {
#pragma unroll
          for (int bj = 0; bj < 2; ++bj)
#pragma unroll
            for (int n = 0; n < 2; ++n) { const f32x4 a = acc[ai][bj][m][n]; u32x2 w; w.x = pk_bf16(a[0] * rs, a[1] * rs); w.y = pk_bf16(a[2] * rs, a[3] * rs);
              *(u32x2*)(p.q + (size_t)row * QW + (2 * pn + bj) * 192 + wc * 32 + n * 16 + fq * 4) = w; }
        } else { const int pos = row & (S - 1); bf16_t* dst = p.q + (size_t)row * QW + ((pn - 4) * 4 + wc) * 192 + 128;
#pragma unroll
          for (int n = 0; n < 2; ++n) { const int j = n * 16 + fq * 4; const f32x4 x1 = acc[ai][0][m][n] * rs, x2 = acc[ai][1][m][n] * rs;
            const float4 cs0 = *(const float4*)(p.ropetab + (pos * 32 + j) * 2), cs1 = *(const float4*)(p.ropetab + (pos * 32 + j) * 2 + 4);
            u32x2 lo, hi;
            lo.x = pk_bf16(x1[0] * cs0.x - x2[0] * cs0.y, x1[1] * cs0.z - x2[1] * cs0.w); lo.y = pk_bf16(x1[2] * cs1.x - x2[2] * cs1.y, x1[3] * cs1.z - x2[3] * cs1.w);
            hi.x = pk_bf16(x2[0] * cs0.x + x1[0] * cs0.y, x2[1] * cs0.z + x1[1] * cs0.w); hi.y = pk_bf16(x2[2] * cs1.x + x1[2] * cs1.y, x2[3] * cs1.z + x1[3] * cs1.w);
            *(u32x2*)(dst + j) = lo; *(u32x2*)(dst + 32 + j) = hi; } }
      }
    EPI_DRAIN();
  }
};
struct Epi2kv {
  static constexpr bool PERM = false, AFTER_DRAIN = false; P p;
  __device__ __forceinline__ void operator()(const f32x4 (&acc)[2][2][4][2], const pg8::Unit& u, int wr, int wc, int fr, int fq) const {
#pragma unroll
    for (int ai = 0; ai < 2; ++ai)
#pragma unroll
      for (int m = 0; m < 4; ++m) { const int row = u.pm * 256 + ai * 128 + wr * 64 + m * 16 + fr;
        const float4 v0 = *(const float4*)(p.ssq_kv + (size_t)row * 8), v1 = *(const float4*)(p.ssq_kv + (size_t)row * 8 + 4);
        const float rs = rsqrtf((v0.x + v0.y + v0.z + v0.w + v1.x + v1.y + v1.z + v1.w) * (1.f / KVL) + EPS);
#pragma unroll
        for (int bj = 0; bj < 2; ++bj)
#pragma unroll
          for (int n = 0; n < 2; ++n) { const f32x4 a = acc[ai][bj][m][n]; u32x2 w; w.x = pk_bf16(a[0] * rs, a[1] * rs); w.y = pk_bf16(a[2] * rs, a[3] * rs);
            *(u32x2*)(p.kv + (size_t)row * KVW + u.pn * 256 + bj * 128 + wc * 32 + n * 16 + fq * 4) = w; } }
    EPI_DRAIN();
  }
};
struct Epi3 {
  static constexpr bool PERM = true, AFTER_DRAIN = false; P p;
  __device__ __forceinline__ void operator()(const f32x4 (&acc)[2][2][4][2], const pg8::Unit& u, int wr, int wc, int fr, int fq) const {
    float4 g2[2][2];
#pragma unroll
    for (int bj = 0; bj < 2; ++bj)
#pragma unroll
      for (int n = 0; n < 2; ++n) g2[bj][n] = *(const float4*)(p.ln2_g + u.pn * 256 + bj * 128 + wc * 32 + fq * 8 + n * 4);
#pragma unroll
    for (int ai = 0; ai < 2; ++ai)
#pragma unroll
      for (int m = 0; m < 4; ++m) { const int row = u.pm * 256 + ai * 128 + wr * 64 + m * 16 + fr; float s = 0.f;
#pragma unroll
        for (int bj = 0; bj < 2; ++bj) { const size_t o_ = (size_t)row * D + u.pn * 256 + bj * 128 + wc * 32 + fq * 8;
          const float4 x0 = *(const float4*)(p.x + o_), x1 = *(const float4*)(p.x + o_ + 4); const f32x4 a0 = acc[ai][bj][m][0], a1 = acc[ai][bj][m][1];
          const float h0 = x0.x + a0[0], h1 = x0.y + a0[1], h2 = x0.z + a0[2], h3 = x0.w + a0[3], h4 = x1.x + a1[0], h5 = x1.y + a1[1], h6 = x1.z + a1[2], h7 = x1.w + a1[3];
          s += (h0 * h0 + h1 * h1) + (h2 * h2 + h3 * h3) + (h4 * h4 + h5 * h5) + (h6 * h6 + h7 * h7);
          *(u32x4*)(p.h16 + o_) = (u32x4){pk_bf16(h0, h1), pk_bf16(h2, h3), pk_bf16(h4, h5), pk_bf16(h6, h7)};
          const float4 ga = g2[bj][0], gb = g2[bj][1];
          *(u32x4*)(p.hn + o_) = (u32x4){pk_bf16(h0 * ga.x, h1 * ga.y), pk_bf16(h2 * ga.z, h3 * ga.w), pk_bf16(h4 * gb.x, h5 * gb.y), pk_bf16(h6 * gb.z, h7 * gb.w)}; }
        s += __shfl_xor(s, 16); s += __shfl_xor(s, 32);
        if (fq == 0) p.ssq_h[(size_t)row * 32 + u.pn * 4 + wc] = s; }
    EPI_DRAIN();
  }
};
__device__ __forceinline__ void phase_gemm1_pg8(const P& p, ldsp lds, int bid, int nb) {
  pg8::Gemm g; g.A = p.xn; g.Bt = p.WinT; g.M = T; g.N = NP1; g.K = D;
  pg8::ColMajorOrder S_; S_.nM = T / 256; S_.nwg = (T / 256) * (NP1 / 256); S_.G = nb; S_.c = bid;
  Epi1 E; E.p = p; pg8::gemm_phase<Epi1, pg8::ColMajorOrder, true, true>(lds, g, S_, E);
}
__device__ __forceinline__ void phase_gemm2_pg8(const P& p, ldsp lds, int bid, int nb) {
  { pg8::Gemm g; g.A = p.qlat; g.Bt = p.WuqT; g.M = T; g.N = QW; g.K = QL;
    pg8::ColMajorOrder S_; S_.nM = T / 256; S_.nwg = (T / 256) * (QW / 256); S_.G = nb; S_.c = bid;
    Epi2q E; E.p = p; pg8::gemm_phase<Epi2q, pg8::ColMajorOrder, true, true>(lds, g, S_, E); }
  { pg8::Gemm g; g.A = p.kvlat; g.Bt = p.WukvT; g.M = T; g.N = KVW; g.K = KVL;
    pg8::ColMajorOrder S_; S_.nM = T / 256; S_.nwg = (T / 256) * (KVW / 256); S_.G = nb; S_.c = (bid + 192) % nb;
    Epi2kv E; E.p = p; pg8::gemm_phase<Epi2kv, pg8::ColMajorOrder, true, true>(lds, g, S_, E); }
}
__device__ __forceinline__ void phase_gemm3_pg8(const P& p, ldsp lds, int bid, int nb) {
  pg8::Gemm g; g.A = p.mix; g.Bt = p.WoT; g.M = T; g.N = D; g.K = D;
  pg8::ColMajorOrder S_; S_.nM = T / 256; S_.nwg = (T / 256) * (D / 256); S_.G = nb; S_.c = bid;
  Epi3 E; E.p = p; pg8::gemm_phase<Epi3, pg8::ColMajorOrder, true, true>(lds, g, S_, E);
}
#define XB_TMO      128
#define XB_XCNT(j)  (256  + 64 * (j))
#define XB_XSUB(j)  (1280 + 64 * (j))
#define XB_XGEN(j)  (2304 + 64 * (j))
#define XB_TOP      3328
#define XB_TOPGEN   3392
#define XCD_BAR_WORDS 3456
#define XB_SPIN_CAP (1u << 20)
__device__ __forceinline__ unsigned xb_ld(unsigned* p)              { return __hip_atomic_load(p, __ATOMIC_RELAXED, __HIP_MEMORY_SCOPE_AGENT); }
__device__ __forceinline__ unsigned xb_add(unsigned* p, unsigned v) { return __hip_atomic_fetch_add(p, v, __ATOMIC_RELAXED, __HIP_MEMORY_SCOPE_AGENT); }
__device__ __forceinline__ unsigned xb_xcc_id() { return (unsigned)__builtin_amdgcn_s_getreg((3 << 11) | 20) & 0xFu; }
#define XB_SPIN(cond, bar) do { unsigned _sp = 0; while (cond) { __builtin_amdgcn_s_sleep(1); \
    if ((++_sp & 255u) == 0u) { if (xb_ld(&(bar)[XB_TMO])) break; if (_sp > XB_SPIN_CAP) { atomicAdd(&(bar)[XB_TMO], 1u); break; } } } } while (0)
struct XcdBarrier { unsigned* bar; unsigned x; volatile LAS unsigned* st; };
__device__ __forceinline__ XcdBarrier xcd_barrier_post(unsigned* bar, volatile LAS unsigned* st) {
  XcdBarrier b; b.bar = bar; b.x = xb_xcc_id(); b.st = st;
  if (threadIdx.x == 0) (void)xb_add(&bar[XB_XCNT(b.x)], 1u);
  return b;
}
__device__ __forceinline__ void xcd_barrier_complete(unsigned* bar, unsigned x, unsigned& nloc, unsigned& nx) {
  const unsigned G = gridDim.x * gridDim.y * gridDim.z;
  unsigned sum, cnt, mine, sp = 0u;
  for (;;) {
    sum = 0u; cnt = 0u; mine = 0u;
#pragma unroll
    for (unsigned j = 0; j < 16; ++j) { const unsigned c = xb_ld(&bar[XB_XCNT(j)]); sum += c; cnt += (c > 0u) ? 1u : 0u; mine = (j == x) ? c : mine; }
    if (sum == G) break;
    __builtin_amdgcn_s_sleep(1);
    if ((++sp & 255u) == 0u) { if (xb_ld(&bar[XB_TMO])) break; if (sp > XB_SPIN_CAP) { atomicAdd(&bar[XB_TMO], 1u); break; } }
  }
  nloc = mine > 0u ? mine : 1u; nx = cnt > 0u ? cnt : 1u;
}
__device__ __forceinline__ void xcd_barrier(const XcdBarrier& b) {
  asm volatile("s_waitcnt vmcnt(0)" ::: "memory");
  __syncthreads();
  if (threadIdx.x == 0) {
    unsigned* bar = b.bar;
    __builtin_amdgcn_s_waitcnt(0);
    unsigned nloc = b.st[0], nx = b.st[1];
    if (nloc == 0u) { xcd_barrier_complete(bar, b.x, nloc, nx); b.st[0] = nloc; b.st[1] = nx; }
    const unsigned old = xb_add(&bar[XB_XSUB(b.x)], 1u);
    const unsigned gen = old / nloc;
    if (old + 1u == (gen + 1u) * nloc) {
      __builtin_amdgcn_fence(__ATOMIC_RELEASE, "agent");
      asm volatile("s_waitcnt vmcnt(0)" ::: "memory");
      const unsigned og = xb_add(&bar[XB_TOP], 1u);
      const unsigned tg = og / nx;
      if (og + 1u == (tg + 1u) * nx) xb_add(&bar[XB_TOPGEN], 1u);
      else XB_SPIN(xb_ld(&bar[XB_TOPGEN]) == tg, bar);
      __builtin_amdgcn_fence(__ATOMIC_ACQUIRE, "agent");
      xb_add(&bar[XB_XGEN(b.x)], 1u);
      asm volatile("s_waitcnt vmcnt(0)" ::: "memory");
    } else {
      XB_SPIN(xb_ld(&bar[XB_XGEN(b.x)]) == gen, bar);
      __builtin_amdgcn_fence(__ATOMIC_ACQUIRE, "agent");
      asm volatile("s_waitcnt vmcnt(0)" ::: "memory");
    }
  }
  __syncthreads();
}

__global__ __launch_bounds__(NTHR, 2) void mega_fwd(P p) {
  extern __shared__ __attribute__((aligned(16))) unsigned char smem[];
  ldsp lds = (ldsp)smem;
  volatile LAS unsigned* st = (volatile LAS unsigned*)(lds + LDS_BYTES - 16);
  if (threadIdx.x == 0) { st[0] = 0u; st[1] = 0u; st[2] = 0u; st[3] = 0u; }
  __syncthreads();
  const XcdBarrier bar = xcd_barrier_post(p.bar, st);
  const int bid = blockIdx.x, nb = gridDim.x;
  phase_prep(p, lds, bid, nb); rmsnorm_rows_dev(p.x, p.ln1_g, p.xn, bid, nb);
  xcd_barrier(bar);
  phase_gemm1_pg8(p, lds, bid, nb);
  xcd_barrier(bar);
  phase_gemm2_pg8(p, lds, bid, nb); phase_conv(p, lds, bid, nb);
  xcd_barrier(bar);
  phase_attn(p, lds, bid, nb);
  xcd_barrier(bar);
  phase_gemm3_pg8(p, lds, bid, nb);
  xcd_barrier(bar);
  phase_route2(p, lds, bid, nb);
  xcd_barrier(bar);
  moe_stream<0>(p, lds, bid, nb);
  moe_stream<1>(p, lds, bid, nb);
  xcd_barrier(bar);
  phase_final(p, bid, nb);
}

static size_t carve(size_t& off, size_t bytes) { const size_t o = off; off += (bytes + 255) & ~(size_t)255; return o; }

extern "C" void kernel_launch(void* const* d_in, const int* in_sizes, int n_in, void* d_out, int out_size, void* d_ws, size_t ws_size, hipStream_t stream) {
  P p{};
  const float** pin = (const float**)&p.x;
  for (int i = 0; i < 22; ++i) pin[i] = (const float*)d_in[i];
  p.out = (float*)d_out;
  char* ws = (char*)d_ws; size_t off = 0;
  p.cnt = (int*)(ws + carve(off, 4096));
  p.bar = (unsigned*)(ws + carve(off, XCD_BAR_WORDS * 4));
  p.moe_done = (unsigned*)(ws + carve(off, 1024));
  p.ssq_h = (float*)(ws + carve(off, (size_t)T * 32 * 4));
  p.rstd_h = (float*)(ws + carve(off, (size_t)T * 4));
  p.h16 = (bf16_t*)(ws + carve(off, (size_t)T * D * 2));
  p.xn = (bf16_t*)(ws + carve(off, (size_t)T * D * 2));
  p.qlat = (bf16_t*)(ws + carve(off, (size_t)T * QL * 2));
  p.kvlat = (bf16_t*)(ws + carve(off, (size_t)T * KVL * 2));
  p.krope = (bf16_t*)(ws + carve(off, (size_t)T * RD * 2));
  p.cglu = (bf16_t*)(ws + carve(off, (size_t)T * CC * 2));
  p.q = (bf16_t*)(ws + carve(off, (size_t)T * QW * 2));
  p.kv = (bf16_t*)(ws + carve(off, (size_t)T * KVW * 2));
  p.mix = (bf16_t*)(ws + carve(off, (size_t)T * D * 2));
  p.hn = (bf16_t*)(ws + carve(off, (size_t)T * D * 2));
  p.hb = (bf16_t*)(ws + carve(off, (size_t)MAXTILES * 256 * DE * 2));
  p.y = (bf16_t*)(ws + carve(off, (size_t)2 * T * D * 2));
  p.ssq_q = (float*)(ws + carve(off, (size_t)T * 12 * 4));
  p.ssq_kv = (float*)(ws + carve(off, (size_t)T * 8 * 4));
  p.h = (float*)(ws + carve(off, (size_t)T * D * 4));
  p.rlog = (float*)(ws + carve(off, (size_t)RSLABS * T * RLD * 4));
  p.convtmp = (float*)(ws + carve(off, (size_t)T * CC * 4));
  p.ropetab = (float*)(ws + carve(off, (size_t)S * 32 * 2 * 4));
  p.list_gate = (float*)(ws + carve(off, (size_t)NE * LCAP * 4));
  p.list_tok = (int*)(ws + carve(off, (size_t)NE * LCAP * 4));
  p.WinT = (bf16_t*)(ws + carve(off, (size_t)NP1 * D * 2));
  p.WuqT = (bf16_t*)(ws + carve(off, (size_t)QW * QL * 2));
  p.WukvT = (bf16_t*)(ws + carve(off, (size_t)KVW * KVL * 2));
  p.WoT = (bf16_t*)(ws + carve(off, (size_t)D * D * 2));
  p.WrT = (bf16_t*)(ws + carve(off, (size_t)256 * D * 2));
  if (off > ws_size) { fprintf(stderr, "kernel_launch: workspace too small (%zu > %zu)\n", off, ws_size); return; }

  static int grid = 0;
  if (grid == 0) {
    int dev = 0, cus = 0, per_cu = 0;
    (void)hipGetDevice(&dev); (void)hipDeviceGetAttribute(&cus, hipDeviceAttributeMultiprocessorCount, dev);
    (void)hipFuncSetAttribute((const void*)mega_fwd, hipFuncAttributeMaxDynamicSharedMemorySize, LDS_BYTES);
    if (hipOccupancyMaxActiveBlocksPerMultiprocessor(&per_cu, (const void*)mega_fwd, NTHR, LDS_BYTES) != hipSuccess || per_cu < 1) { fprintf(stderr, "kernel_launch: occupancy query failed (%d)\n", per_cu); per_cu = 1; }
    (void)hipGetLastError();
    grid = cus * per_cu;
    fprintf(stderr, "kernel_launch: %d CUs x %d = grid %d\n", cus, per_cu, grid);
  }
  (void)hipMemsetAsync(p.bar, 0, XCD_BAR_WORDS * 4, stream);
  mega_fwd<<<grid, NTHR, LDS_BYTES, stream>>>(p);
}
```

```cpp
#include <hip/hip_runtime.h>
#include <cstdint>
#include <cstdio>
#include <type_traits>

typedef unsigned short bf16_t;

constexpr int T = 8192, D = 2048, S = 2048, NB = 4, H = 8;
constexpr int QL = 768, KVL = 512, RD = 64, CC = 1024, INC = 3392;
constexpr int QW = 1536  , KVW = 2048  ;
constexpr int NE = 64, DE = 512, NG = 8, EPG = 8, NRL = 72  ;
constexpr int CW = 31;
constexpr float EPS = 1e-6f;
constexpr int RSLABS = 8, RLD = 128;
constexpr int LCAP = T;
constexpr int MAXTILES = 128;

__device__ __forceinline__ float bf2f(bf16_t v) { return __uint_as_float(((unsigned)v) << 16); }
__device__ __forceinline__ bf16_t f2bf(float f) { unsigned u = __float_as_uint(f); u += 0x7fffu + ((u >> 16) & 1u); return (bf16_t)(u >> 16); }
__device__ __forceinline__ float sigmoidf_(float x) { return __builtin_amdgcn_rcpf(1.f + __builtin_amdgcn_exp2f(-1.4426950408889634f * x)); }
__device__ __forceinline__ float siluf_(float x) { return x * sigmoidf_(x); }

struct P {
  const float *x, *ln1_g, *w_in, *b_glu, *q_norm_g, *w_uq, *kv_norm_g, *w_ukv, *w_dw, *b_dw, *conv_ln_g, *conv_ln_b, *w_o, *ln2_g,
      *w_group, *b_group, *w_router, *b_router, *w_gate, *w_up, *w_down, *final_g;
  float* out;
  bf16_t *xn, *qlat, *kvlat, *krope, *cglu, *q, *kv, *mix, *hn, *hb, *y;
  float *ssq_q, *ssq_kv, *h, *rlog, *convtmp, *ropetab, *list_gate;
  int *cnt, *list_tok;
  bf16_t *WinT, *WuqT, *WukvT, *WoT, *WrT;
  unsigned* bar;
  unsigned* moe_done;
  float *ssq_h, *rstd_h;
  bf16_t* h16;
};

__device__ __forceinline__ float wave_sum(float v) {
#pragma unroll
  for (int o = 32; o > 0; o >>= 1) v += __shfl_xor(v, o);
  return v;
}
#define LAS __attribute__((address_space(3)))
typedef LAS unsigned char* ldsp;
typedef short bf16x8 __attribute__((ext_vector_type(8)));
typedef short s16x4 __attribute__((ext_vector_type(4)));
typedef float f32x4 __attribute__((ext_vector_type(4)));
typedef unsigned u32x2 __attribute__((ext_vector_type(2)));
typedef unsigned u32x4 __attribute__((ext_vector_type(4)));
constexpr int NTHR = 512, BM = 256, BK = 64, TILE_B = BM * BK * 2, STAGE_B = 2 * TILE_B, LDS_BYTES = 150528;
constexpr int NP1 = 3584;

__device__ __forceinline__ unsigned pk_bf16(float lo, float hi) { unsigned r; asm("v_cvt_pk_bf16_f32 %0, %1, %2" : "=v"(r) : "v"(lo), "v"(hi)); return r; }
__device__ __forceinline__ int lds_byte(int r, int c) { const int st = (r >> 4) * 2 + (c >> 5), ob = (r & 15) * 64 + (c & 31) * 2; return st * 1024 + (ob ^ (((ob >> 9) & 1) << 5)); }
__device__ __forceinline__ void stage_rc(int b, int& R, int& C) { const int st = b >> 10, sb = b & 1023, swz = sb ^ (((sb >> 9) & 1) << 5); R = (st >> 1) * 16 + swz / 64; C = (st & 1) * 32 + (swz % 64) / 2; }
__device__ __forceinline__ int trf(int k) { return ((k & 3) << 2) | ((k >> 2) & 3); }
__device__ __forceinline__ int tr_byte(int k, int n) { return (n >> 7) * 16384 + 256 * k + 16 * ((((n & 127) >> 3)) ^ trf(k)) + (n & 7) * 2; }

struct ColSrc { const float* src; int ld; int c; };
template <int WHICH> __device__ __forceinline__ ColSrc colmap(const P& p, int q) {
  ColSrc r; r.src = nullptr; r.ld = 0; r.c = -1;
  if (WHICH == 0) { r.src = p.w_in; r.ld = INC;
    if (q < 1280) r.c = q;
    else if (q < 3328) { const int pl = q - 1280, t = pl >> 8, j = pl & 255; r.c = 1344 + (j >> 7) * 1024 + t * 128 + (j & 127); }
    else { const int j = q - 3328; if (j < 32) r.c = 1280 + j; else if (j >= 128 && j < 160) r.c = 1280 + 32 + (j - 128); } }
  else if (WHICH == 1) { r.src = p.w_uq; r.ld = QW;
    if (q < 1024) { const int t = q >> 8, j = q & 255; r.c = (2 * t + (j >> 7)) * 192 + (j & 127); }
    else { const int t = (q - 1024) >> 8, j = q & 255, bj = j >> 7, wcc = (j >> 5) & 3, d = j & 31; r.c = (t * 4 + wcc) * 192 + 128 + bj * 32 + d; } }
  else if (WHICH == 2) { r.src = p.w_ukv; r.ld = KVW; r.c = q; }
  else if (WHICH == 3) { r.src = p.w_o; r.ld = D; r.c = q; }
  else { if (q < NG) { r.src = p.w_group; r.ld = NG; r.c = q; } else if (q < NRL) { r.src = p.w_router; r.ld = NE; r.c = q - NG; } }
  return r;
}
struct PrepDesc { bf16_t* dst; const float* gain; int K, kt, pt, which; };
__device__ __forceinline__ ColSrc colmap_rt(const P& p, int which, int q) {
  switch (which) { case 0: return colmap<0>(p, q); case 1: return colmap<1>(p, q); case 2: return colmap<2>(p, q); case 3: return colmap<3>(p, q); default: return colmap<4>(p, q); }
}
constexpr int PU0 = (D / 64) * (NP1 / 64), PU1 = (QL / 64) * (QW / 64), PU2 = (KVL / 64) * (KVW / 64), PU3 = (D / 64) * (D / 64), PU4 = (D / 64) * (256 / 64), PUT = PU0 + PU1 + PU2 + PU3 + PU4;
__device__ __forceinline__ PrepDesc prep_desc(const P& p, int u) {
  PrepDesc d; int v = u;
  if (v < PU0) { d.dst = p.WinT; d.gain = nullptr; d.K = D; d.kt = v % (D / 64); d.pt = v / (D / 64); d.which = 0; return d; } v -= PU0;
  if (v < PU1) { d.dst = p.WuqT; d.gain = p.q_norm_g; d.K = QL; d.kt = v % (QL / 64); d.pt = v / (QL / 64); d.which = 1; return d; } v -= PU1;
  if (v < PU2) { d.dst = p.WukvT; d.gain = p.kv_norm_g; d.K = KVL; d.kt = v % (KVL / 64); d.pt = v / (KVL / 64); d.which = 2; return d; } v -= PU2;
  if (v < PU3) { d.dst = p.WoT; d.gain = nullptr; d.K = D; d.kt = v % (D / 64); d.pt = v / (D / 64); d.which = 3; return d; } v -= PU3;
  d.dst = p.WrT; d.gain = nullptr; d.K = D; d.kt = v % (D / 64); d.pt = v / (D / 64); d.which = 4; return d;
}
__device__ __forceinline__ void phase_prep(const P& p, ldsp lds, int bid, int nb, int ulo, int uhi, bool misc) {
  const int t = threadIdx.x, nl = t & 63, ksub = t >> 6, pl = t >> 3, kc = t & 7;
  for (int u0 = ulo + bid; u0 < uhi; u0 += 4 * nb) {
    float v[4][8];
#pragma unroll
    for (int b = 0; b < 4; ++b) { const int u = u0 + b * nb;
#pragma unroll
      for (int kk = 0; kk < 8; ++kk) v[b][kk] = 0.f;
      if (u < uhi) { const PrepDesc d = prep_desc(p, u); const ColSrc cs = colmap_rt(p, d.which, d.pt * 64 + nl);
        if (cs.c >= 0) {
#pragma unroll
          for (int kk = 0; kk < 8; ++kk) { const int k = d.kt * 64 + kk * 8 + ksub; float x = cs.src[(size_t)k * cs.ld + cs.c]; if (d.gain) x *= d.gain[k]; v[b][kk] = x; } } } }
#pragma unroll
    for (int b = 0; b < 4; ++b) { LAS float* tl = (LAS float*)(lds + b * 16640);
#pragma unroll
      for (int kk = 0; kk < 8; ++kk) tl[(kk * 8 + ksub) * 65 + nl] = v[b][kk]; }
    __syncthreads();
#pragma unroll
    for (int b = 0; b < 4; ++b) { const int u = u0 + b * nb;
      if (u < uhi) { const PrepDesc d = prep_desc(p, u); const LAS float* tl = (const LAS float*)(lds + b * 16640);
        u32x4 w;
        w.x = pk_bf16(tl[(kc * 8 + 0) * 65 + pl], tl[(kc * 8 + 1) * 65 + pl]); w.y = pk_bf16(tl[(kc * 8 + 2) * 65 + pl], tl[(kc * 8 + 3) * 65 + pl]);
        w.z = pk_bf16(tl[(kc * 8 + 4) * 65 + pl], tl[(kc * 8 + 5) * 65 + pl]); w.w = pk_bf16(tl[(kc * 8 + 6) * 65 + pl], tl[(kc * 8 + 7) * 65 + pl]);
        *(u32x4*)(d.dst + (size_t)(d.pt * 64 + pl) * d.K + d.kt * 64 + kc * 8) = w; } }
    __syncthreads();
  }
  if (!misc) return;
  for (int i = bid * NTHR + threadIdx.x; i < S * 32; i += nb * NTHR) { const int pos = i >> 5, f = i & 31;
    const float ang = (float)pos * powf(10000.f, -(float)f / 32.f); p.ropetab[2 * i] = cosf(ang); p.ropetab[2 * i + 1] = sinf(ang); }
  if (bid == 0 && threadIdx.x < 1024) p.cnt[threadIdx.x] = 0;
  if (bid == (nb > 1 ? 1 : 0) && threadIdx.x < 256) p.moe_done[threadIdx.x] = 0u;
}
__device__ __forceinline__ void rmsnorm_rows_dev(const float* __restrict__ in, const float* __restrict__ g, bf16_t* __restrict__ out, int bid, int nb) {
  const int lane = threadIdx.x & 63, w = (bid * NTHR + threadIdx.x) >> 6, nw = nb * (NTHR / 64);
  for (int r = w; r < T; r += 2 * nw) {
    const int r1 = min(r + nw, T - 1); const bool has1 = r + nw < T;
    const float4* s0 = (const float4*)(in + (size_t)r * D); const float4* s1 = (const float4*)(in + (size_t)r1 * D);
    float4 v0[8], v1[8]; float q0 = 0.f, q1 = 0.f;
#pragma unroll
    for (int i = 0; i < 8; ++i) { v0[i] = s0[i * 64 + lane]; v1[i] = s1[i * 64 + lane]; }
#pragma unroll
    for (int i = 0; i < 8; ++i) { q0 += v0[i].x * v0[i].x + v0[i].y * v0[i].y + v0[i].z * v0[i].z + v0[i].w * v0[i].w; q1 += v1[i].x * v1[i].x + v1[i].y * v1[i].y + v1[i].z * v1[i].z + v1[i].w * v1[i].w; }
    q0 = wave_sum(q0); q1 = wave_sum(q1);
    const float rs0 = rsqrtf(q0 * (1.f / D) + EPS), rs1 = rsqrtf(q1 * (1.f / D) + EPS);
#pragma unroll
    for (int i = 0; i < 8; ++i) { const float4 gg = ((const float4*)g)[i * 64 + lane];
      u32x2 o; o.x = pk_bf16(v0[i].x * rs0 * gg.x, v0[i].y * rs0 * gg.y); o.y = pk_bf16(v0[i].z * rs0 * gg.z, v0[i].w * rs0 * gg.w);
      ((u32x2*)(out + (size_t)r * D))[i * 64 + lane] = o;
      if (has1) { u32x2 o1; o1.x = pk_bf16(v1[i].x * rs1 * gg.x, v1[i].y * rs1 * gg.y); o1.y = pk_bf16(v1[i].z * rs1 * gg.z, v1[i].w * rs1 * gg.w);
        ((u32x2*)(out + (size_t)r1 * D))[i * 64 + lane] = o1; } }
  }
}

namespace att {
typedef float f32x16 __attribute__((ext_vector_type(16)));
constexpr int KVBLK = 64, SHM_V = 64 * 128 * 2, SHM_KN = 64 * 128 * 2, SHM_KR = 64 * 64 * 2, SHM_BUF = SHM_V + SHM_KN + SHM_KR;
constexpr float SCALE = 0.07216878364870322f, THR = 8.f;
#define KSWZ(row, colB) ((row) * 256 + ((colB) ^ (((row) & 7) << 4)))
#define KRSWZ(row, colB) ((row) * 128 + ((colB) ^ ((((row) >> 1) & 7) << 4)))
#define SBAR() __builtin_amdgcn_sched_barrier(0)
__device__ __forceinline__ int crow(int r, int hi) { return (r & 3) + 8 * (r >> 2) + 4 * hi; }
__device__ __forceinline__ unsigned cvtpk(float lo, float hi) { unsigned r; asm volatile("v_cvt_pk_bf16_f32 %0, %1, %2" : "=v"(r) : "v"(lo), "v"(hi)); return r; }
__device__ __forceinline__ void partialSM(f32x16& p0, f32x16& p1, float& m_reg, float& mn, float& alpha) {
  constexpr float C = SCALE * 1.4426950408889634f;
  float pmax = p0[0];
#pragma unroll
  for (int r = 1; r < 16; ++r) pmax = fmaxf(pmax, p0[r]);
#pragma unroll
  for (int r = 0; r < 16; ++r) pmax = fmaxf(pmax, p1[r]);
  { auto rr = __builtin_amdgcn_permlane32_swap(__float_as_uint(pmax), __float_as_uint(pmax), false, false);
    pmax = fmaxf(__uint_as_float(rr[0]), __uint_as_float(rr[1])); }
  if (__builtin_expect(__all(pmax - m_reg <= THR / SCALE), 1)) { mn = m_reg; alpha = 1.f; }
  else { mn = fmaxf(m_reg, pmax); alpha = __builtin_amdgcn_exp2f((m_reg - mn) * C); m_reg = mn; }
  const float mnC = -mn * C;
#pragma unroll
  for (int r = 0; r < 16; ++r) p0[r] = fmaf(p0[r], C, mnC);
#pragma unroll
  for (int r = 0; r < 16; ++r) p1[r] = fmaf(p1[r], C, mnC);
#pragma unroll
  for (int r = 0; r < 16; ++r) p0[r] = __builtin_amdgcn_exp2f(p0[r]);
}
__device__ __forceinline__ void finishSM(f32x16& p0, f32x16& p1, float alpha, float& l_reg, bf16x8& pa0, bf16x8& pa1, bf16x8& pa2, bf16x8& pa3) {
#pragma unroll
  for (int r = 0; r < 16; ++r) p1[r] = __builtin_amdgcn_exp2f(p1[r]);
  float ps = 0;
#pragma unroll
  for (int r = 0; r < 16; ++r) ps += p0[r];
#pragma unroll
  for (int r = 0; r < 16; ++r) ps += p1[r];
  { auto rr = __builtin_amdgcn_permlane32_swap(__float_as_uint(ps), __float_as_uint(ps), false, false);
    ps = __uint_as_float(rr[0]) + __uint_as_float(rr[1]); }
  l_reg = l_reg * alpha + ps;
#define PK4(P_, BASE, OUT) do { unsigned a0 = cvtpk(P_[BASE + 0], P_[BASE + 1]), a1 = cvtpk(P_[BASE + 2], P_[BASE + 3]);   \
    unsigned b0 = cvtpk(P_[BASE + 4], P_[BASE + 5]), b1 = cvtpk(P_[BASE + 6], P_[BASE + 7]);                              \
    auto r0 = __builtin_amdgcn_permlane32_swap(a0, b0, false, false); auto r1 = __builtin_amdgcn_permlane32_swap(a1, b1, false, false); \
    u32x4 w = {r0[0], r1[0], r0[1], r1[1]}; OUT = *reinterpret_cast<bf16x8*>(&w); } while (0)
  PK4(p0, 0, pa0); PK4(p0, 8, pa1); PK4(p1, 0, pa2); PK4(p1, 8, pa3);
#undef PK4
}
__device__ __forceinline__ void qkt(f32x16& p0, f32x16& p1, ldsp Kn, ldsp Kr, const bf16x8 (&qr)[8], ldsp qrl, int r32, int hi) {
  asm volatile("" : "+v"(r32), "+v"(hi));
  p0 = f32x16{}; p1 = f32x16{};
#pragma unroll
  for (int d0 = 0; d0 < 8; ++d0) { const int cb = (d0 * 16 + hi * 8) * 2;
    const bf16x8 b0 = *(const LAS bf16x8*)(Kn + KSWZ(r32, cb)); const bf16x8 b1 = *(const LAS bf16x8*)(Kn + KSWZ(32 + r32, cb));
    p0 = __builtin_amdgcn_mfma_f32_32x32x16_bf16(b0, qr[d0], p0, 0, 0, 0); p1 = __builtin_amdgcn_mfma_f32_32x32x16_bf16(b1, qr[d0], p1, 0, 0, 0); }
#pragma unroll
  for (int d0 = 0; d0 < 4; ++d0) { const int cb = (d0 * 16 + hi * 8) * 2;
    const bf16x8 b0 = *(const LAS bf16x8*)(Kr + KRSWZ(r32, cb)); const bf16x8 b1 = *(const LAS bf16x8*)(Kr + KRSWZ(32 + r32, cb));
    const bf16x8 qf = *(const LAS bf16x8*)(qrl + KSWZ(r32, cb + 128));
    p0 = __builtin_amdgcn_mfma_f32_32x32x16_bf16(b0, qf, p0, 0, 0, 0); p1 = __builtin_amdgcn_mfma_f32_32x32x16_bf16(b1, qf, p1, 0, 0, 0); }
}
__device__ __forceinline__ int v_st(int k, int c) { const int kk = (k & ~0xC) | ((k & 4) << 1) | ((k & 8) >> 1); return ((kk >> 3) * 4 + (c >> 5)) * 512 + ((kk & 7) * 32 + (c & 31)) * 2; }
__device__ __forceinline__ int v_rd_base(int lane) { return ((lane & 3) << 3) | (((lane >> 2) & 3) << 6) | (((lane >> 4) & 1) << 5) | (((lane >> 5) & 1) << 8); }
__device__ __forceinline__ s16x4 trr(ldsp vb, int off) { return __builtin_amdgcn_ds_read_tr16_b64_v4i16((LAS s16x4*)(vb + off)); }
__device__ __forceinline__ void pv_one(f32x16& od, ldsp vb, int d0, bf16x8 pa0, bf16x8 pa1, bf16x8 pa2, bf16x8 pa3) {
#define VOFF(ks, half) (d0 * 512 + (ks) * 4096 + (half) * 2048)
  const s16x4 l0 = trr(vb, VOFF(0, 0)), h0 = trr(vb, VOFF(0, 1)), l1 = trr(vb, VOFF(1, 0)), h1 = trr(vb, VOFF(1, 1));
  const s16x4 l2 = trr(vb, VOFF(2, 0)), h2 = trr(vb, VOFF(2, 1)), l3 = trr(vb, VOFF(3, 0)), h3 = trr(vb, VOFF(3, 1));
#undef VOFF
#define PK(L, H_) (bf16x8){L[0], L[1], L[2], L[3], H_[0], H_[1], H_[2], H_[3]}
  od = __builtin_amdgcn_mfma_f32_32x32x16_bf16(pa0, PK(l0, h0), od, 0, 0, 0);
  od = __builtin_amdgcn_mfma_f32_32x32x16_bf16(pa1, PK(l1, h1), od, 0, 0, 0);
  od = __builtin_amdgcn_mfma_f32_32x32x16_bf16(pa2, PK(l2, h2), od, 0, 0, 0);
  od = __builtin_amdgcn_mfma_f32_32x32x16_bf16(pa3, PK(l3, h3), od, 0, 0, 0);
  SBAR();
#undef PK
}
__device__ __forceinline__ void pv_all(f32x16 (&o)[4], ldsp vb, bf16x8 pa0, bf16x8 pa1, bf16x8 pa2, bf16x8 pa3) {
  pv_one(o[0], vb, 0, pa0, pa1, pa2, pa3); pv_one(o[1], vb, 1, pa0, pa1, pa2, pa3); pv_one(o[2], vb, 2, pa0, pa1, pa2, pa3); pv_one(o[3], vb, 3, pa0, pa1, pa2, pa3);
}
__device__ __forceinline__ void attn_unit(const bf16_t* __restrict__ Qb, const bf16_t* __restrict__ Kh, const bf16_t* __restrict__ Krp, bf16_t* __restrict__ Ob, ldsp lds) {
  int tid = threadIdx.x; asm volatile("" : "+v"(tid));
  const int wid = tid >> 6, lane = tid & 63, r32 = lane & 31, hi = lane >> 5;
  LAS float* ws = (LAS float*)(lds + 2 * SHM_BUF) + wid * 64; LAS float* li_l = ws; LAS float* al_l = ws + 32;
  float m_reg = -1e30f, l_reg = 0; f32x16 o[4] = {}; bf16x8 qr[8];
  const bf16_t* Qw = Qb + (size_t)(wid * 32 + r32) * QW + hi * 8;
#pragma unroll
  for (int d0 = 0; d0 < 8; ++d0) qr[d0] = *(const bf16x8*)(Qw + d0 * 16);
  ldsp qrl = lds + 2 * SHM_BUF + 2048 + wid * 8192;
#pragma unroll
  for (int d0 = 0; d0 < 8; ++d0) *(LAS bf16x8*)(qrl + KSWZ(r32, (d0 * 16 + hi * 8) * 2)) = *(const bf16x8*)(Qw + 64 + d0 * 16);
  const int sr = tid >> 4, sc = (tid & 15) * 8, vst0 = v_st(sr, sc), vst1 = v_st(32 + sr, sc);
  const int rr_ = tid >> 3, rc_ = (tid & 7) * 8;
  const int vrb = v_rd_base(lane);
  bf16x8 vs0, vs1, ks0, ks1, krs;
#define VB(b) (lds + (b) * SHM_BUF)
#define KNB(b) (lds + (b) * SHM_BUF + SHM_V)
#define KRB(b) (lds + (b) * SHM_BUF + SHM_V + SHM_KN)
#define SLOAD(k0) do { const bf16_t* kp0 = Kh + (size_t)((k0) + sr) * KVW + sc; const bf16_t* kp1 = Kh + (size_t)((k0) + 32 + sr) * KVW + sc; \
    vs0 = *(const bf16x8*)(kp0 + 128); vs1 = *(const bf16x8*)(kp1 + 128); ks0 = *(const bf16x8*)kp0; ks1 = *(const bf16x8*)kp1; \
    krs = *(const bf16x8*)(Krp + (size_t)((k0) + rr_) * RD + rc_); } while (0)
#define SWRITE(b) do { *(LAS bf16x8*)(VB(b) + vst0) = vs0; *(LAS bf16x8*)(VB(b) + vst1) = vs1; \
    *(LAS bf16x8*)(KNB(b) + KSWZ(sr, sc * 2)) = ks0; *(LAS bf16x8*)(KNB(b) + KSWZ(32 + sr, sc * 2)) = ks1; \
    *(LAS bf16x8*)(KRB(b) + KRSWZ(rr_, rc_ * 2)) = krs; } while (0)
#define RESC(a) do { if (__any((a) < 1.f)) { if (hi == 0) al_l[r32] = (a); asm volatile("s_waitcnt lgkmcnt(0)" ::: "memory"); \
    _Pragma("unroll") for (int d = 0; d < 4; ++d) _Pragma("unroll") for (int r = 0; r < 16; ++r) o[d][r] *= al_l[crow(r, hi)]; } } while (0)
  f32x16 pA0, pA1, pB0, pB1; float mnA, mnB, alA, alB; bf16x8 pa0, pa1, pa2, pa3; constexpr int NT = S / KVBLK;
  SLOAD(0); SWRITE(0); __syncthreads();
  qkt(pA0, pA1, KNB(0), KRB(0), qr, qrl, r32, hi); partialSM(pA0, pA1, m_reg, mnA, alA);
  SLOAD(KVBLK); SWRITE(1); __syncthreads();
  for (int j = 1; j + 1 < NT; j += 2) {
    SBAR(); qkt(pB0, pB1, KNB(1), KRB(1), qr, qrl, r32, hi);
    finishSM(pA0, pA1, alA, l_reg, pa0, pa1, pa2, pa3); SBAR();
    SLOAD((j + 1) * KVBLK); SBAR();
    pv_all(o, VB(0) + vrb, pa0, pa1, pa2, pa3); partialSM(pB0, pB1, m_reg, mnB, alB);
    __syncthreads(); SWRITE(0);
    RESC(alB); __syncthreads();
    SBAR(); qkt(pA0, pA1, KNB(0), KRB(0), qr, qrl, r32, hi);
    finishSM(pB0, pB1, alB, l_reg, pa0, pa1, pa2, pa3); SBAR();
    SLOAD((j + 2) * KVBLK); SBAR();
    pv_all(o, VB(1) + vrb, pa0, pa1, pa2, pa3); partialSM(pA0, pA1, m_reg, mnA, alA);
    __syncthreads(); SWRITE(1);
    RESC(alA); __syncthreads();
  }
  SBAR(); qkt(pB0, pB1, KNB(1), KRB(1), qr, qrl, r32, hi);
  finishSM(pA0, pA1, alA, l_reg, pa0, pa1, pa2, pa3); SBAR();
  pv_all(o, VB(0) + vrb, pa0, pa1, pa2, pa3); partialSM(pB0, pB1, m_reg, mnB, alB);
  __syncthreads(); RESC(alB);
  finishSM(pB0, pB1, alB, l_reg, pa0, pa1, pa2, pa3); SBAR();
  pv_all(o, VB(1) + vrb, pa0, pa1, pa2, pa3);
  if (hi == 0) li_l[r32] = l_reg; asm volatile("s_waitcnt lgkmcnt(0)" ::: "memory");
  float rli[16];
#pragma unroll
  for (int r = 0; r < 16; ++r) rli[r] = __builtin_amdgcn_rcpf(li_l[crow(r, hi)]);
  bf16_t* Ow = Ob + (size_t)(wid * 32) * D;
#pragma unroll
  for (int r = 0; r < 16; ++r) { const int orow = crow(r, hi);
#pragma unroll
    for (int d0 = 0; d0 < 4; ++d0) Ow[(size_t)orow * D + d0 * 32 + r32] = f2bf(o[d0][r] * rli[r]); }
  __syncthreads();
#undef VB
#undef KNB
#undef KRB
#undef SLOAD
#undef SWRITE
#undef RESC
}
}
__device__ __forceinline__ void phase_attn(const P& p, ldsp lds, int bid, int nb) {
  for (int u = bid; u < NB * H * (S / 256); u += nb) {
    const int qb = u & 7, h = (u >> 3) & 7, b = u >> 6;
    const size_t row0 = (size_t)b * S + qb * 256;
    att::attn_unit(p.q + row0 * QW + h * 192, p.kv + (size_t)b * S * KVW + h * 256, p.krope + (size_t)b * S * RD, p.mix + row0 * D + h * 128, lds);
  }
}


__device__ __forceinline__ void phase_conv(const P& p, ldsp lds, int bid, int nb) {
  LAS float* red = (LAS float*)lds;
  for (int u = bid; u < T / 16; u += nb) {
    int tid = threadIdx.x; asm volatile("" : "+v"(tid));
    const int wid = tid >> 6, lane = tid & 63, ch = tid * 2;
    const int t0 = u * 16, b = t0 / S, s0 = t0 % S;
    float w0[CW], w1[CW];
#pragma unroll
    for (int j = 0; j < CW; ++j) { const float2 wv = *(const float2*)(p.w_dw + j * CC + ch); w0[j] = wv.x; w1[j] = wv.y; }
    const float2 bd = *(const float2*)(p.b_dw + ch);
    float a0[16], a1[16];
#pragma unroll
    for (int i = 0; i < 16; ++i) { a0[i] = bd.x; a1[i] = bd.y; }
#pragma unroll
    for (int rr = 0; rr < 46; ++rr) { const int s = s0 - 15 + rr; float v0 = 0.f, v1 = 0.f;
      { const int scl = min(max(s, 0), S - 1); const unsigned raw = *(const unsigned*)(p.cglu + ((size_t)b * S + scl) * CC + ch);
        const bool ok = (s >= 0 && s < S); v0 = ok ? __uint_as_float(raw << 16) : 0.f; v1 = ok ? __uint_as_float(raw & 0xffff0000u) : 0.f; }
#pragma unroll
      for (int i = 0; i < 16; ++i) { const int j = rr - i; if (j >= 0 && j < CW) { a0[i] += w0[j] * v0; a1[i] += w1[j] * v1; } } }
#pragma unroll
    for (int i = 0; i < 16; ++i) { const float sm = wave_sum(a0[i] + a1[i]), sq = wave_sum(a0[i] * a0[i] + a1[i] * a1[i]);
      if (lane == 0) { red[wid * 32 + i] = sm; red[wid * 32 + 16 + i] = sq; } }
    __syncthreads();
    if (tid < 32) { float t = 0.f;
#pragma unroll
      for (int w = 0; w < 8; ++w) t += red[w * 32 + tid];
      red[256 + tid] = t; }
    __syncthreads();
    const float2 lg = *(const float2*)(p.conv_ln_g + ch), lb = *(const float2*)(p.conv_ln_b + ch);
#pragma unroll
    for (int i = 0; i < 16; ++i) { const float mu = red[256 + i] * (1.f / CC), var = red[256 + 16 + i] * (1.f / CC) - mu * mu; const float rs = rsqrtf(fmaxf(var, 0.f) + EPS);
      const float y0 = (a0[i] - mu) * rs * lg.x + lb.x, y1 = (a1[i] - mu) * rs * lg.y + lb.y;
      *(unsigned*)(p.mix + (size_t)(t0 + i) * D + CC + ch) = pk_bf16(siluf_(y0), siluf_(y1)); }
    __syncthreads();
  }
}

__device__ __forceinline__ void phase_route2(const P& p, ldsp lds, int bid, int nb) {
  constexpr int RS = 4096 + 16;
  const int tid = threadIdx.x, wid = tid >> 6, lane = tid & 63, fr = lane & 15, fq = lane >> 4;
  for (int u = bid; u < T / 32; u += nb) {
    const int t0 = u * 32;
    __syncthreads();
#pragma unroll
    for (int i = 0; i < 16; ++i) { const int c = i * 512 + tid, r = c >> 8, pc = c & 255;
      *(LAS u32x4*)(lds + r * RS + pc * 16) = *(const u32x4*)(p.hn + (size_t)(t0 + r) * D + pc * 8); }
    __syncthreads();
    f32x4 acc[2][5];
#pragma unroll
    for (int m = 0; m < 2; ++m)
#pragma unroll
      for (int n = 0; n < 5; ++n) acc[m][n] = (f32x4){0.f, 0.f, 0.f, 0.f};
#pragma unroll 2
    for (int ks = 0; ks < 8; ++ks) { const int k0 = wid * 256 + ks * 32 + fq * 8;
      bf16x8 Bf[5];
#pragma unroll
      for (int n = 0; n < 5; ++n) Bf[n] = *(const bf16x8*)(p.WrT + (size_t)(n * 16 + fr) * D + k0);
      const bf16x8 A0 = *(const LAS bf16x8*)(lds + fr * RS + k0 * 2), A1 = *(const LAS bf16x8*)(lds + (16 + fr) * RS + k0 * 2);
#pragma unroll
      for (int n = 0; n < 5; ++n) { acc[0][n] = __builtin_amdgcn_mfma_f32_16x16x32_bf16(Bf[n], A0, acc[0][n], 0, 0, 0); acc[1][n] = __builtin_amdgcn_mfma_f32_16x16x32_bf16(Bf[n], A1, acc[1][n], 0, 0, 0); } }
    __syncthreads();
    LAS float* part = (LAS float*)lds;
#pragma unroll
    for (int m = 0; m < 2; ++m)
#pragma unroll
      for (int n = 0; n < 5; ++n) *(LAS f32x4*)(part + (wid * 32 + m * 16 + fr) * 80 + n * 16 + fq * 4) = acc[m][n];
    __syncthreads();
    LAS float* lg_ = part + 8 * 32 * 80;
    for (int o = tid; o < 32 * 80; o += NTHR) { float s = 0.f;
#pragma unroll
      for (int w = 0; w < 8; ++w) s += part[w * 2560 + o];
      lg_[o] = s; }
    __syncthreads();
    if (tid < 32) { const int t = t0 + tid; const LAS float* L_ = lg_ + tid * 80;
      float sq = 0.f;
#pragma unroll
      for (int i = 0; i < 32; i += 4) { const float4 v = *(const float4*)(p.ssq_h + (size_t)t * 32 + i); sq += (v.x + v.y) + (v.z + v.w); }
      const float rs = rsqrtf(sq * (1.f / D) + EPS); p.rstd_h[t] = rs;
      float lg[NG];
#pragma unroll
      for (int j = 0; j < NG; ++j) lg[j] = L_[j] * rs + p.b_group[j];
      int gs = 0; float gm = lg[0];
#pragma unroll
      for (int j = 1; j < NG; ++j) if (lg[j] > gm) { gm = lg[j]; gs = j; }
      float gsum = 0.f;
#pragma unroll
      for (int j = 0; j < NG; ++j) gsum += __expf(lg[j] - gm);
      const float pg = 1.f / gsum;
      float el[EPG];
#pragma unroll
      for (int j = 0; j < EPG; ++j) el[j] = L_[NG + gs * EPG + j] * rs + p.b_router[gs * EPG + j];
      int i1 = 0; float m1 = el[0];
#pragma unroll
      for (int j = 1; j < EPG; ++j) if (el[j] > m1) { m1 = el[j]; i1 = j; }
      int i2 = -1; float m2 = -1e30f;
#pragma unroll
      for (int j = 0; j < EPG; ++j) if (j != i1 && el[j] > m2) { m2 = el[j]; i2 = j; }
      const float e2 = __expf(m2 - m1); const float w1 = 1.f / (1.f + e2), w2 = e2 / (1.f + e2);
      const int ea = gs * EPG + i1, eb = gs * EPG + i2;
      const int pa = atomicAdd(&p.cnt[ea], 1); p.list_tok[ea * LCAP + pa] = t * 2; p.list_gate[ea * LCAP + pa] = pg * w1;
      const int pb = atomicAdd(&p.cnt[eb], 1); p.list_tok[eb * LCAP + pb] = t * 2 + 1; p.list_gate[eb * LCAP + pb] = pg * w2;
    }
  }
}
__device__ __forceinline__ int trw(int k, int c) { return (c >> 4) * 2080 + (k >> 4) * 512 + (((k & 15) * 32) ^ (((k >> 3) & 1) << 7)) + (c & 15) * 2; }
struct MoeUnit { int e, m0, count, sl, start, tile; };
template <int MODE, int PROBE = 0>
__device__ __forceinline__ void moe_stream(const P& p, ldsp lds, int bid, int nb) {
  constexpr int NS = MODE == 0 ? 8 : 16, NK = MODE == 0 ? D / BK : DE / BK, MROWS = 320, NFM = 5, MA_B = MROWS * 128, MSTAGE = MA_B + 16640 + 256;
  constexpr int TAB_OFF = 2 * MSTAGE + 1024, TAB_UNIT = MROWS * 8, CAP = (LDS_BYTES - 16 - TAB_OFF) / TAB_UNIT;
  LAS int* ts = (LAS int*)(lds + 2 * MSTAGE);
  LAS int* stt = ts + 80; LAS int* cntl = ts + 160;
  __syncthreads();
  if (threadIdx.x < NE) cntl[threadIdx.x] = p.cnt[threadIdx.x];
  __syncthreads();
  if (threadIdx.x == 0) { int s = 0, r = 0; for (int e = 0; e < NE; ++e) { const int c = cntl[e]; ts[e] = s; stt[e] = r; s += (c + MROWS - 1) / MROWS; r += c; } ts[NE] = s; stt[NE] = r; }
  __syncthreads();
  const int ntile = ts[NE];
  int xcd, slot, nslots, nloc;
  if ((nb & 7) == 0) { xcd = bid & 7; slot = bid >> 3; nslots = nb >> 3; nloc = ((ntile - xcd + 7) >> 3) * NS; }
  else { xcd = 0; slot = bid; nslots = nb; nloc = ntile * NS; }
  int nu_all = nloc > slot ? (nloc - slot + nslots - 1) / nslots : 0, doff = 0;
  if (MODE == 1) {
    const int nlu = nloc / 2, ubase = nlu / nslots, urem = nlu % nslots, Tt = (4 * nlu + nloc + nslots - 1) / nslots;
    int rem = nloc; nu_all = 0;
    for (int k = 0; k < nslots; ++k) { const int sidx = (k + urem) % nslots, U = sidx < urem ? ubase + 1 : ubase; const int d = min(max(0, Tt - 4 * U), rem);
      if (sidx == slot) { doff = nloc - rem; nu_all = d; } rem -= d; }
  }
  int tid = threadIdx.x; asm volatile("" : "+v"(tid));
  const int wid = tid >> 6, lane = tid & 63, wm = wid >> 1, wn = wid & 1, fr = lane & 15, fq = lane >> 4;
  const bf16_t* abase = MODE == 0 ? p.hn : p.hb;
  constexpr int LDB = (PROBE & 1) ? 128 : (MODE == 0 ? DE : D);
  for (int c0 = 0; c0 < nu_all; c0 += CAP) {
    const int nu = min(CAP, nu_all - c0), total = nu * NK;
    auto unit_of = [&](int j) { MoeUnit u; const int l = MODE == 0 ? slot + (c0 + j) * nslots : doff + c0 + j; const int tile = ((nb & 7) == 0) ? (l / NS) * 8 + xcd : l / NS; u.sl = l % NS; u.tile = tile;
      int e = 0;
#pragma unroll 1
      for (int s = 32; s > 0; s >>= 1) if (e + s < NE && ts[e + s] <= tile) e += s;
      u.e = e; u.m0 = (tile - ts[e]) * MROWS; u.count = min(MROWS, cntl[e] - u.m0); u.start = stt[e]; return u; };
    __syncthreads();
    for (int j = 0; j < nu; ++j) { const MoeUnit u = unit_of(j);
      for (int r = threadIdx.x; r < MROWS; r += NTHR) { const int rr = min(r, u.count - 1);
        if (MODE == 0) { const int tk = p.list_tok[u.e * LCAP + u.m0 + rr] >> 1; ((LAS unsigned*)(lds + TAB_OFF + j * TAB_UNIT))[r] = (unsigned)(tk * D); ((LAS float*)(lds + TAB_OFF + j * TAB_UNIT + MROWS * 4))[r] = p.rstd_h[tk]; }
        else { ((LAS int*)(lds + TAB_OFF + j * TAB_UNIT))[r] = p.list_tok[u.e * LCAP + u.m0 + rr]; ((LAS float*)(lds + TAB_OFF + j * TAB_UNIT + MROWS * 4))[r] = p.list_gate[u.e * LCAP + u.m0 + rr]; } } }
    asm volatile("s_waitcnt vmcnt(0)" ::: "memory");
    __syncthreads();
    unsigned ao[NFM]; int a_j = -1, a_tile = -1;
    auto a_setup = [&](int j) { const MoeUnit u = unit_of(j); a_j = j;
      if (MODE == 1 && u.tile != a_tile) {
        if (wid == 0) { unsigned sp = 0; while (__hip_atomic_load(p.moe_done + u.tile, __ATOMIC_RELAXED, __HIP_MEMORY_SCOPE_AGENT) < 8u) { __builtin_amdgcn_s_sleep(8); if (++sp > (1u << 22)) break; }
          __builtin_amdgcn_fence(__ATOMIC_ACQUIRE, "agent"); asm volatile("s_waitcnt vmcnt(0)" ::: "memory"); }
        __syncthreads(); a_tile = u.tile; }
#pragma unroll
      for (int i = 0; i < NFM; ++i) { int R, C; stage_rc(wid * 1024 + i * 8192 + lane * 16, R, C);
        if (MODE == 0) ao[i] = ((const LAS unsigned*)(lds + TAB_OFF + j * TAB_UNIT))[R] + C; else ao[i] = (unsigned)((u.start + u.m0 + min(R, u.count - 1)) * DE + C); } };
    const float* bsrc = nullptr; int b_j = -1;
    auto b_setup = [&](int j) { const MoeUnit u = unit_of(j); b_j = j; const int tc = (lane & 31) * 4;
      if (PROBE & 1) { if (MODE == 0) bsrc = p.w_gate + (size_t)((u.tile * NS + u.sl) & 255) * D * 128 + (size_t)(8 * wid + (lane >> 5)) * 128 + tc; else bsrc = p.w_down + (size_t)((u.tile * NS + u.sl) & 1023) * DE * 128 + (size_t)(8 * wid + (lane >> 5)) * 128 + tc; }
      else if (MODE == 0) { const int jj = tc & 63; bsrc = (jj < 32 ? p.w_gate : p.w_up) + (size_t)u.e * D * DE + (size_t)(8 * wid + (lane >> 5)) * DE + u.sl * 64 + (tc >> 6) * 32 + (jj & 31); }
      else bsrc = p.w_down + (size_t)u.e * DE * D + (size_t)(8 * wid + (lane >> 5)) * D + u.sl * 128 + tc; };
    u32x4 ar0[NFM]; float4 br0[4], br1[4];
    f32x4 acc[NFM][4];
#pragma unroll
    for (int i = 0; i < NFM; ++i)
#pragma unroll
      for (int n = 0; n < 4; ++n) acc[i][n] = (f32x4){0.f, 0.f, 0.f, 0.f};
#define A_ISSUE(AR, pos_) do { const int pos = min((pos_), total - 1); const int j_ = pos / NK, kt_ = pos % NK; if (j_ != a_j) a_setup(j_); \
      _Pragma("unroll") for (int i = 0; i < NFM; ++i) AR[i] = *(const u32x4*)(abase + ao[i] + kt_ * BK); } while (0)
#define B_ISSUE(BR, pos_) do { const int pos = min((pos_), total - 1); const int j_ = pos / NK, kt_ = pos % NK; if (j_ != b_j) b_setup(j_); \
      _Pragma("unroll") for (int q = 0; q < 4; ++q) BR[q] = *(const float4*)(bsrc + (size_t)(kt_ * BK + 2 * q) * LDB); } while (0)
#define A_WRITE(AR, buf) do { int t_ = tid; asm volatile("" : "+v"(t_)); const int w_i = t_ >> 6, l_i = t_ & 63; \
      _Pragma("unroll") for (int i = 0; i < NFM; ++i) *(LAS u32x4*)(lds + (buf) * MSTAGE + w_i * 1024 + i * 8192 + l_i * 16) = AR[i]; } while (0)
#define B_WRITE(BR, buf) do { int t_ = tid; asm volatile("" : "+v"(t_)); const int w_i = t_ >> 6, l_i = t_ & 63; \
      _Pragma("unroll") for (int q = 0; q < 4; ++q) { u32x2 w_; w_.x = pk_bf16(BR[q].x, BR[q].y); w_.y = pk_bf16(BR[q].z, BR[q].w); \
      const int tc_ = (l_i & 31) * 4, ic_ = MODE == 1 ? ((tc_ & 64) | (((tc_ >> 2) & 3) << 4) | (((tc_ >> 4) & 3) << 2)) : tc_;     \
      *(LAS u32x2*)(lds + (buf) * MSTAGE + MA_B + trw(8 * w_i + 2 * q + (l_i >> 5), ic_)) = w_; } } while (0)
    int c_j = 0; MoeUnit cu = unit_of(0); int nvf = max(0, min(NFM, ((cu.count + 15) / 16 - wm + 3) >> 2));
    auto compute_nf = [&](int buf, auto nfc) {
      constexpr int NF = decltype(nfc)::value;
      ldsp sb = lds + buf * MSTAGE;
      int t_ = tid; asm volatile("" : "+v"(t_));
      const int wn_ = (t_ >> 6) & 1, wm_ = t_ >> 7, fr_ = t_ & 15, fq_ = (t_ >> 4) & 3, q_ = fr_ >> 2, pp_ = fr_ & 3;
      const int lp0 = (fq_ >> 1) * 512 + (fq_ & 1) * 256 + ((fq_ & 1) << 7) + q_ * 32 + pp_ * 8;
      const int trb0 = MA_B + wn_ * 4 * 2080 + lp0, trb1 = MA_B + wn_ * 4 * 2080 + (lp0 ^ 128);
      const int afb = lds_byte(wm_ * 16 + fr_, fq_ * 8);
#pragma unroll
      for (int ks = 0; ks < 2; ++ks) {
        bf16x8 Bf[4];
#pragma unroll
        for (int n = 0; n < 4; ++n) {
          const s16x4 lo = __builtin_amdgcn_ds_read_tr16_b64_v4i16((LAS s16x4*)(sb + trb0 + n * 2080 + ks * 1024));
          const s16x4 hi = __builtin_amdgcn_ds_read_tr16_b64_v4i16((LAS s16x4*)(sb + trb1 + n * 2080 + ks * 1024));
          Bf[n] = __builtin_shufflevector(lo, hi, 0, 1, 2, 3, 4, 5, 6, 7); }
        bf16x8 At[NF];
#pragma unroll
        for (int i = 0; i < NF; ++i) At[i] = *(const LAS bf16x8*)(sb + afb + i * 8192 + ks * 1024);
#pragma unroll
        for (int i = 0; i < NF; ++i)
#pragma unroll
          for (int n = 0; n < 4; ++n) acc[i][n] = __builtin_amdgcn_mfma_f32_16x16x32_bf16(Bf[n], At[i], acc[i][n], 0, 0, 0);
        __builtin_amdgcn_sched_barrier(0);
      }
    };
    auto compute = [&](int buf) {
      if (nvf <= 4) compute_nf(buf, std::integral_constant<int, 4>()); else compute_nf(buf, std::integral_constant<int, 5>()); };
    auto epilogue = [&]() {
      int fr2 = fr, fq2 = fq; asm volatile("" : "+v"(fr2), "+v"(fq2));
#pragma unroll
      for (int i = 0; i < NFM; ++i) { const int r = (wm + 4 * i) * 16 + fr2;
        if (r < cu.count) {
          if (MODE == 0) { bf16_t* dst = ((PROBE & 1) ? (bf16_t*)p.convtmp : p.hb) + (size_t)(cu.start + cu.m0 + r) * DE + cu.sl * 64 + wn * 32 + fq2 * 4;
            const float rs = ((const LAS float*)(lds + TAB_OFF + c_j * TAB_UNIT + MROWS * 4))[r];
#pragma unroll
            for (int n = 0; n < 2; ++n) { const f32x4 g = acc[i][n] * rs, uu = acc[i][n + 2] * rs;
              const unsigned lo = pk_bf16(siluf_(g[0]) * uu[0], siluf_(g[1]) * uu[1]), hi = pk_bf16(siluf_(g[2]) * uu[2], siluf_(g[3]) * uu[3]);
              __hip_atomic_store((unsigned long long*)(dst + n * 16), ((unsigned long long)hi << 32) | lo, __ATOMIC_RELAXED, __HIP_MEMORY_SCOPE_AGENT); } }
          else { const int ts2 = ((const LAS int*)(lds + TAB_OFF + c_j * TAB_UNIT))[r]; const float gate = ((const LAS float*)(lds + TAB_OFF + c_j * TAB_UNIT + MROWS * 4))[r];
            bf16_t* dst = p.y + (size_t)ts2 * D + cu.sl * 128 + wn * 64 + fq2 * 16;
            u32x4 w0, w1;
            w0.x = pk_bf16(acc[i][0][0] * gate, acc[i][0][1] * gate); w0.y = pk_bf16(acc[i][0][2] * gate, acc[i][0][3] * gate); w0.z = pk_bf16(acc[i][1][0] * gate, acc[i][1][1] * gate); w0.w = pk_bf16(acc[i][1][2] * gate, acc[i][1][3] * gate);
            w1.x = pk_bf16(acc[i][2][0] * gate, acc[i][2][1] * gate); w1.y = pk_bf16(acc[i][2][2] * gate, acc[i][2][3] * gate); w1.z = pk_bf16(acc[i][3][0] * gate, acc[i][3][1] * gate); w1.w = pk_bf16(acc[i][3][2] * gate, acc[i][3][3] * gate);
            if (!(PROBE & 16)) { *(u32x4*)dst = w0; *(u32x4*)(dst + 8) = w1; } else asm volatile("" :: "v"(w0.x), "v"(w1.x)); }
        }
#pragma unroll
        for (int n = 0; n < 4; ++n) acc[i][n] = (f32x4){0.f, 0.f, 0.f, 0.f};
      }
    };
    A_ISSUE(ar0, 0); B_ISSUE(br0, 0); A_WRITE(ar0, 0); B_WRITE(br0, 0);
    B_ISSUE(br1, 1); A_ISSUE(ar0, 1); B_ISSUE(br0, 2);
    __syncthreads();
#define STEP(s, BRW, ARW) do { \
      if (!(PROBE & 4)) A_WRITE(ar0, ((s) + 1) & 1); if (!(PROBE & 32)) B_WRITE(BRW, ((s) + 1) & 1); else asm volatile("" :: "v"(BRW[0].x), "v"(BRW[1].x), "v"(BRW[2].x), "v"(BRW[3].x)); \
      if (!(PROBE & 4)) A_ISSUE(ar0, (s) + 2); if (!(PROBE & 8)) B_ISSUE(BRW, (s) + 3); \
      if (!(PROBE & 2)) compute((s) & 1); \
      int sig_ = -1; \
      if (((s) + 1) % NK == 0) { epilogue(); __builtin_amdgcn_s_waitcnt(0x0F70); sig_ = cu.tile; if ((s) + 1 < total) { c_j = ((s) + 1) / NK; cu = unit_of(c_j); nvf = max(0, min(NFM, ((cu.count + 15) / 16 - wm + 3) >> 2)); } } \
      asm volatile("s_waitcnt lgkmcnt(0)" ::: "memory"); __builtin_amdgcn_s_barrier(); \
      if (MODE == 0 && !PROBE && sig_ >= 0 && threadIdx.x == 0) __hip_atomic_fetch_add(p.moe_done + sig_, 1u, __ATOMIC_RELAXED, __HIP_MEMORY_SCOPE_AGENT);     \
      } while (0)
    for (int s = 0; s < total; s += 2) { STEP(s, br1, ar1); STEP(s + 1, br0, ar0); }
    asm volatile("s_waitcnt vmcnt(0)" ::: "memory");
#undef STEP
#undef A_ISSUE
#undef B_ISSUE
#undef A_WRITE
#undef B_WRITE
  }
}
__device__ __forceinline__ void phase_final(const P& p, int bid, int nb) {
  const int lane = threadIdx.x & 63, w = (bid * NTHR + threadIdx.x) >> 6, nw = nb * (NTHR / 64);
  for (int r = w; r < T; r += nw) {
    const u32x2* src = (const u32x2*)(p.h16 + (size_t)r * D);
    const u32x2* y0 = (const u32x2*)(p.y + (size_t)(2 * r) * D); const u32x2* y1 = (const u32x2*)(p.y + (size_t)(2 * r + 1) * D);
    float4 v[8]; float ss = 0.f;
#pragma unroll
    for (int i = 0; i < 8; ++i) { const u32x2 hv = src[i * 64 + lane]; v[i].x = __uint_as_float(hv.x << 16); v[i].y = __uint_as_float(hv.x & 0xffff0000u); v[i].z = __uint_as_float(hv.y << 16); v[i].w = __uint_as_float(hv.y & 0xffff0000u);
      const u32x2 a = y0[i * 64 + lane], b = y1[i * 64 + lane];
      v[i].x += __uint_as_float(a.x << 16) + __uint_as_float(b.x << 16); v[i].y += __uint_as_float(a.x & 0xffff0000u) + __uint_as_float(b.x & 0xffff0000u);
      v[i].z += __uint_as_float(a.y << 16) + __uint_as_float(b.y << 16); v[i].w += __uint_as_float(a.y & 0xffff0000u) + __uint_as_float(b.y & 0xffff0000u);
      ss += v[i].x * v[i].x + v[i].y * v[i].y + v[i].z * v[i].z + v[i].w * v[i].w; }
    ss = wave_sum(ss);
    const float rs = rsqrtf(ss * (1.f / D) + EPS);
#pragma unroll
    for (int i = 0; i < 8; ++i) { const float4 gg = ((const float4*)p.final_g)[i * 64 + lane];
      float4 o; o.x = v[i].x * rs * gg.x; o.y = v[i].y * rs * gg.y; o.z = v[i].z * rs * gg.z; o.w = v[i].w * rs * gg.w;
      ((float4*)(p.out + (size_t)r * D))[i * 64 + lane] = o; }
  }
}

namespace pg8 {
#define PG8_LAS __attribute__((address_space(3)))
typedef unsigned short bf16_t;
typedef short bf16x8 __attribute__((ext_vector_type(8)));
typedef float f32x4 __attribute__((ext_vector_type(4)));
constexpr int BM = 256, BK = 64, HALF = 128, HTB = HALF * BK * 2, STAGE_BYTES = 8 * HTB;
__device__ __forceinline__ int lds_byte(int r, int c) { const int st = (r >> 4) * 2 + (c >> 5), rr = r & 15, cc = c & 31, ob = rr * 64 + cc * 2; return st * 1024 + (ob ^ (((ob >> 9) & 1) << 5)); }
__device__ __forceinline__ void stage_rc(int b, int& R, int& C) { const int st = b / 1024, sb = b % 1024, swz = sb ^ (((sb >> 9) & 1) << 5); R = (st >> 1) * 16 + swz / 64; C = (st & 1) * 32 + (swz % 64) / 2; }
__device__ __forceinline__ int perm32(int rho) { const int n = rho >> 4, i = rho & 15; return 8 * (i >> 2) + 4 * n + (i & 3); }
struct Unit { int pm, pn; };
struct Gemm { const bf16_t* A; const bf16_t* Bt; int M, N, K; };
struct ColMajorOrder { int nM, nwg, G, c;
  __device__ __forceinline__ bool next(int i, Unit& u) const { const int L = i * G + c; if (L >= nwg) return false; u.pm = L % nM; u.pn = L / nM; return true; }
  __device__ __forceinline__ void a_ready(const Unit&) const {}
  __device__ __forceinline__ void done(const Unit&) const {} };
template <class Epi, class Sched, bool ALIGN_EPI = false, bool SP2 = false>
__device__ __forceinline__ void gemm_phase(PG8_LAS unsigned char* lds, const Gemm g, const Sched& S, const Epi& E) {
    const int tid = threadIdx.x, wid = __builtin_amdgcn_readfirstlane(tid >> 6), lane = tid & 63, wr = wid >> 2, wc = wid & 3, fr = lane & 15, fq = lane >> 4;
    const int K = g.K, nt = K / BK;
    unsigned voffA[2], voffB[2];
#pragma unroll
    for (int i = 0; i < 2; ++i) { int R, C; stage_rc(tid * 16 + i * 8192, R, C); const int Rb = Epi::PERM ? ((R & ~31) + perm32(R & 31)) : R;
        voffA[i] = (unsigned)(R * K + C) * 2u; voffB[i] = (unsigned)(Rb * K + C) * 2u; }
    const size_t kstep = (size_t)(BK * 2);
    const size_t hstep = (size_t)HALF * K * 2;
    const size_t tstep = 2 * hstep;
    const unsigned ldsw = (unsigned)wid * 1024u;
    const int aoff = lds_byte(wr * 64 + fr, fq * 8), boff = lds_byte(wc * 32 + fr, fq * 8);
#define PG8_SA(b, h) (((b) * 2 + (h)) * HTB)
#define PG8_SB(b, h) ((4 + (b) * 2 + (h)) * HTB)
#define PG8_STAGE(bufoff, gbase, voff) do { _Pragma("unroll") for (int _i = 0; _i < 2; ++_i) \
        __builtin_amdgcn_global_load_lds((const unsigned*)((const char*)(gbase) + (voff)[_i]), (PG8_LAS unsigned*)(lds + (bufoff) + ldsw + _i * 8192), 16, 0, 0); } while (0)
#define PG8_LDA(dst, b, h) do { _Pragma("unroll") for (int m = 0; m < 4; ++m) _Pragma("unroll") for (int k = 0; k < 2; ++k) dst[m][k] = *(const PG8_LAS bf16x8*)(lds + PG8_SA(b, h) + aoff + m * 2048 + k * 1024); } while (0)
#define PG8_LDB(dst, b, h) do { _Pragma("unroll") for (int n = 0; n < 2; ++n) _Pragma("unroll") for (int k = 0; k < 2; ++k) dst[n][k] = *(const PG8_LAS bf16x8*)(lds + PG8_SB(b, h) + boff + n * 2048 + k * 1024); } while (0)
#define PG8_MMA(ai, bj, At, Bt) do { __builtin_amdgcn_s_setprio(1); _Pragma("unroll") for (int m = 0; m < 4; ++m) _Pragma("unroll") for (int n = 0; n < 2; ++n) _Pragma("unroll") for (int k = 0; k < 2; ++k) \
        acc[ai][bj][m][n] = __builtin_amdgcn_mfma_f32_16x16x32_bf16(Bt[n][k], At[m][k], acc[ai][bj][m][n], 0, 0, 0); __builtin_amdgcn_s_setprio(0); } while (0)
#define PG8_WAIT_V(n) asm volatile("s_waitcnt vmcnt(" #n ")" ::: "memory")
#define PG8_WAIT_L(n) asm volatile("s_waitcnt lgkmcnt(" #n ")" ::: "memory")
#define PG8_BAR __builtin_amdgcn_s_barrier()
#define PG8_SCHED __builtin_amdgcn_sched_barrier(0)
    Unit cur, nxt; int ui = 0;
    if (!S.next(0, cur)) return;
    f32x4 acc[2][2][4][2];
#pragma unroll
    for (int a = 0; a < 2; ++a)
#pragma unroll
        for (int b = 0; b < 2; ++b)
#pragma unroll
            for (int m = 0; m < 4; ++m)
#pragma unroll
                for (int n = 0; n < 2; ++n) acc[a][b][m][n] = (f32x4){0.f, 0.f, 0.f, 0.f};
    bf16x8 At[4][2], B0[2][2], B1[2][2];
    const char* cA = (const char*)g.A + (size_t)cur.pm * tstep; const char* cB = (const char*)g.Bt + (size_t)cur.pn * tstep;
    S.a_ready(cur);
    if constexpr (SP2) {
        PG8_STAGE(PG8_SB(0, 0), cB, voffB); PG8_STAGE(PG8_SB(0, 1), cB + hstep, voffB); PG8_STAGE(PG8_SA(0, 0), cA, voffA); PG8_STAGE(PG8_SA(0, 1), cA + hstep, voffA);
        if (wr == 1) PG8_BAR;
        PG8_WAIT_V(2); PG8_BAR;
        PG8_STAGE(PG8_SB(1, 0), cB + kstep, voffB); PG8_STAGE(PG8_SA(1, 0), cA + kstep, voffA); PG8_STAGE(PG8_SB(1, 1), cB + hstep + kstep, voffB);
        PG8_WAIT_V(6); PG8_BAR;
    } else {
        PG8_STAGE(PG8_SB(0, 0), cB, voffB); PG8_STAGE(PG8_SA(0, 0), cA, voffA); PG8_STAGE(PG8_SB(0, 1), cB + hstep, voffB); PG8_STAGE(PG8_SA(0, 1), cA + hstep, voffA);
        if (wr == 1) PG8_BAR;
        PG8_WAIT_V(4); PG8_BAR;
        PG8_STAGE(PG8_SB(1, 0), cB + kstep, voffB); PG8_STAGE(PG8_SA(1, 0), cA + kstep, voffA); PG8_STAGE(PG8_SB(1, 1), cB + hstep + kstep, voffB);
        PG8_WAIT_V(6); PG8_BAR;
    }
    for (;;) {
        const bool has_next = S.next(ui + 1, nxt);
        const char* nA = has_next ? (const char*)g.A + (size_t)nxt.pm * tstep : cA; const char* nB = has_next ? (const char*)g.Bt + (size_t)nxt.pn * tstep : cB;
        for (int t = 0; t < nt; t += 2) {
            const bool last = (t == nt - 2);
            const char* a1 = cA + (size_t)(t + 1) * kstep;
            const char* a2 = last ? nA : cA + (size_t)(t + 2) * kstep; const char* b2 = last ? nB : cB + (size_t)(t + 2) * kstep;
            const char* a3 = a2 + kstep; const char* b3 = b2 + kstep;
            if (last && has_next) S.a_ready(nxt);
            if constexpr (SP2) {
            PG8_LDB(B0, 0, 0); PG8_LDB(B1, 0, 1); PG8_SCHED; PG8_LDA(At, 0, 0); PG8_STAGE(PG8_SA(1, 1), a1 + hstep, voffA);
            PG8_WAIT_V(8); PG8_WAIT_L(0); PG8_BAR; PG8_MMA(0, 0, At, B0); PG8_MMA(0, 1, At, B1); PG8_BAR; PG8_SCHED;
            PG8_LDA(At, 0, 1); PG8_STAGE(PG8_SB(0, 0), b2, voffB); PG8_STAGE(PG8_SB(0, 1), b2 + hstep, voffB); PG8_STAGE(PG8_SA(0, 0), a2, voffA);
            PG8_WAIT_V(8); PG8_WAIT_L(0); PG8_BAR; PG8_MMA(1, 0, At, B0); PG8_MMA(1, 1, At, B1); PG8_BAR; PG8_SCHED;
            PG8_LDB(B0, 1, 0); PG8_LDB(B1, 1, 1); PG8_SCHED; PG8_LDA(At, 1, 0); PG8_STAGE(PG8_SA(0, 1), a2 + hstep, voffA);
            PG8_WAIT_V(8); PG8_WAIT_L(0); PG8_BAR; PG8_MMA(0, 0, At, B0); PG8_MMA(0, 1, At, B1); PG8_BAR; PG8_SCHED;
            PG8_LDA(At, 1, 1); PG8_STAGE(PG8_SB(1, 0), b3, voffB); PG8_STAGE(PG8_SB(1, 1), b3 + hstep, voffB); PG8_STAGE(PG8_SA(1, 0), a3, voffA);
            PG8_WAIT_V(8); PG8_WAIT_L(0); PG8_BAR; PG8_MMA(1, 0, At, B0); PG8_MMA(1, 1, At, B1); PG8_BAR; PG8_SCHED;
            } else {
            PG8_LDB(B0, 0, 0); PG8_SCHED; PG8_LDA(At, 0, 0); PG8_STAGE(PG8_SA(1, 1), a1 + hstep, voffA);
            PG8_WAIT_L(8); PG8_BAR; PG8_WAIT_L(0); PG8_MMA(0, 0, At, B0); PG8_BAR; PG8_SCHED;
            PG8_LDB(B1, 0, 1); PG8_STAGE(PG8_SB(0, 0), b2, voffB);
            PG8_BAR; PG8_WAIT_L(0); PG8_MMA(0, 1, At, B1); PG8_BAR;
            PG8_LDA(At, 0, 1); PG8_STAGE(PG8_SA(0, 0), a2, voffA);
            PG8_BAR; PG8_WAIT_L(0); PG8_MMA(1, 0, At, B0); PG8_BAR; PG8_SCHED;
            PG8_STAGE(PG8_SB(0, 1), b2 + hstep, voffB);
            PG8_WAIT_V(6); PG8_BAR; PG8_MMA(1, 1, At, B1); PG8_BAR;
            PG8_LDB(B0, 1, 0); PG8_SCHED; PG8_LDA(At, 1, 0); PG8_STAGE(PG8_SA(0, 1), a2 + hstep, voffA);
            PG8_WAIT_L(8); PG8_BAR; PG8_WAIT_L(0); PG8_MMA(0, 0, At, B0); PG8_BAR; PG8_SCHED;
            PG8_LDB(B1, 1, 1); PG8_STAGE(PG8_SB(1, 0), b3, voffB);
            PG8_BAR; PG8_WAIT_L(0); PG8_MMA(0, 1, At, B1); PG8_BAR;
            PG8_LDA(At, 1, 1); PG8_STAGE(PG8_SA(1, 0), a3, voffA);
            PG8_BAR; PG8_WAIT_L(0); PG8_MMA(1, 0, At, B0); PG8_BAR; PG8_SCHED;
            PG8_STAGE(PG8_SB(1, 1), b3 + hstep, voffB);
            PG8_WAIT_V(6); PG8_BAR; PG8_MMA(1, 1, At, B1); PG8_BAR;
            }
        }
        if constexpr (ALIGN_EPI) { if (wr == 0) PG8_BAR; }
        if constexpr (!Epi::AFTER_DRAIN) { E(acc, cur, wr, wc, fr, fq); S.done(cur); }
        if (!has_next) break;
#pragma unroll
        for (int a = 0; a < 2; ++a)
#pragma unroll
            for (int b = 0; b < 2; ++b)
#pragma unroll
                for (int m = 0; m < 4; ++m)
#pragma unroll
                    for (int n = 0; n < 2; ++n) acc[a][b][m][n] = (f32x4){0.f, 0.f, 0.f, 0.f};
        cur = nxt; cA = nA; cB = nB; ++ui;
        if constexpr (ALIGN_EPI) { if (wr == 1) PG8_BAR; }
    }
    PG8_WAIT_V(0);
    if constexpr (!ALIGN_EPI) { if (wr == 0) PG8_BAR; }
    PG8_BAR;
    if constexpr (Epi::AFTER_DRAIN) { E.fused(acc, cur, wr, wc, fr, fq, lds, wid, lane); S.done(cur); }
#undef PG8_SA
#undef PG8_SB
#undef PG8_STAGE
#undef PG8_LDA
#undef PG8_LDB
#undef PG8_MMA
#undef PG8_WAIT_V
#undef PG8_WAIT_L
#undef PG8_BAR
#undef PG8_SCHED
}
}

#define EPI_DRAIN() asm volatile("s_waitcnt vmcnt(0)" ::: "memory")
struct Epi1 {
  static constexpr bool PERM = false, AFTER_DRAIN = false; P p;
  __device__ __forceinline__ void operator()(const f32x4 (&acc)[2][2][4][2], const pg8::Unit& u, int wr, int wc, int fr, int fq) const {
    const int pn = u.pn;
    if (pn <= 4) {
      bf16_t* dst; int ld, c0; float* ssq; int sst;
      if (pn < 3) { dst = p.qlat; ld = QL; c0 = pn * 256; ssq = p.ssq_q + pn * 4 + wc; sst = 12; } else { dst = p.kvlat; ld = KVL; c0 = (pn - 3) * 256; ssq = p.ssq_kv + (pn - 3) * 4 + wc; sst = 8; }
#pragma unroll
      for (int ai = 0; ai < 2; ++ai)
#pragma unroll
        for (int m = 0; m < 4; ++m) { const int row = u.pm * 256 + ai * 128 + wr * 64 + m * 16 + fr; float s = 0.f;
#pragma unroll
          for (int bj = 0; bj < 2; ++bj)
#pragma unroll
            for (int n = 0; n < 2; ++n) { const f32x4 a = acc[ai][bj][m][n]; s += a[0] * a[0] + a[1] * a[1] + a[2] * a[2] + a[3] * a[3];
              u32x2 w; w.x = pk_bf16(a[0], a[1]); w.y = pk_bf16(a[2], a[3]); *(u32x2*)(dst + (size_t)row * ld + c0 + bj * 128 + wc * 32 + n * 16 + fq * 4) = w; }
          s += __shfl_xor(s, 16); s += __shfl_xor(s, 32);
          if (fq == 0) ssq[(size_t)row * sst] = s; }
    } else if (pn <= 12) {
#pragma unroll
      for (int n = 0; n < 2; ++n) { const int ch = (pn - 5) * 128 + wc * 32 + n * 16 + fq * 4; const float4 ba = *(const float4*)(p.b_glu + ch), bg = *(const float4*)(p.b_glu + 1024 + ch);
#pragma unroll
        for (int ai = 0; ai < 2; ++ai)
#pragma unroll
          for (int m = 0; m < 4; ++m) { const int row = u.pm * 256 + ai * 128 + wr * 64 + m * 16 + fr; const f32x4 a = acc[ai][0][m][n], g = acc[ai][1][m][n];
            u32x2 w; w.x = pk_bf16((a[0] + ba.x) * sigmoidf_(g[0] + bg.x), (a[1] + ba.y) * sigmoidf_(g[1] + bg.y));
            w.y = pk_bf16((a[2] + ba.z) * sigmoidf_(g[2] + bg.z), (a[3] + ba.w) * sigmoidf_(g[3] + bg.w));
            *(u32x2*)(p.cglu + (size_t)row * CC + ch) = w; } }
    } else if (wc == 0) {
#pragma unroll
      for (int ai = 0; ai < 2; ++ai)
#pragma unroll
        for (int m = 0; m < 4; ++m) { const int row = u.pm * 256 + ai * 128 + wr * 64 + m * 16 + fr; const int pos = row & (S - 1);
#pragma unroll
          for (int n = 0; n < 2; ++n) { const int j = n * 16 + fq * 4; const f32x4 x1 = acc[ai][0][m][n], x2 = acc[ai][1][m][n];
            const float4 cs0 = *(const float4*)(p.ropetab + (pos * 32 + j) * 2), cs1 = *(const float4*)(p.ropetab + (pos * 32 + j) * 2 + 4);
            u32x2 lo, hi;
            lo.x = pk_bf16(x1[0] * cs0.x - x2[0] * cs0.y, x1[1] * cs0.z - x2[1] * cs0.w); lo.y = pk_bf16(x1[2] * cs1.x - x2[2] * cs1.y, x1[3] * cs1.z - x2[3] * cs1.w);
            hi.x = pk_bf16(x2[0] * cs0.x + x1[0] * cs0.y, x2[1] * cs0.z + x1[1] * cs0.w); hi.y = pk_bf16(x2[2] * cs1.x + x1[2] * cs1.y, x2[3] * cs1.z + x1[3] * cs1.w);
            *(u32x2*)(p.krope + (size_t)row * RD + j) = lo; *(u32x2*)(p.krope + (size_t)row * RD + 32 + j) = hi; } }
    }
    EPI_DRAIN();
  }
};
struct Epi2q {
  static constexpr bool PERM = false, AFTER_DRAIN = false; P p;
  __device__ __forceinline__ void operator()(const f32x4 (&acc)[2][2][4][2], const pg8::Unit& u, int wr, int wc, int fr, int fq) const {
    const int pn = u.pn;
#pragma unroll
    for (int ai = 0; ai < 2; ++ai)
#pragma unroll
      for (int m = 0; m < 4; ++m) { const int row = u.pm * 256 + ai * 128 + wr * 64 + m * 16 + fr;
        float sq = 0.f;
#pragma unroll
        for (int i = 0; i < 12; i += 4) { const float4 v = *(const float4*)(p.ssq_q + (size_t)row * 12 + i); sq += v.x + v.y + v.z + v.w; }
        const float rs = rsqrtf(sq * (1.f / QL) + EPS);
        if (pn < 4) {
#pragma unroll
          for (int bj = 0; bj < 2; ++bj)
#pragma unroll
            for (int n = 0; n < 2; ++n) { const f32x4 a = acc[ai][bj][m][n]; u32x2 w; w.x = pk_bf16(a[0] * rs, a[1] * rs); w.y = pk_bf16(a[2] * rs, a[3] * rs);
              *(u32x2*)(p.q + (size_t)row * QW + (2 * pn + bj) * 192 + wc * 32 + n * 16 + fq * 4) = w; }
        } else { const int pos = row & (S - 1); bf16_t* dst = p.q + (size_t)row * QW + ((pn - 4) * 4 + wc) * 192 + 128;
#pragma unroll
          for (int n = 0; n < 2; ++n) { const int j = n * 16 + fq * 4; const f32x4 x1 = acc[ai][0][m][n] * rs, x2 = acc[ai][1][m][n] * rs;
            const float4 cs0 = *(const float4*)(p.ropetab + (pos * 32 + j) * 2), cs1 = *(const float4*)(p.ropetab + (pos * 32 + j) * 2 + 4);
            u32x2 lo, hi;
            lo.x = pk_bf16(x1[0] * cs0.x - x2[0] * cs0.y, x1[1] * cs0.z - x2[1] * cs0.w); lo.y = pk_bf16(x1[2] * cs1.x - x2[2] * cs1.y, x1[3] * cs1.z - x2[3] * cs1.w);
            hi.x = pk_bf16(x2[0] * cs0.x + x1[0] * cs0.y, x2[1] * cs0.z + x1[1] * cs0.w); hi.y = pk_bf16(x2[2] * cs1.x + x1[2] * cs1.y, x2[3] * cs1.z + x1[3] * cs1.w);
            *(u32x2*)(dst + j) = lo; *(u32x2*)(dst + 32 + j) = hi; } }
      }
    EPI_DRAIN();
  }
};
struct Epi2kv {
  static constexpr bool PERM = false, AFTER_DRAIN = false; P p;
  __device__ __forceinline__ void operator()(const f32x4 (&acc)[2][2][4][2], const pg8::Unit& u, int wr, int wc, int fr, int fq) const {
#pragma unroll
    for (int ai = 0; ai < 2; ++ai)
#pragma unroll
      for (int m = 0; m < 4; ++m) { const int row = u.pm * 256 + ai * 128 + wr * 64 + m * 16 + fr;
        const float4 v0 = *(const float4*)(p.ssq_kv + (size_t)row * 8), v1 = *(const float4*)(p.ssq_kv + (size_t)row * 8 + 4);
        const float rs = rsqrtf((v0.x + v0.y + v0.z + v0.w + v1.x + v1.y + v1.z + v1.w) * (1.f / KVL) + EPS);
#pragma unroll
        for (int bj = 0; bj < 2; ++bj)
#pragma unroll
          for (int n = 0; n < 2; ++n) { const f32x4 a = acc[ai][bj][m][n]; u32x2 w; w.x = pk_bf16(a[0] * rs, a[1] * rs); w.y = pk_bf16(a[2] * rs, a[3] * rs);
            *(u32x2*)(p.kv + (size_t)row * KVW + u.pn * 256 + bj * 128 + wc * 32 + n * 16 + fq * 4) = w; } }
    EPI_DRAIN();
  }
};
struct Epi3 {
  static constexpr bool PERM = true, AFTER_DRAIN = false; P p;
  __device__ __forceinline__ void operator()(const f32x4 (&acc)[2][2][4][2], const pg8::Unit& u, int wr, int wc, int fr, int fq) const {
    float4 g2[2][2];
#pragma unroll
    for (int bj = 0; bj < 2; ++bj)
#pragma unroll
      for (int n = 0; n < 2; ++n) g2[bj][n] = *(const float4*)(p.ln2_g + u.pn * 256 + bj * 128 + wc * 32 + fq * 8 + n * 4);
#pragma unroll
    for (int ai = 0; ai < 2; ++ai)
#pragma unroll
      for (int m = 0; m < 4; ++m) { const int row = u.pm * 256 + ai * 128 + wr * 64 + m * 16 + fr; float s = 0.f;
#pragma unroll
        for (int bj = 0; bj < 2; ++bj) { const size_t o_ = (size_t)row * D + u.pn * 256 + bj * 128 + wc * 32 + fq * 8;
          const float4 x0 = *(const float4*)(p.x + o_), x1 = *(const float4*)(p.x + o_ + 4); const f32x4 a0 = acc[ai][bj][m][0], a1 = acc[ai][bj][m][1];
          const float h0 = x0.x + a0[0], h1 = x0.y + a0[1], h2 = x0.z + a0[2], h3 = x0.w + a0[3], h4 = x1.x + a1[0], h5 = x1.y + a1[1], h6 = x1.z + a1[2], h7 = x1.w + a1[3];
          s += (h0 * h0 + h1 * h1) + (h2 * h2 + h3 * h3) + (h4 * h4 + h5 * h5) + (h6 * h6 + h7 * h7);
          *(u32x4*)(p.h16 + o_) = (u32x4){pk_bf16(h0, h1), pk_bf16(h2, h3), pk_bf16(h4, h5), pk_bf16(h6, h7)};
          const float4 ga = g2[bj][0], gb = g2[bj][1];
          *(u32x4*)(p.hn + o_) = (u32x4){pk_bf16(h0 * ga.x, h1 * ga.y), pk_bf16(h2 * ga.z, h3 * ga.w), pk_bf16(h4 * gb.x, h5 * gb.y), pk_bf16(h6 * gb.z, h7 * gb.w)}; }
        s += __shfl_xor(s, 16); s += __shfl_xor(s, 32);
        if (fq == 0) p.ssq_h[(size_t)row * 32 + u.pn * 4 + wc] = s; }
    EPI_DRAIN();
  }
};
__device__ __forceinline__ void phase_gemm1_pg8(const P& p, ldsp lds, int bid, int nb) {
  pg8::Gemm g; g.A = p.xn; g.Bt = p.WinT; g.M = T; g.N = NP1; g.K = D;
  pg8::ColMajorOrder S_; S_.nM = T / 256; S_.nwg = (T / 256) * (NP1 / 256); S_.G = nb; S_.c = bid;
  Epi1 E; E.p = p; pg8::gemm_phase<Epi1, pg8::ColMajorOrder, true, true>(lds, g, S_, E);
}
__device__ __forceinline__ void phase_gemm2_pg8(const P& p, ldsp lds, int bid, int nb) {
  { pg8::Gemm g; g.A = p.qlat; g.Bt = p.WuqT; g.M = T; g.N = QW; g.K = QL;
    pg8::ColMajorOrder S_; S_.nM = T / 256; S_.nwg = (T / 256) * (QW / 256); S_.G = nb; S_.c = bid;
    Epi2q E; E.p = p; pg8::gemm_phase<Epi2q, pg8::ColMajorOrder, true, true>(lds, g, S_, E); }
  { pg8::Gemm g; g.A = p.kvlat; g.Bt = p.WukvT; g.M = T; g.N = KVW; g.K = KVL;
    pg8::ColMajorOrder S_; S_.nM = T / 256; S_.nwg = (T / 256) * (KVW / 256); S_.G = nb; S_.c = (bid + 192) % nb;
    Epi2kv E; E.p = p; pg8::gemm_phase<Epi2kv, pg8::ColMajorOrder, true, true>(lds, g, S_, E); }
}
__device__ __forceinline__ void phase_gemm3_pg8(const P& p, ldsp lds, int bid, int nb) {
  pg8::Gemm g; g.A = p.mix; g.Bt = p.WoT; g.M = T; g.N = D; g.K = D;
  pg8::ColMajorOrder S_; S_.nM = T / 256; S_.nwg = (T / 256) * (D / 256); S_.G = nb; S_.c = bid;
  Epi3 E; E.p = p; pg8::gemm_phase<Epi3, pg8::ColMajorOrder, true, true>(lds, g, S_, E);
}
#define XB_TMO      128
#define XB_XCNT(j)  (256  + 64 * (j))
#define XB_XSUB(j)  (1280 + 64 * (j))
#define XB_XGEN(j)  (2304 + 64 * (j))
#define XB_TOP      3328
#define XB_TOPGEN   3392
#define XCD_BAR_WORDS 3456
#define XB_SPIN_CAP (1u << 20)
__device__ __forceinline__ unsigned xb_ld(unsigned* p)              { return __hip_atomic_load(p, __ATOMIC_RELAXED, __HIP_MEMORY_SCOPE_AGENT); }
__device__ __forceinline__ unsigned xb_add(unsigned* p, unsigned v) { return __hip_atomic_fetch_add(p, v, __ATOMIC_RELAXED, __HIP_MEMORY_SCOPE_AGENT); }
__device__ __forceinline__ unsigned xb_xcc_id() { return (unsigned)__builtin_amdgcn_s_getreg((3 << 11) | 20) & 0xFu; }
#define XB_SPIN(cond, bar) do { unsigned _sp = 0; while (cond) { __builtin_amdgcn_s_sleep(1); \
    if ((++_sp & 255u) == 0u) { if (xb_ld(&(bar)[XB_TMO])) break; if (_sp > XB_SPIN_CAP) { atomicAdd(&(bar)[XB_TMO], 1u); break; } } } } while (0)
struct XcdBarrier { unsigned* bar; unsigned x; volatile LAS unsigned* st; };
__device__ __forceinline__ XcdBarrier xcd_barrier_post(unsigned* bar, volatile LAS unsigned* st) {
  XcdBarrier b; b.bar = bar; b.x = xb_xcc_id(); b.st = st;
  if (threadIdx.x == 0) (void)xb_add(&bar[XB_XCNT(b.x)], 1u);
  return b;
}
__device__ __forceinline__ void xcd_barrier_complete(unsigned* bar, unsigned x, unsigned& nloc, unsigned& nx) {
  const unsigned G = gridDim.x * gridDim.y * gridDim.z;
  unsigned sum, cnt, mine, sp = 0u;
  for (;;) {
    sum = 0u; cnt = 0u; mine = 0u;
#pragma unroll
    for (unsigned j = 0; j < 16; ++j) { const unsigned c = xb_ld(&bar[XB_XCNT(j)]); sum += c; cnt += (c > 0u) ? 1u : 0u; mine = (j == x) ? c : mine; }
    if (sum == G) break;
    __builtin_amdgcn_s_sleep(1);
    if ((++sp & 255u) == 0u) { if (xb_ld(&bar[XB_TMO])) break; if (sp > XB_SPIN_CAP) { atomicAdd(&bar[XB_TMO], 1u); break; } }
  }
  nloc = mine > 0u ? mine : 1u; nx = cnt > 0u ? cnt : 1u;
}
__device__ __forceinline__ void xcd_barrier(const XcdBarrier& b) {
  asm volatile("s_waitcnt vmcnt(0)" ::: "memory");
  __syncthreads();
  if (threadIdx.x == 0) {
    unsigned* bar = b.bar;
    __builtin_amdgcn_s_waitcnt(0);
    unsigned nloc = b.st[0], nx = b.st[1];
    if (nloc == 0u) { xcd_barrier_complete(bar, b.x, nloc, nx); b.st[0] = nloc; b.st[1] = nx; }
    const unsigned old = xb_add(&bar[XB_XSUB(b.x)], 1u);
    const unsigned gen = old / nloc;
    if (old + 1u == (gen + 1u) * nloc) {
      __builtin_amdgcn_fence(__ATOMIC_RELEASE, "agent");
      asm volatile("s_waitcnt vmcnt(0)" ::: "memory");
      const unsigned og = xb_add(&bar[XB_TOP], 1u);
      const unsigned tg = og / nx;
      if (og + 1u == (tg + 1u) * nx) xb_add(&bar[XB_TOPGEN], 1u);
      else XB_SPIN(xb_ld(&bar[XB_TOPGEN]) == tg, bar);
      __builtin_amdgcn_fence(__ATOMIC_ACQUIRE, "agent");
      xb_add(&bar[XB_XGEN(b.x)], 1u);
      asm volatile("s_waitcnt vmcnt(0)" ::: "memory");
    } else {
      XB_SPIN(xb_ld(&bar[XB_XGEN(b.x)]) == gen, bar);
      __builtin_amdgcn_fence(__ATOMIC_ACQUIRE, "agent");
      asm volatile("s_waitcnt vmcnt(0)" ::: "memory");
    }
  }
  __syncthreads();
}

__global__ __launch_bounds__(NTHR, 2) void mega_fwd(P p) {
  extern __shared__ __attribute__((aligned(16))) unsigned char smem[];
  ldsp lds = (ldsp)smem;
  volatile LAS unsigned* st = (volatile LAS unsigned*)(lds + LDS_BYTES - 16);
  if (threadIdx.x == 0) { st[0] = 0u; st[1] = 0u; st[2] = 0u; st[3] = 0u; }
  __syncthreads();
  const XcdBarrier bar = xcd_barrier_post(p.bar, st);
  const int bid = blockIdx.x, nb = gridDim.x;
  phase_prep(p, lds, bid, nb, 0, PU0, true); rmsnorm_rows_dev(p.x, p.ln1_g, p.xn, bid, nb);
  xcd_barrier(bar);
  phase_gemm1_pg8(p, lds, bid, nb);
  { const int n1 = ((T / 256) * (NP1 / 256)) % nb, idle = n1 ? nb - n1 : nb;
    if (idle == nb) phase_prep(p, lds, bid, nb, PU0, PUT, false); else if (bid >= n1) phase_prep(p, lds, bid - n1, idle, PU0, PUT, false); }
  xcd_barrier(bar);
  phase_gemm2_pg8(p, lds, bid, nb); phase_conv(p, lds, bid, nb);
  xcd_barrier(bar);
  phase_attn(p, lds, bid, nb);
  xcd_barrier(bar);
  phase_gemm3_pg8(p, lds, bid, nb);
  xcd_barrier(bar);
  phase_route2(p, lds, bid, nb);
  xcd_barrier(bar);
  moe_stream<0>(p, lds, bid, nb);
  moe_stream<1>(p, lds, bid, nb);
  xcd_barrier(bar);
  phase_final(p, bid, nb);
}

static size_t carve(size_t& off, size_t bytes) { const size_t o = off; off += (bytes + 255) & ~(size_t)255; return o; }

extern "C" void kernel_launch(void* const* d_in, const int* in_sizes, int n_in, void* d_out, int out_size, void* d_ws, size_t ws_size, hipStream_t stream) {
  P p{};
  const float** pin = (const float**)&p.x;
  for (int i = 0; i < 22; ++i) pin[i] = (const float*)d_in[i];
  p.out = (float*)d_out;
  char* ws = (char*)d_ws; size_t off = 0;
  p.cnt = (int*)(ws + carve(off, 4096));
  p.bar = (unsigned*)(ws + carve(off, XCD_BAR_WORDS * 4));
  p.moe_done = (unsigned*)(ws + carve(off, 1024));
  p.ssq_h = (float*)(ws + carve(off, (size_t)T * 32 * 4));
  p.rstd_h = (float*)(ws + carve(off, (size_t)T * 4));
  p.h16 = (bf16_t*)(ws + carve(off, (size_t)T * D * 2));
  p.xn = (bf16_t*)(ws + carve(off, (size_t)T * D * 2));
  p.qlat = (bf16_t*)(ws + carve(off, (size_t)T * QL * 2));
  p.kvlat = (bf16_t*)(ws + carve(off, (size_t)T * KVL * 2));
  p.krope = (bf16_t*)(ws + carve(off, (size_t)T * RD * 2));
  p.cglu = (bf16_t*)(ws + carve(off, (size_t)T * CC * 2));
  p.q = (bf16_t*)(ws + carve(off, (size_t)T * QW * 2));
  p.kv = (bf16_t*)(ws + carve(off, (size_t)T * KVW * 2));
  p.mix = (bf16_t*)(ws + carve(off, (size_t)T * D * 2));
  p.hn = (bf16_t*)(ws + carve(off, (size_t)T * D * 2));
  p.hb = (bf16_t*)(ws + carve(off, (size_t)MAXTILES * 256 * DE * 2));
  p.y = (bf16_t*)(ws + carve(off, (size_t)2 * T * D * 2));
  p.ssq_q = (float*)(ws + carve(off, (size_t)T * 12 * 4));
  p.ssq_kv = (float*)(ws + carve(off, (size_t)T * 8 * 4));
  p.h = (float*)(ws + carve(off, (size_t)T * D * 4));
  p.rlog = (float*)(ws + carve(off, (size_t)RSLABS * T * RLD * 4));
  p.convtmp = (float*)(ws + carve(off, (size_t)T * CC * 4));
  p.ropetab = (float*)(ws + carve(off, (size_t)S * 32 * 2 * 4));
  p.list_gate = (float*)(ws + carve(off, (size_t)NE * LCAP * 4));
  p.list_tok = (int*)(ws + carve(off, (size_t)NE * LCAP * 4));
  p.WinT = (bf16_t*)(ws + carve(off, (size_t)NP1 * D * 2));
  p.WuqT = (bf16_t*)(ws + carve(off, (size_t)QW * QL * 2));
  p.WukvT = (bf16_t*)(ws + carve(off, (size_t)KVW * KVL * 2));
  p.WoT = (bf16_t*)(ws + carve(off, (size_t)D * D * 2));
  p.WrT = (bf16_t*)(ws + carve(off, (size_t)256 * D * 2));
  if (off > ws_size) { fprintf(stderr, "kernel_launch: workspace too small (%zu > %zu)\n", off, ws_size); return; }

  static int grid = 0;
  if (grid == 0) {
    int dev = 0, cus = 0, per_cu = 0;
    (void)hipGetDevice(&dev); (void)hipDeviceGetAttribute(&cus, hipDeviceAttributeMultiprocessorCount, dev);
    (void)hipFuncSetAttribute((const void*)mega_fwd, hipFuncAttributeMaxDynamicSharedMemorySize, LDS_BYTES);
    if (hipOccupancyMaxActiveBlocksPerMultiprocessor(&per_cu, (const void*)mega_fwd, NTHR, LDS_BYTES) != hipSuccess || per_cu < 1) { fprintf(stderr, "kernel_launch: occupancy query failed (%d)\n", per_cu); per_cu = 1; }
    (void)hipGetLastError();
    grid = cus * per_cu;
    fprintf(stderr, "kernel_launch: %d CUs x %d = grid %d\n", cus, per_cu, grid);
  }
  (void)hipMemsetAsync(p.bar, 0, XCD_BAR_WORDS * 4, stream);
  mega_fwd<<<grid, NTHR, LDS_BYTES, stream>>>(p);
}
```

```cpp
#include <hip/hip_runtime.h>
#include <cstdint>
#include <cstdio>
#include <type_traits>

typedef unsigned short bf16_t;

constexpr int T = 8192, D = 2048, S = 2048, NB = 4, H = 8;
constexpr int QL = 768, KVL = 512, RD = 64, CC = 1024, INC = 3392;
constexpr int QW = 1536  , KVW = 2048  ;
constexpr int NE = 64, DE = 512, NG = 8, EPG = 8, NRL = 72  ;
constexpr int CW = 31;
constexpr float EPS = 1e-6f;
constexpr int RSLABS = 8, RLD = 128;
constexpr int LCAP = T;
constexpr int MAXTILES = 128;

__device__ __forceinline__ float bf2f(bf16_t v) { return __uint_as_float(((unsigned)v) << 16); }
__device__ __forceinline__ bf16_t f2bf(float f) { unsigned u = __float_as_uint(f); u += 0x7fffu + ((u >> 16) & 1u); return (bf16_t)(u >> 16); }
__device__ __forceinline__ float sigmoidf_(float x) { return __builtin_amdgcn_rcpf(1.f + __builtin_amdgcn_exp2f(-1.4426950408889634f * x)); }
__device__ __forceinline__ float siluf_(float x) { return x * sigmoidf_(x); }

struct P {
  const float *x, *ln1_g, *w_in, *b_glu, *q_norm_g, *w_uq, *kv_norm_g, *w_ukv, *w_dw, *b_dw, *conv_ln_g, *conv_ln_b, *w_o, *ln2_g,
      *w_group, *b_group, *w_router, *b_router, *w_gate, *w_up, *w_down, *final_g;
  float* out;
  bf16_t *xn, *qlat, *kvlat, *krope, *cglu, *q, *kv, *mix, *hn, *hb, *y;
  float *ssq_q, *ssq_kv, *h, *rlog, *convtmp, *ropetab, *list_gate;
  int *cnt, *list_tok;
  bf16_t *WinT, *WuqT, *WukvT, *WoT, *WrT;
  unsigned* bar;
  unsigned* moe_done;
  float *ssq_h, *rstd_h;
  bf16_t* h16;
};

__device__ __forceinline__ float wave_sum(float v) {
#pragma unroll
  for (int o = 32; o > 0; o >>= 1) v += __shfl_xor(v, o);
  return v;
}
#define LAS __attribute__((address_space(3)))
typedef LAS unsigned char* ldsp;
typedef short bf16x8 __attribute__((ext_vector_type(8)));
typedef short s16x4 __attribute__((ext_vector_type(4)));
typedef float f32x4 __attribute__((ext_vector_type(4)));
typedef unsigned u32x2 __attribute__((ext_vector_type(2)));
typedef unsigned u32x4 __attribute__((ext_vector_type(4)));
constexpr int NTHR = 512, BM = 256, BK = 64, TILE_B = BM * BK * 2, STAGE_B = 2 * TILE_B, LDS_BYTES = 163840;
constexpr int NP1 = 3584;

__device__ __forceinline__ unsigned pk_bf16(float lo, float hi) { unsigned r; asm("v_cvt_pk_bf16_f32 %0, %1, %2" : "=v"(r) : "v"(lo), "v"(hi)); return r; }
__device__ __forceinline__ int lds_byte(int r, int c) { const int st = (r >> 4) * 2 + (c >> 5), ob = (r & 15) * 64 + (c & 31) * 2; return st * 1024 + (ob ^ (((ob >> 9) & 1) << 5)); }
__device__ __forceinline__ void stage_rc(int b, int& R, int& C) { const int st = b >> 10, sb = b & 1023, swz = sb ^ (((sb >> 9) & 1) << 5); R = (st >> 1) * 16 + swz / 64; C = (st & 1) * 32 + (swz % 64) / 2; }
__device__ __forceinline__ int trf(int k) { return ((k & 3) << 2) | ((k >> 2) & 3); }
__device__ __forceinline__ int tr_byte(int k, int n) { return (n >> 7) * 16384 + 256 * k + 16 * ((((n & 127) >> 3)) ^ trf(k)) + (n & 7) * 2; }

struct ColSrc { const float* src; int ld; int c; };
template <int WHICH> __device__ __forceinline__ ColSrc colmap(const P& p, int q) {
  ColSrc r; r.src = nullptr; r.ld = 0; r.c = -1;
  if (WHICH == 0) { r.src = p.w_in; r.ld = INC;
    if (q < 1280) r.c = q;
    else if (q < 3328) { const int pl = q - 1280, t = pl >> 8, j = pl & 255; r.c = 1344 + (j >> 7) * 1024 + t * 128 + (j & 127); }
    else { const int j = q - 3328; if (j < 32) r.c = 1280 + j; else if (j >= 128 && j < 160) r.c = 1280 + 32 + (j - 128); } }
  else if (WHICH == 1) { r.src = p.w_uq; r.ld = QW;
    if (q < 1024) { const int t = q >> 8, j = q & 255; r.c = (2 * t + (j >> 7)) * 192 + (j & 127); }
    else { const int t = (q - 1024) >> 8, j = q & 255, bj = j >> 7, wcc = (j >> 5) & 3, d = j & 31; r.c = (t * 4 + wcc) * 192 + 128 + bj * 32 + d; } }
  else if (WHICH == 2) { r.src = p.w_ukv; r.ld = KVW; r.c = q; }
  else if (WHICH == 3) { r.src = p.w_o; r.ld = D; r.c = q; }
  else { if (q < NG) { r.src = p.w_group; r.ld = NG; r.c = q; } else if (q < NRL) { r.src = p.w_router; r.ld = NE; r.c = q - NG; } }
  return r;
}
struct PrepDesc { bf16_t* dst; const float* gain; int K, kt, pt, which; };
__device__ __forceinline__ ColSrc colmap_rt(const P& p, int which, int q) {
  switch (which) { case 0: return colmap<0>(p, q); case 1: return colmap<1>(p, q); case 2: return colmap<2>(p, q); case 3: return colmap<3>(p, q); default: return colmap<4>(p, q); }
}
constexpr int PU0 = (D / 64) * (NP1 / 64), PU1 = (QL / 64) * (QW / 64), PU2 = (KVL / 64) * (KVW / 64), PU3 = (D / 64) * (D / 64), PU4 = (D / 64) * (256 / 64), PUT = PU0 + PU1 + PU2 + PU3 + PU4;
__device__ __forceinline__ PrepDesc prep_desc(const P& p, int u) {
  PrepDesc d; int v = u;
  if (v < PU0) { d.dst = p.WinT; d.gain = nullptr; d.K = D; d.kt = v % (D / 64); d.pt = v / (D / 64); d.which = 0; return d; } v -= PU0;
  if (v < PU1) { d.dst = p.WuqT; d.gain = p.q_norm_g; d.K = QL; d.kt = v % (QL / 64); d.pt = v / (QL / 64); d.which = 1; return d; } v -= PU1;
  if (v < PU2) { d.dst = p.WukvT; d.gain = p.kv_norm_g; d.K = KVL; d.kt = v % (KVL / 64); d.pt = v / (KVL / 64); d.which = 2; return d; } v -= PU2;
  if (v < PU3) { d.dst = p.WoT; d.gain = nullptr; d.K = D; d.kt = v % (D / 64); d.pt = v / (D / 64); d.which = 3; return d; } v -= PU3;
  d.dst = p.WrT; d.gain = nullptr; d.K = D; d.kt = v % (D / 64); d.pt = v / (D / 64); d.which = 4; return d;
}
__device__ __forceinline__ void phase_prep(const P& p, ldsp lds, int bid, int nb) {
  const int t = threadIdx.x, nl = t & 63, ksub = t >> 6, pl = t >> 3, kc = t & 7;
  for (int u0 = bid; u0 < PUT; u0 += 4 * nb) {
    float v[4][8];
#pragma unroll
    for (int b = 0; b < 4; ++b) { const int u = u0 + b * nb;
#pragma unroll
      for (int kk = 0; kk < 8; ++kk) v[b][kk] = 0.f;
      if (u < PUT) { const PrepDesc d = prep_desc(p, u); const ColSrc cs = colmap_rt(p, d.which, d.pt * 64 + nl);
        if (cs.c >= 0) {
#pragma unroll
          for (int kk = 0; kk < 8; ++kk) { const int k = d.kt * 64 + kk * 8 + ksub; float x = cs.src[(size_t)k * cs.ld + cs.c]; if (d.gain) x *= d.gain[k]; v[b][kk] = x; } } } }
#pragma unroll
    for (int b = 0; b < 4; ++b) { LAS float* tl = (LAS float*)(lds + b * 16640);
#pragma unroll
      for (int kk = 0; kk < 8; ++kk) tl[(kk * 8 + ksub) * 65 + nl] = v[b][kk]; }
    __syncthreads();
#pragma unroll
    for (int b = 0; b < 4; ++b) { const int u = u0 + b * nb;
      if (u < PUT) { const PrepDesc d = prep_desc(p, u); const LAS float* tl = (const LAS float*)(lds + b * 16640);
        u32x4 w;
        w.x = pk_bf16(tl[(kc * 8 + 0) * 65 + pl], tl[(kc * 8 + 1) * 65 + pl]); w.y = pk_bf16(tl[(kc * 8 + 2) * 65 + pl], tl[(kc * 8 + 3) * 65 + pl]);
        w.z = pk_bf16(tl[(kc * 8 + 4) * 65 + pl], tl[(kc * 8 + 5) * 65 + pl]); w.w = pk_bf16(tl[(kc * 8 + 6) * 65 + pl], tl[(kc * 8 + 7) * 65 + pl]);
        *(u32x4*)(d.dst + (size_t)(d.pt * 64 + pl) * d.K + d.kt * 64 + kc * 8) = w; } }
    __syncthreads();
  }
  for (int i = bid * NTHR + threadIdx.x; i < S * 32; i += nb * NTHR) { const int pos = i >> 5, f = i & 31;
    const float ang = (float)pos * powf(10000.f, -(float)f / 32.f); p.ropetab[2 * i] = cosf(ang); p.ropetab[2 * i + 1] = sinf(ang); }
  if (bid == 0 && threadIdx.x < 1024) p.cnt[threadIdx.x] = 0;
  if (bid == (nb > 1 ? 1 : 0) && threadIdx.x < 256) p.moe_done[threadIdx.x] = 0u;
}
__device__ __forceinline__ void rmsnorm_rows_dev(const float* __restrict__ in, const float* __restrict__ g, bf16_t* __restrict__ out, int bid, int nb) {
  const int lane = threadIdx.x & 63, w = (bid * NTHR + threadIdx.x) >> 6, nw = nb * (NTHR / 64);
  for (int r = w; r < T; r += 2 * nw) {
    const int r1 = min(r + nw, T - 1); const bool has1 = r + nw < T;
    const float4* s0 = (const float4*)(in + (size_t)r * D); const float4* s1 = (const float4*)(in + (size_t)r1 * D);
    float4 v0[8], v1[8]; float q0 = 0.f, q1 = 0.f;
#pragma unroll
    for (int i = 0; i < 8; ++i) { v0[i] = s0[i * 64 + lane]; v1[i] = s1[i * 64 + lane]; }
#pragma unroll
    for (int i = 0; i < 8; ++i) { q0 += v0[i].x * v0[i].x + v0[i].y * v0[i].y + v0[i].z * v0[i].z + v0[i].w * v0[i].w; q1 += v1[i].x * v1[i].x + v1[i].y * v1[i].y + v1[i].z * v1[i].z + v1[i].w * v1[i].w; }
    q0 = wave_sum(q0); q1 = wave_sum(q1);
    const float rs0 = rsqrtf(q0 * (1.f / D) + EPS), rs1 = rsqrtf(q1 * (1.f / D) + EPS);
#pragma unroll
    for (int i = 0; i < 8; ++i) { const float4 gg = ((const float4*)g)[i * 64 + lane];
      u32x2 o; o.x = pk_bf16(v0[i].x * rs0 * gg.x, v0[i].y * rs0 * gg.y); o.y = pk_bf16(v0[i].z * rs0 * gg.z, v0[i].w * rs0 * gg.w);
      ((u32x2*)(out + (size_t)r * D))[i * 64 + lane] = o;
      if (has1) { u32x2 o1; o1.x = pk_bf16(v1[i].x * rs1 * gg.x, v1[i].y * rs1 * gg.y); o1.y = pk_bf16(v1[i].z * rs1 * gg.z, v1[i].w * rs1 * gg.w);
        ((u32x2*)(out + (size_t)r1 * D))[i * 64 + lane] = o1; } }
  }
}

namespace att {
typedef float f32x16 __attribute__((ext_vector_type(16)));
constexpr int KVBLK = 64, SHM_V = 64 * 128 * 2, SHM_KN = 64 * 128 * 2, SHM_KR = 64 * 64 * 2, SHM_BUF = SHM_V + SHM_KN + SHM_KR;
constexpr float SCALE = 0.07216878364870322f, THR = 8.f;
#define KSWZ(row, colB) ((row) * 256 + ((colB) ^ (((row) & 7) << 4)))
#define KRSWZ(row, colB) ((row) * 128 + ((colB) ^ ((((row) >> 1) & 7) << 4)))
#define SBAR() __builtin_amdgcn_sched_barrier(0)
__device__ __forceinline__ int crow(int r, int hi) { return (r & 3) + 8 * (r >> 2) + 4 * hi; }
__device__ __forceinline__ unsigned cvtpk(float lo, float hi) { unsigned r; asm volatile("v_cvt_pk_bf16_f32 %0, %1, %2" : "=v"(r) : "v"(lo), "v"(hi)); return r; }
__device__ __forceinline__ void partialSM(f32x16& p0, f32x16& p1, float& m_reg, float& mn, float& alpha) {
  constexpr float C = SCALE * 1.4426950408889634f;
  float pmax = p0[0];
#pragma unroll
  for (int r = 1; r < 16; ++r) pmax = fmaxf(pmax, p0[r]);
#pragma unroll
  for (int r = 0; r < 16; ++r) pmax = fmaxf(pmax, p1[r]);
  { auto rr = __builtin_amdgcn_permlane32_swap(__float_as_uint(pmax), __float_as_uint(pmax), false, false);
    pmax = fmaxf(__uint_as_float(rr[0]), __uint_as_float(rr[1])); }
  if (__builtin_expect(__all(pmax - m_reg <= THR / SCALE), 1)) { mn = m_reg; alpha = 1.f; }
  else { mn = fmaxf(m_reg, pmax); alpha = __builtin_amdgcn_exp2f((m_reg - mn) * C); m_reg = mn; }
  const float mnC = -mn * C;
#pragma unroll
  for (int r = 0; r < 16; ++r) p0[r] = fmaf(p0[r], C, mnC);
#pragma unroll
  for (int r = 0; r < 16; ++r) p1[r] = fmaf(p1[r], C, mnC);
#pragma unroll
  for (int r = 0; r < 16; ++r) p0[r] = __builtin_amdgcn_exp2f(p0[r]);
}
__device__ __forceinline__ void finishSM(f32x16& p0, f32x16& p1, float alpha, float& l_reg, bf16x8& pa0, bf16x8& pa1, bf16x8& pa2, bf16x8& pa3) {
#pragma unroll
  for (int r = 0; r < 16; ++r) p1[r] = __builtin_amdgcn_exp2f(p1[r]);
  float ps = 0;
#pragma unroll
  for (int r = 0; r < 16; ++r) ps += p0[r];
#pragma unroll
  for (int r = 0; r < 16; ++r) ps += p1[r];
  { auto rr = __builtin_amdgcn_permlane32_swap(__float_as_uint(ps), __float_as_uint(ps), false, false);
    ps = __uint_as_float(rr[0]) + __uint_as_float(rr[1]); }
  l_reg = l_reg * alpha + ps;
#define PK4(P_, BASE, OUT) do { unsigned a0 = cvtpk(P_[BASE + 0], P_[BASE + 1]), a1 = cvtpk(P_[BASE + 2], P_[BASE + 3]);   \
    unsigned b0 = cvtpk(P_[BASE + 4], P_[BASE + 5]), b1 = cvtpk(P_[BASE + 6], P_[BASE + 7]);                              \
    auto r0 = __builtin_amdgcn_permlane32_swap(a0, b0, false, false); auto r1 = __builtin_amdgcn_permlane32_swap(a1, b1, false, false); \
    u32x4 w = {r0[0], r1[0], r0[1], r1[1]}; OUT = *reinterpret_cast<bf16x8*>(&w); } while (0)
  PK4(p0, 0, pa0); PK4(p0, 8, pa1); PK4(p1, 0, pa2); PK4(p1, 8, pa3);
#undef PK4
}
__device__ __forceinline__ void qkt(f32x16& p0, f32x16& p1, ldsp Kn, ldsp Kr, const bf16x8 (&qr)[8], ldsp qrl, int r32, int hi) {
  asm volatile("" : "+v"(r32), "+v"(hi));
  p0 = f32x16{}; p1 = f32x16{};
#pragma unroll
  for (int d0 = 0; d0 < 8; ++d0) { const int cb = (d0 * 16 + hi * 8) * 2;
    const bf16x8 b0 = *(const LAS bf16x8*)(Kn + KSWZ(r32, cb)); const bf16x8 b1 = *(const LAS bf16x8*)(Kn + KSWZ(32 + r32, cb));
    p0 = __builtin_amdgcn_mfma_f32_32x32x16_bf16(b0, qr[d0], p0, 0, 0, 0); p1 = __builtin_amdgcn_mfma_f32_32x32x16_bf16(b1, qr[d0], p1, 0, 0, 0); }
#pragma unroll
  for (int d0 = 0; d0 < 4; ++d0) { const int cb = (d0 * 16 + hi * 8) * 2;
    const bf16x8 b0 = *(const LAS bf16x8*)(Kr + KRSWZ(r32, cb)); const bf16x8 b1 = *(const LAS bf16x8*)(Kr + KRSWZ(32 + r32, cb));
    const bf16x8 qf = *(const LAS bf16x8*)(qrl + KSWZ(r32, cb + 128));
    p0 = __builtin_amdgcn_mfma_f32_32x32x16_bf16(b0, qf, p0, 0, 0, 0); p1 = __builtin_amdgcn_mfma_f32_32x32x16_bf16(b1, qf, p1, 0, 0, 0); }
}
__device__ __forceinline__ int v_st(int k, int c) { const int kk = (k & ~0xC) | ((k & 4) << 1) | ((k & 8) >> 1); return ((kk >> 3) * 4 + (c >> 5)) * 512 + ((kk & 7) * 32 + (c & 31)) * 2; }
__device__ __forceinline__ int v_rd_base(int lane) { return ((lane & 3) << 3) | (((lane >> 2) & 3) << 6) | (((lane >> 4) & 1) << 5) | (((lane >> 5) & 1) << 8); }
__device__ __forceinline__ s16x4 trr(ldsp vb, int off) { return __builtin_amdgcn_ds_read_tr16_b64_v4i16((LAS s16x4*)(vb + off)); }
__device__ __forceinline__ void pv_one(f32x16& od, ldsp vb, int d0, bf16x8 pa0, bf16x8 pa1, bf16x8 pa2, bf16x8 pa3) {
#define VOFF(ks, half) (d0 * 512 + (ks) * 4096 + (half) * 2048)
  const s16x4 l0 = trr(vb, VOFF(0, 0)), h0 = trr(vb, VOFF(0, 1)), l1 = trr(vb, VOFF(1, 0)), h1 = trr(vb, VOFF(1, 1));
  const s16x4 l2 = trr(vb, VOFF(2, 0)), h2 = trr(vb, VOFF(2, 1)), l3 = trr(vb, VOFF(3, 0)), h3 = trr(vb, VOFF(3, 1));
#undef VOFF
#define PK(L, H_) (bf16x8){L[0], L[1], L[2], L[3], H_[0], H_[1], H_[2], H_[3]}
  od = __builtin_amdgcn_mfma_f32_32x32x16_bf16(pa0, PK(l0, h0), od, 0, 0, 0);
  od = __builtin_amdgcn_mfma_f32_32x32x16_bf16(pa1, PK(l1, h1), od, 0, 0, 0);
  od = __builtin_amdgcn_mfma_f32_32x32x16_bf16(pa2, PK(l2, h2), od, 0, 0, 0);
  od = __builtin_amdgcn_mfma_f32_32x32x16_bf16(pa3, PK(l3, h3), od, 0, 0, 0);
  SBAR();
#undef PK
}
__device__ __forceinline__ void pv_all(f32x16 (&o)[4], ldsp vb, bf16x8 pa0, bf16x8 pa1, bf16x8 pa2, bf16x8 pa3) {
  pv_one(o[0], vb, 0, pa0, pa1, pa2, pa3); pv_one(o[1], vb, 1, pa0, pa1, pa2, pa3); pv_one(o[2], vb, 2, pa0, pa1, pa2, pa3); pv_one(o[3], vb, 3, pa0, pa1, pa2, pa3);
}
__device__ __forceinline__ void attn_unit(const bf16_t* __restrict__ Qb, const bf16_t* __restrict__ Kh, const bf16_t* __restrict__ Krp, bf16_t* __restrict__ Ob, ldsp lds) {
  int tid = threadIdx.x; asm volatile("" : "+v"(tid));
  const int wid = tid >> 6, lane = tid & 63, r32 = lane & 31, hi = lane >> 5;
  LAS float* ws = (LAS float*)(lds + 2 * SHM_BUF) + wid * 64; LAS float* li_l = ws; LAS float* al_l = ws + 32;
  float m_reg = -1e30f, l_reg = 0; f32x16 o[4] = {}; bf16x8 qr[8];
  const bf16_t* Qw = Qb + (size_t)(wid * 32 + r32) * QW + hi * 8;
#pragma unroll
  for (int d0 = 0; d0 < 8; ++d0) qr[d0] = *(const bf16x8*)(Qw + d0 * 16);
  ldsp qrl = lds + 2 * SHM_BUF + 2048 + wid * 8192;
#pragma unroll
  for (int d0 = 0; d0 < 8; ++d0) *(LAS bf16x8*)(qrl + KSWZ(r32, (d0 * 16 + hi * 8) * 2)) = *(const bf16x8*)(Qw + 64 + d0 * 16);
  const int sr = tid >> 4, sc = (tid & 15) * 8, vst0 = v_st(sr, sc), vst1 = v_st(32 + sr, sc);
  const int rr_ = tid >> 3, rc_ = (tid & 7) * 8;
  const int vrb = v_rd_base(lane);
  bf16x8 vs0, vs1, ks0, ks1, krs;
#define VB(b) (lds + (b) * SHM_BUF)
#define KNB(b) (lds + (b) * SHM_BUF + SHM_V)
#define KRB(b) (lds + (b) * SHM_BUF + SHM_V + SHM_KN)
#define SLOAD(k0) do { const bf16_t* kp0 = Kh + (size_t)((k0) + sr) * KVW + sc; const bf16_t* kp1 = Kh + (size_t)((k0) + 32 + sr) * KVW + sc; \
    vs0 = *(const bf16x8*)(kp0 + 128); vs1 = *(const bf16x8*)(kp1 + 128); ks0 = *(const bf16x8*)kp0; ks1 = *(const bf16x8*)kp1; \
    krs = *(const bf16x8*)(Krp + (size_t)((k0) + rr_) * RD + rc_); } while (0)
#define SWRITE(b) do { *(LAS bf16x8*)(VB(b) + vst0) = vs0; *(LAS bf16x8*)(VB(b) + vst1) = vs1; \
    *(LAS bf16x8*)(KNB(b) + KSWZ(sr, sc * 2)) = ks0; *(LAS bf16x8*)(KNB(b) + KSWZ(32 + sr, sc * 2)) = ks1; \
    *(LAS bf16x8*)(KRB(b) + KRSWZ(rr_, rc_ * 2)) = krs; } while (0)
#define RESC(a) do { if (__any((a) < 1.f)) { if (hi == 0) al_l[r32] = (a); asm volatile("s_waitcnt lgkmcnt(0)" ::: "memory"); \
    _Pragma("unroll") for (int d = 0; d < 4; ++d) _Pragma("unroll") for (int r = 0; r < 16; ++r) o[d][r] *= al_l[crow(r, hi)]; } } while (0)
  f32x16 pA0, pA1, pB0, pB1; float mnA, mnB, alA, alB; bf16x8 pa0, pa1, pa2, pa3; constexpr int NT = S / KVBLK;
  SLOAD(0); SWRITE(0); __syncthreads();
  qkt(pA0, pA1, KNB(0), KRB(0), qr, qrl, r32, hi); partialSM(pA0, pA1, m_reg, mnA, alA);
  SLOAD(KVBLK); SWRITE(1); __syncthreads();
  for (int j = 1; j + 1 < NT; j += 2) {
    SBAR(); qkt(pB0, pB1, KNB(1), KRB(1), qr, qrl, r32, hi);
    finishSM(pA0, pA1, alA, l_reg, pa0, pa1, pa2, pa3); SBAR();
    SLOAD((j + 1) * KVBLK); SBAR();
    pv_all(o, VB(0) + vrb, pa0, pa1, pa2, pa3); partialSM(pB0, pB1, m_reg, mnB, alB);
    __syncthreads(); SWRITE(0);
    RESC(alB); __syncthreads();
    SBAR(); qkt(pA0, pA1, KNB(0), KRB(0), qr, qrl, r32, hi);
    finishSM(pB0, pB1, alB, l_reg, pa0, pa1, pa2, pa3); SBAR();
    SLOAD((j + 2) * KVBLK); SBAR();
    pv_all(o, VB(1) + vrb, pa0, pa1, pa2, pa3); partialSM(pA0, pA1, m_reg, mnA, alA);
    __syncthreads(); SWRITE(1);
    RESC(alA); __syncthreads();
  }
  SBAR(); qkt(pB0, pB1, KNB(1), KRB(1), qr, qrl, r32, hi);
  finishSM(pA0, pA1, alA, l_reg, pa0, pa1, pa2, pa3); SBAR();
  pv_all(o, VB(0) + vrb, pa0, pa1, pa2, pa3); partialSM(pB0, pB1, m_reg, mnB, alB);
  __syncthreads(); RESC(alB);
  finishSM(pB0, pB1, alB, l_reg, pa0, pa1, pa2, pa3); SBAR();
  pv_all(o, VB(1) + vrb, pa0, pa1, pa2, pa3);
  if (hi == 0) li_l[r32] = l_reg; asm volatile("s_waitcnt lgkmcnt(0)" ::: "memory");
  float rli[16];
#pragma unroll
  for (int r = 0; r < 16; ++r) rli[r] = __builtin_amdgcn_rcpf(li_l[crow(r, hi)]);
  bf16_t* Ow = Ob + (size_t)(wid * 32) * D;
#pragma unroll
  for (int r = 0; r < 16; ++r) { const int orow = crow(r, hi);
#pragma unroll
    for (int d0 = 0; d0 < 4; ++d0) Ow[(size_t)orow * D + d0 * 32 + r32] = f2bf(o[d0][r] * rli[r]); }
  __syncthreads();
#undef VB
#undef KNB
#undef KRB
#undef SLOAD
#undef SWRITE
#undef RESC
}
}
__device__ __forceinline__ void phase_attn(const P& p, ldsp lds, int bid, int nb) {
  for (int u = bid; u < NB * H * (S / 256); u += nb) {
    const int qb = u & 7, h = (u >> 3) & 7, b = u >> 6;
    const size_t row0 = (size_t)b * S + qb * 256;
    att::attn_unit(p.q + row0 * QW + h * 192, p.kv + (size_t)b * S * KVW + h * 256, p.krope + (size_t)b * S * RD, p.mix + row0 * D + h * 128, lds);
  }
}


__device__ __forceinline__ void phase_conv(const P& p, ldsp lds, int bid, int nb) {
  LAS float* red = (LAS float*)lds;
  for (int u = bid; u < T / 16; u += nb) {
    int tid = threadIdx.x; asm volatile("" : "+v"(tid));
    const int wid = tid >> 6, lane = tid & 63, ch = tid * 2;
    const int t0 = u * 16, b = t0 / S, s0 = t0 % S;
    float w0[CW], w1[CW];
#pragma unroll
    for (int j = 0; j < CW; ++j) { const float2 wv = *(const float2*)(p.w_dw + j * CC + ch); w0[j] = wv.x; w1[j] = wv.y; }
    const float2 bd = *(const float2*)(p.b_dw + ch);
    float a0[16], a1[16];
#pragma unroll
    for (int i = 0; i < 16; ++i) { a0[i] = bd.x; a1[i] = bd.y; }
#pragma unroll
    for (int rr = 0; rr < 46; ++rr) { const int s = s0 - 15 + rr; float v0 = 0.f, v1 = 0.f;
      { const int scl = min(max(s, 0), S - 1); const unsigned raw = *(const unsigned*)(p.cglu + ((size_t)b * S + scl) * CC + ch);
        const bool ok = (s >= 0 && s < S); v0 = ok ? __uint_as_float(raw << 16) : 0.f; v1 = ok ? __uint_as_float(raw & 0xffff0000u) : 0.f; }
#pragma unroll
      for (int i = 0; i < 16; ++i) { const int j = rr - i; if (j >= 0 && j < CW) { a0[i] += w0[j] * v0; a1[i] += w1[j] * v1; } } }
#pragma unroll
    for (int i = 0; i < 16; ++i) { const float sm = wave_sum(a0[i] + a1[i]), sq = wave_sum(a0[i] * a0[i] + a1[i] * a1[i]);
      if (lane == 0) { red[wid * 32 + i] = sm; red[wid * 32 + 16 + i] = sq; } }
    __syncthreads();
    if (tid < 32) { float t = 0.f;
#pragma unroll
      for (int w = 0; w < 8; ++w) t += red[w * 32 + tid];
      red[256 + tid] = t; }
    __syncthreads();
    const float2 lg = *(const float2*)(p.conv_ln_g + ch), lb = *(const float2*)(p.conv_ln_b + ch);
#pragma unroll
    for (int i = 0; i < 16; ++i) { const float mu = red[256 + i] * (1.f / CC), var = red[256 + 16 + i] * (1.f / CC) - mu * mu; const float rs = rsqrtf(fmaxf(var, 0.f) + EPS);
      const float y0 = (a0[i] - mu) * rs * lg.x + lb.x, y1 = (a1[i] - mu) * rs * lg.y + lb.y;
      *(unsigned*)(p.mix + (size_t)(t0 + i) * D + CC + ch) = pk_bf16(siluf_(y0), siluf_(y1)); }
    __syncthreads();
  }
}

__device__ __forceinline__ void phase_route2(const P& p, ldsp lds, int bid, int nb) {
  constexpr int RS = 4096 + 16;
  const int tid = threadIdx.x, wid = tid >> 6, lane = tid & 63, fr = lane & 15, fq = lane >> 4;
  for (int u = bid; u < T / 32; u += nb) {
    const int t0 = u * 32;
    __syncthreads();
#pragma unroll
    for (int i = 0; i < 16; ++i) { const int c = i * 512 + tid, r = c >> 8, pc = c & 255;
      *(LAS u32x4*)(lds + r * RS + pc * 16) = *(const u32x4*)(p.hn + (size_t)(t0 + r) * D + pc * 8); }
    __syncthreads();
    f32x4 acc[2][5];
#pragma unroll
    for (int m = 0; m < 2; ++m)
#pragma unroll
      for (int n = 0; n < 5; ++n) acc[m][n] = (f32x4){0.f, 0.f, 0.f, 0.f};
#pragma unroll 2
    for (int ks = 0; ks < 8; ++ks) { const int k0 = wid * 256 + ks * 32 + fq * 8;
      bf16x8 Bf[5];
#pragma unroll
      for (int n = 0; n < 5; ++n) Bf[n] = *(const bf16x8*)(p.WrT + (size_t)(n * 16 + fr) * D + k0);
      const bf16x8 A0 = *(const LAS bf16x8*)(lds + fr * RS + k0 * 2), A1 = *(const LAS bf16x8*)(lds + (16 + fr) * RS + k0 * 2);
#pragma unroll
      for (int n = 0; n < 5; ++n) { acc[0][n] = __builtin_amdgcn_mfma_f32_16x16x32_bf16(Bf[n], A0, acc[0][n], 0, 0, 0); acc[1][n] = __builtin_amdgcn_mfma_f32_16x16x32_bf16(Bf[n], A1, acc[1][n], 0, 0, 0); } }
    __syncthreads();
    LAS float* part = (LAS float*)lds;
#pragma unroll
    for (int m = 0; m < 2; ++m)
#pragma unroll
      for (int n = 0; n < 5; ++n) *(LAS f32x4*)(part + (wid * 32 + m * 16 + fr) * 80 + n * 16 + fq * 4) = acc[m][n];
    __syncthreads();
    LAS float* lg_ = part + 8 * 32 * 80;
    for (int o = tid; o < 32 * 80; o += NTHR) { float s = 0.f;
#pragma unroll
      for (int w = 0; w < 8; ++w) s += part[w * 2560 + o];
      lg_[o] = s; }
    __syncthreads();
    if (tid < 32) { const int t = t0 + tid; const LAS float* L_ = lg_ + tid * 80;
      float sq = 0.f;
#pragma unroll
      for (int i = 0; i < 32; i += 4) { const float4 v = *(const float4*)(p.ssq_h + (size_t)t * 32 + i); sq += (v.x + v.y) + (v.z + v.w); }
      const float rs = rsqrtf(sq * (1.f / D) + EPS); p.rstd_h[t] = rs;
      float lg[NG];
#pragma unroll
      for (int j = 0; j < NG; ++j) lg[j] = L_[j] * rs + p.b_group[j];
      int gs = 0; float gm = lg[0];
#pragma unroll
      for (int j = 1; j < NG; ++j) if (lg[j] > gm) { gm = lg[j]; gs = j; }
      float gsum = 0.f;
#pragma unroll
      for (int j = 0; j < NG; ++j) gsum += __expf(lg[j] - gm);
      const float pg = 1.f / gsum;
      float el[EPG];
#pragma unroll
      for (int j = 0; j < EPG; ++j) el[j] = L_[NG + gs * EPG + j] * rs + p.b_router[gs * EPG + j];
      int i1 = 0; float m1 = el[0];
#pragma unroll
      for (int j = 1; j < EPG; ++j) if (el[j] > m1) { m1 = el[j]; i1 = j; }
      int i2 = -1; float m2 = -1e30f;
#pragma unroll
      for (int j = 0; j < EPG; ++j) if (j != i1 && el[j] > m2) { m2 = el[j]; i2 = j; }
      const float e2 = __expf(m2 - m1); const float w1 = 1.f / (1.f + e2), w2 = e2 / (1.f + e2);
      const int ea = gs * EPG + i1, eb = gs * EPG + i2;
      const int pa = atomicAdd(&p.cnt[ea], 1); p.list_tok[ea * LCAP + pa] = t * 2; p.list_gate[ea * LCAP + pa] = pg * w1;
      const int pb = atomicAdd(&p.cnt[eb], 1); p.list_tok[eb * LCAP + pb] = t * 2 + 1; p.list_gate[eb * LCAP + pb] = pg * w2;
    }
  }
}
__device__ __forceinline__ int trw(int k, int c) { return (c >> 4) * 2080 + (k >> 4) * 512 + (((k & 15) * 32) ^ (((k >> 3) & 1) << 7)) + (c & 15) * 2; }
struct MoeUnit { int e, m0, count, sl, start, tile; };
template <int MODE, int PROBE = 0>
__device__ __forceinline__ void moe_stream(const P& p, ldsp lds, int bid, int nb) {
  constexpr int NS = MODE == 0 ? 8 : 16, NK = MODE == 0 ? D / BK : DE / BK, MROWS = 320, NFM = 5, MA_B = MROWS * 128, MSTAGE = MA_B + 16640 + 256;
  constexpr int TAB_OFF = 2 * MSTAGE + 1024, TAB_UNIT = MROWS * 8, CAP = (LDS_BYTES - 16 - TAB_OFF) / TAB_UNIT;
  LAS int* ts = (LAS int*)(lds + 2 * MSTAGE);
  LAS int* stt = ts + 80; LAS int* cntl = ts + 160;
  __syncthreads();
  if (threadIdx.x < NE) cntl[threadIdx.x] = p.cnt[threadIdx.x];
  __syncthreads();
  if (threadIdx.x == 0) { int s = 0, r = 0; for (int e = 0; e < NE; ++e) { const int c = cntl[e]; ts[e] = s; stt[e] = r; s += (c + MROWS - 1) / MROWS; r += c; } ts[NE] = s; stt[NE] = r; }
  __syncthreads();
  const int ntile = ts[NE];
  int xcd, slot, nslots, nloc;
  if ((nb & 7) == 0) { xcd = bid & 7; slot = bid >> 3; nslots = nb >> 3; nloc = ((ntile - xcd + 7) >> 3) * NS; }
  else { xcd = 0; slot = bid; nslots = nb; nloc = ntile * NS; }
  int nu_all = nloc > slot ? (nloc - slot + nslots - 1) / nslots : 0, doff = 0;
  if (MODE == 1) {
    const int nlu = nloc / 2, ubase = nlu / nslots, urem = nlu % nslots, Tt = (4 * nlu + nloc + nslots - 1) / nslots;
    int rem = nloc; nu_all = 0;
    for (int k = 0; k < nslots; ++k) { const int sidx = (k + urem) % nslots, U = sidx < urem ? ubase + 1 : ubase; const int d = min(max(0, Tt - 4 * U), rem);
      if (sidx == slot) { doff = nloc - rem; nu_all = d; } rem -= d; }
  }
  int tid = threadIdx.x; asm volatile("" : "+v"(tid));
  const int wid = tid >> 6, lane = tid & 63, wm = wid >> 1, wn = wid & 1, fr = lane & 15, fq = lane >> 4;
  const bf16_t* abase = MODE == 0 ? p.hn : p.hb;
  constexpr int LDB = (PROBE & 1) ? 128 : (MODE == 0 ? DE : D);
  for (int c0 = 0; c0 < nu_all; c0 += CAP) {
    const int nu = min(CAP, nu_all - c0), total = nu * NK;
    auto unit_of = [&](int j) { MoeUnit u; const int l = MODE == 0 ? slot + (c0 + j) * nslots : doff + c0 + j; const int tile = ((nb & 7) == 0) ? (l / NS) * 8 + xcd : l / NS; u.sl = l % NS; u.tile = tile;
      int e = 0;
#pragma unroll 1
      for (int s = 32; s > 0; s >>= 1) if (e + s < NE && ts[e + s] <= tile) e += s;
      u.e = e; u.m0 = (tile - ts[e]) * MROWS; u.count = min(MROWS, cntl[e] - u.m0); u.start = stt[e]; return u; };
    __syncthreads();
    for (int j = 0; j < nu; ++j) { const MoeUnit u = unit_of(j);
      for (int r = threadIdx.x; r < MROWS; r += NTHR) { const int rr = min(r, u.count - 1);
        if (MODE == 0) { const int tk = p.list_tok[u.e * LCAP + u.m0 + rr] >> 1; ((LAS unsigned*)(lds + TAB_OFF + j * TAB_UNIT))[r] = (unsigned)(tk * D); ((LAS float*)(lds + TAB_OFF + j * TAB_UNIT + MROWS * 4))[r] = p.rstd_h[tk]; }
        else { ((LAS int*)(lds + TAB_OFF + j * TAB_UNIT))[r] = p.list_tok[u.e * LCAP + u.m0 + rr]; ((LAS float*)(lds + TAB_OFF + j * TAB_UNIT + MROWS * 4))[r] = p.list_gate[u.e * LCAP + u.m0 + rr]; } } }
    asm volatile("s_waitcnt vmcnt(0)" ::: "memory");
    __syncthreads();
    unsigned ao[NFM]; int a_j = -1, a_tile = -1;
    auto a_setup = [&](int j) { const MoeUnit u = unit_of(j); a_j = j;
      if (MODE == 1 && u.tile != a_tile) {
        if (wid == 0) { unsigned sp = 0; while (__hip_atomic_load(p.moe_done + u.tile, __ATOMIC_RELAXED, __HIP_MEMORY_SCOPE_AGENT) < 8u) { __builtin_amdgcn_s_sleep(8); if (++sp > (1u << 22)) break; }
          __builtin_amdgcn_fence(__ATOMIC_ACQUIRE, "agent"); asm volatile("s_waitcnt vmcnt(0)" ::: "memory"); }
        __syncthreads(); a_tile = u.tile; }
#pragma unroll
      for (int i = 0; i < NFM; ++i) { int R, C; stage_rc(wid * 1024 + i * 8192 + lane * 16, R, C);
        if (MODE == 0) ao[i] = ((const LAS unsigned*)(lds + TAB_OFF + j * TAB_UNIT))[R] + C; else ao[i] = (unsigned)((u.start + u.m0 + min(R, u.count - 1)) * DE + C); } };
    const float* bsrc = nullptr; int b_j = -1;
    auto b_setup = [&](int j) { const MoeUnit u = unit_of(j); b_j = j; const int tc = (lane & 31) * 4;
      if (PROBE & 1) { if (MODE == 0) bsrc = p.w_gate + (size_t)((u.tile * NS + u.sl) & 255) * D * 128 + (size_t)(8 * wid + (lane >> 5)) * 128 + tc; else bsrc = p.w_down + (size_t)((u.tile * NS + u.sl) & 1023) * DE * 128 + (size_t)(8 * wid + (lane >> 5)) * 128 + tc; }
      else if (MODE == 0) { const int jj = tc & 63; bsrc = (jj < 32 ? p.w_gate : p.w_up) + (size_t)u.e * D * DE + (size_t)(8 * wid + (lane >> 5)) * DE + u.sl * 64 + (tc >> 6) * 32 + (jj & 31); }
      else bsrc = p.w_down + (size_t)u.e * DE * D + (size_t)(8 * wid + (lane >> 5)) * D + u.sl * 128 + tc; };
    u32x4 ar0[NFM]; float4 br0[4], br1[4];
    f32x4 acc[NFM][4];
#pragma unroll
    for (int i = 0; i < NFM; ++i)
#pragma unroll
      for (int n = 0; n < 4; ++n) acc[i][n] = (f32x4){0.f, 0.f, 0.f, 0.f};
#define A_ISSUE(AR, pos_) do { const int pos = min((pos_), total - 1); const int j_ = pos / NK, kt_ = pos % NK; if (j_ != a_j) a_setup(j_); \
      _Pragma("unroll") for (int i = 0; i < NFM; ++i) AR[i] = *(const u32x4*)(abase + ao[i] + kt_ * BK); } while (0)
#define B_ISSUE(BR, pos_) do { const int pos = min((pos_), total - 1); const int j_ = pos / NK, kt_ = pos % NK; if (j_ != b_j) b_setup(j_); \
      _Pragma("unroll") for (int q = 0; q < 4; ++q) BR[q] = *(const float4*)(bsrc + (size_t)(kt_ * BK + 2 * q) * LDB); } while (0)
#define A_WRITE(AR, buf) do { int t_ = tid; asm volatile("" : "+v"(t_)); const int w_i = t_ >> 6, l_i = t_ & 63; \
      _Pragma("unroll") for (int i = 0; i < NFM; ++i) *(LAS u32x4*)(lds + (buf) * MSTAGE + w_i * 1024 + i * 8192 + l_i * 16) = AR[i]; } while (0)
#define B_WRITE(BR, buf) do { int t_ = tid; asm volatile("" : "+v"(t_)); const int w_i = t_ >> 6, l_i = t_ & 63; \
      _Pragma("unroll") for (int q = 0; q < 4; ++q) { u32x2 w_; w_.x = pk_bf16(BR[q].x, BR[q].y); w_.y = pk_bf16(BR[q].z, BR[q].w); \
      const int tc_ = (l_i & 31) * 4, ic_ = MODE == 1 ? ((tc_ & 64) | (((tc_ >> 2) & 3) << 4) | (((tc_ >> 4) & 3) << 2)) : tc_;     \
      *(LAS u32x2*)(lds + (buf) * MSTAGE + MA_B + trw(8 * w_i + 2 * q + (l_i >> 5), ic_)) = w_; } } while (0)
    int c_j = 0; MoeUnit cu = unit_of(0); int nvf = max(0, min(NFM, ((cu.count + 15) / 16 - wm + 3) >> 2));
    auto compute_nf = [&](int buf, auto nfc) {
      constexpr int NF = decltype(nfc)::value;
      ldsp sb = lds + buf * MSTAGE;
      int t_ = tid; asm volatile("" : "+v"(t_));
      const int wn_ = (t_ >> 6) & 1, wm_ = t_ >> 7, fr_ = t_ & 15, fq_ = (t_ >> 4) & 3, q_ = fr_ >> 2, pp_ = fr_ & 3;
      const int lp0 = (fq_ >> 1) * 512 + (fq_ & 1) * 256 + ((fq_ & 1) << 7) + q_ * 32 + pp_ * 8;
      const int trb0 = MA_B + wn_ * 4 * 2080 + lp0, trb1 = MA_B + wn_ * 4 * 2080 + (lp0 ^ 128);
      const int afb = lds_byte(wm_ * 16 + fr_, fq_ * 8);
#pragma unroll
      for (int ks = 0; ks < 2; ++ks) {
        bf16x8 Bf[4];
#pragma unroll
        for (int n = 0; n < 4; ++n) {
          const s16x4 lo = __builtin_amdgcn_ds_read_tr16_b64_v4i16((LAS s16x4*)(sb + trb0 + n * 2080 + ks * 1024));
          const s16x4 hi = __builtin_amdgcn_ds_read_tr16_b64_v4i16((LAS s16x4*)(sb + trb1 + n * 2080 + ks * 1024));
          Bf[n] = __builtin_shufflevector(lo, hi, 0, 1, 2, 3, 4, 5, 6, 7); }
        bf16x8 At[NF];
#pragma unroll
        for (int i = 0; i < NF; ++i) At[i] = *(const LAS bf16x8*)(sb + afb + i * 8192 + ks * 1024);
#pragma unroll
        for (int i = 0; i < NF; ++i)
#pragma unroll
          for (int n = 0; n < 4; ++n) acc[i][n] = __builtin_amdgcn_mfma_f32_16x16x32_bf16(Bf[n], At[i], acc[i][n], 0, 0, 0);
        __builtin_amdgcn_sched_barrier(0);
      }
    };
    auto compute = [&](int buf) {
      if (nvf <= 4) compute_nf(buf, std::integral_constant<int, 4>()); else compute_nf(buf, std::integral_constant<int, 5>()); };
    auto epilogue = [&]() {
      int fr2 = fr, fq2 = fq; asm volatile("" : "+v"(fr2), "+v"(fq2));
#pragma unroll
      for (int i = 0; i < NFM; ++i) { const int r = (wm + 4 * i) * 16 + fr2;
        if (r < cu.count) {
          if (MODE == 0) { bf16_t* dst = ((PROBE & 1) ? (bf16_t*)p.convtmp : p.hb) + (size_t)(cu.start + cu.m0 + r) * DE + cu.sl * 64 + wn * 32 + fq2 * 4;
            const float rs = ((const LAS float*)(lds + TAB_OFF + c_j * TAB_UNIT + MROWS * 4))[r];
#pragma unroll
            for (int n = 0; n < 2; ++n) { const f32x4 g = acc[i][n] * rs, uu = acc[i][n + 2] * rs;
              const unsigned lo = pk_bf16(siluf_(g[0]) * uu[0], siluf_(g[1]) * uu[1]), hi = pk_bf16(siluf_(g[2]) * uu[2], siluf_(g[3]) * uu[3]);
              __hip_atomic_store((unsigned long long*)(dst + n * 16), ((unsigned long long)hi << 32) | lo, __ATOMIC_RELAXED, __HIP_MEMORY_SCOPE_AGENT); } }
          else { const int ts2 = ((const LAS int*)(lds + TAB_OFF + c_j * TAB_UNIT))[r]; const float gate = ((const LAS float*)(lds + TAB_OFF + c_j * TAB_UNIT + MROWS * 4))[r];
            bf16_t* dst = p.y + (size_t)ts2 * D + cu.sl * 128 + wn * 64 + fq2 * 16;
            u32x4 w0, w1;
            w0.x = pk_bf16(acc[i][0][0] * gate, acc[i][0][1] * gate); w0.y = pk_bf16(acc[i][0][2] * gate, acc[i][0][3] * gate); w0.z = pk_bf16(acc[i][1][0] * gate, acc[i][1][1] * gate); w0.w = pk_bf16(acc[i][1][2] * gate, acc[i][1][3] * gate);
            w1.x = pk_bf16(acc[i][2][0] * gate, acc[i][2][1] * gate); w1.y = pk_bf16(acc[i][2][2] * gate, acc[i][2][3] * gate); w1.z = pk_bf16(acc[i][3][0] * gate, acc[i][3][1] * gate); w1.w = pk_bf16(acc[i][3][2] * gate, acc[i][3][3] * gate);
            if (!(PROBE & 16)) { *(u32x4*)dst = w0; *(u32x4*)(dst + 8) = w1; } else asm volatile("" :: "v"(w0.x), "v"(w1.x)); }
        }
#pragma unroll
        for (int n = 0; n < 4; ++n) acc[i][n] = (f32x4){0.f, 0.f, 0.f, 0.f};
      }
    };
    A_ISSUE(ar0, 0); B_ISSUE(br0, 0); A_WRITE(ar0, 0); B_WRITE(br0, 0);
    B_ISSUE(br1, 1); A_ISSUE(ar0, 1); B_ISSUE(br0, 2);
    __syncthreads();
#define STEP(s, BRW, ARW) do { \
      if (!(PROBE & 4)) A_WRITE(ar0, ((s) + 1) & 1); if (!(PROBE & 32)) B_WRITE(BRW, ((s) + 1) & 1); else asm volatile("" :: "v"(BRW[0].x), "v"(BRW[1].x), "v"(BRW[2].x), "v"(BRW[3].x)); \
      if (!(PROBE & 4)) A_ISSUE(ar0, (s) + 2); if (!(PROBE & 8)) B_ISSUE(BRW, (s) + 3); \
      if (!(PROBE & 2)) compute((s) & 1); \
      int sig_ = -1; \
      if (((s) + 1) % NK == 0) { epilogue(); __builtin_amdgcn_s_waitcnt(0x0F70); sig_ = cu.tile; if ((s) + 1 < total) { c_j = ((s) + 1) / NK; cu = unit_of(c_j); nvf = max(0, min(NFM, ((cu.count + 15) / 16 - wm + 3) >> 2)); } } \
      asm volatile("s_waitcnt lgkmcnt(0)" ::: "memory"); __builtin_amdgcn_s_barrier(); \
      if (MODE == 0 && !PROBE && sig_ >= 0 && threadIdx.x == 0) __hip_atomic_fetch_add(p.moe_done + sig_, 1u, __ATOMIC_RELAXED, __HIP_MEMORY_SCOPE_AGENT);     \
      } while (0)
    for (int s = 0; s < total; s += 2) { STEP(s, br1, ar1); STEP(s + 1, br0, ar0); }
    asm volatile("s_waitcnt vmcnt(0)" ::: "memory");
#undef STEP
#undef A_ISSUE
#undef B_ISSUE
#undef A_WRITE
#undef B_WRITE
  }
}
template <int MODE>
__device__ __forceinline__ void moe_wide(const P& p, ldsp lds, int bid, int nb) {
  constexpr int NS = MODE == 0 ? 4 : 8, NK = MODE == 0 ? D / BK : DE / BK, MROWS = 320, NFM = 5, MA_B = MROWS * 128, MSTAGE = MA_B + 16 * 2080 + 256;
  constexpr int TAB_OFF = 2 * MSTAGE + 1024, TAB_UNIT = MROWS * 8, CAP = (LDS_BYTES - 16 - TAB_OFF) / TAB_UNIT;
  static_assert(CAP >= 2, "LDS");
  LAS int* ts = (LAS int*)(lds + 2 * MSTAGE);
  LAS int* stt = ts + 80; LAS int* cntl = ts + 160;
  __syncthreads();
  if (threadIdx.x < NE) cntl[threadIdx.x] = p.cnt[threadIdx.x];
  __syncthreads();
  if (threadIdx.x == 0) { int s = 0, r = 0; for (int e = 0; e < NE; ++e) { const int c = cntl[e]; ts[e] = s; stt[e] = r; s += (c + MROWS - 1) / MROWS; r += c; } ts[NE] = s; stt[NE] = r; }
  __syncthreads();
  const int ntile = ts[NE];
  int xcd, slot, nslots, nloc;
  if ((nb & 7) == 0) { xcd = bid & 7; slot = bid >> 3; nslots = nb >> 3; nloc = ((ntile - xcd + 7) >> 3) * NS; }
  else { xcd = 0; slot = bid; nslots = nb; nloc = ntile * NS; }
  int nu_all = nloc > slot ? (nloc - slot + nslots - 1) / nslots : 0, doff = 0;
  if (MODE == 1) {
    const int nlu = nloc  , ubase = nlu / nslots, urem = nlu % nslots, Tt = (3 * nlu + nloc + nslots - 1) / nslots;
    int rem = nloc; nu_all = 0;
    for (int k = 0; k < nslots; ++k) { const int sidx = (k + urem) % nslots, U = sidx < urem ? ubase + 1 : ubase; const int d = min(max(0, Tt - 3 * U), rem);
      if (sidx == slot) { doff = nloc - rem; nu_all = d; } rem -= d; }
  }
  int tid = threadIdx.x; asm volatile("" : "+v"(tid));
  const int wid = tid >> 6, lane = tid & 63, wm = wid >> 1, wn = wid & 1, fr = lane & 15, fq = lane >> 4;
  const int widu = __builtin_amdgcn_readfirstlane(tid >> 6);
  const bf16_t* abase = MODE == 0 ? p.hn : p.hb;
  constexpr int LDB = MODE == 0 ? DE : D;
  for (int c0 = 0; c0 < nu_all; c0 += CAP) {
    const int nu = min(CAP, nu_all - c0), total = nu * NK;
    auto unit_of = [&](int j) { MoeUnit u; const int l = MODE == 0 ? slot + (c0 + j) * nslots : doff + c0 + j; const int tile = ((nb & 7) == 0) ? (l / NS) * 8 + xcd : l / NS; u.sl = l % NS; u.tile = tile;
      int e = 0;
#pragma unroll 1
      for (int s = 32; s > 0; s >>= 1) if (e + s < NE && ts[e + s] <= tile) e += s;
      u.e = e; u.m0 = (tile - ts[e]) * MROWS; u.count = min(MROWS, cntl[e] - u.m0); u.start = stt[e]; return u; };
    __syncthreads();
    for (int j = 0; j < nu; ++j) { const MoeUnit u = unit_of(j);
      for (int r = threadIdx.x; r < MROWS; r += NTHR) { const int rr = min(r, u.count - 1);
        if (MODE == 0) { const int tk = p.list_tok[u.e * LCAP + u.m0 + rr] >> 1; ((LAS unsigned*)(lds + TAB_OFF + j * TAB_UNIT))[r] = (unsigned)(tk * D); ((LAS float*)(lds + TAB_OFF + j * TAB_UNIT + MROWS * 4))[r] = p.rstd_h[tk]; }
        else { ((LAS int*)(lds + TAB_OFF + j * TAB_UNIT))[r] = p.list_tok[u.e * LCAP + u.m0 + rr]; ((LAS float*)(lds + TAB_OFF + j * TAB_UNIT + MROWS * 4))[r] = p.list_gate[u.e * LCAP + u.m0 + rr]; } } }
    asm volatile("s_waitcnt vmcnt(0)" ::: "memory");
    __syncthreads();
    unsigned ao[NFM]; int a_j = -1, a_tile = -1;
    auto a_setup = [&](int j) { const MoeUnit u = unit_of(j); a_j = j;
      if (MODE == 1 && u.tile != a_tile) {
        if (wid == 0) { unsigned sp = 0; while (__hip_atomic_load(p.moe_done + u.tile, __ATOMIC_RELAXED, __HIP_MEMORY_SCOPE_AGENT) < 8u) { __builtin_amdgcn_s_sleep(8); if (++sp > (1u << 22)) break; }
          __builtin_amdgcn_fence(__ATOMIC_ACQUIRE, "agent"); asm volatile("s_waitcnt vmcnt(0)" ::: "memory"); }
        __syncthreads(); a_tile = u.tile; }
#pragma unroll
      for (int i = 0; i < NFM; ++i) { int R, C; stage_rc(wid * 1024 + i * 8192 + lane * 16, R, C);
        if (MODE == 0) ao[i] = ((const LAS unsigned*)(lds + TAB_OFF + j * TAB_UNIT))[R] + C; else ao[i] = (unsigned)((u.start + u.m0 + min(R, u.count - 1)) * DE + C); } };
    const float* bsrc = nullptr; int b_j = -1;
    auto b_setup = [&](int j) { const MoeUnit u = unit_of(j); b_j = j; const int tc = lane * 4;
      if (MODE == 0) { const int jj = tc & 127; bsrc = (jj < 64 ? p.w_gate : p.w_up) + (size_t)u.e * D * DE + (size_t)(8 * wid) * DE + u.sl * 128 + (tc >> 7) * 64 + (jj & 63); }
      else bsrc = p.w_down + (size_t)u.e * DE * D + (size_t)(8 * wid) * D + u.sl * 256 + tc; };
    f32x4 br[8];
    f32x4 acc[NFM][8];
#pragma unroll
    for (int i = 0; i < NFM; ++i)
#pragma unroll
      for (int n = 0; n < 8; ++n) acc[i][n] = (f32x4){0.f, 0.f, 0.f, 0.f};
#define A_DMA(buf, pos_) do { const int pos = min((pos_), total - 1); const int j_ = pos / NK, kt_ = pos % NK; if (j_ != a_j) a_setup(j_); \
      _Pragma("unroll") for (int i = 0; i < NFM; ++i) { unsigned keep_; const bf16_t* g_ = abase + ao[i] + kt_ * BK; const unsigned d_ = (unsigned)(uintptr_t)(lds + (buf) * MSTAGE) + (unsigned)(widu * 1024 + i * 8192); \
        asm volatile("s_mov_b32 %0, m0\n\ts_mov_b32 m0, %2\n\ts_nop 0\n\tglobal_load_lds_dwordx4 %1, off\n\ts_mov_b32 m0, %0" : "=&s"(keep_) : "v"(g_), "s"(d_) : "memory"); } } while (0)
#define B_ISSUE(pos_) do { const int pos = min((pos_), total - 1); const int j_ = pos / NK, kt_ = pos % NK; if (j_ != b_j) b_setup(j_); \
      _Pragma("unroll") for (int q = 0; q < 8; ++q) br[q] = *(const f32x4*)(bsrc + (size_t)(kt_ * BK + q) * LDB); } while (0)
#define B_WRITE(buf) do { int t_ = tid; asm volatile("" : "+v"(t_)); const int w_i = t_ >> 6, tc_ = (t_ & 63) * 4; \
      const int ic_ = MODE == 1 ? ((tc_ & 192) | (((tc_ >> 2) & 3) << 4) | (((tc_ >> 4) & 3) << 2)) : tc_;     \
      _Pragma("unroll") for (int q = 0; q < 8; ++q) { u32x2 w_; w_.x = pk_bf16(br[q][0], br[q][1]); w_.y = pk_bf16(br[q][2], br[q][3]); \
      *(LAS u32x2*)(lds + (buf) * MSTAGE + MA_B + trw(8 * w_i + q, ic_)) = w_; } } while (0)
    int c_j = 0; MoeUnit cu = unit_of(0);
    auto compute = [&](int buf) {
      ldsp sb = lds + buf * MSTAGE;
      int t_ = tid; asm volatile("" : "+v"(t_));
      const int wn_ = (t_ >> 6) & 1, wm_ = t_ >> 7, fr_ = t_ & 15, fq_ = (t_ >> 4) & 3, q_ = fr_ >> 2, pp_ = fr_ & 3;
      const int lp0 = (fq_ >> 1) * 512 + (fq_ & 1) * 256 + ((fq_ & 1) << 7) + q_ * 32 + pp_ * 8;
      const int trb0 = MA_B + wn_ * 8 * 2080 + lp0, trb1 = MA_B + wn_ * 8 * 2080 + (lp0 ^ 128);
      const int afb = lds_byte(wm_ * 16 + fr_, fq_ * 8);
#pragma unroll
      for (int ks = 0; ks < 2; ++ks)
#pragma unroll
        for (int h = 0; h < 2; ++h) {
          bf16x8 Bf[4];
#pragma unroll
          for (int n = 0; n < 4; ++n) {
            const s16x4 lo = __builtin_amdgcn_ds_read_tr16_b64_v4i16((LAS s16x4*)(sb + trb0 + (h * 4 + n) * 2080 + ks * 1024));
            const s16x4 hi = __builtin_amdgcn_ds_read_tr16_b64_v4i16((LAS s16x4*)(sb + trb1 + (h * 4 + n) * 2080 + ks * 1024));
            Bf[n] = __builtin_shufflevector(lo, hi, 0, 1, 2, 3, 4, 5, 6, 7); }
#pragma unroll
          for (int i = 0; i < NFM; ++i) { const bf16x8 At = *(const LAS bf16x8*)(sb + afb + i * 8192 + ks * 1024);
#pragma unroll
            for (int n = 0; n < 4; ++n) acc[i][h * 4 + n] = __builtin_amdgcn_mfma_f32_16x16x32_bf16(Bf[n], At, acc[i][h * 4 + n], 0, 0, 0); }
          __builtin_amdgcn_sched_barrier(0);
        }
    };
    auto epilogue = [&]() {
      int fr2 = fr, fq2 = fq; asm volatile("" : "+v"(fr2), "+v"(fq2));
#pragma unroll
      for (int i = 0; i < NFM; ++i) { const int r = (wm + 4 * i) * 16 + fr2;
        if (r < cu.count) {
          if (MODE == 0) { const float rs = ((const LAS float*)(lds + TAB_OFF + c_j * TAB_UNIT + MROWS * 4))[r];
            bf16_t* dst = p.hb + (size_t)(cu.start + cu.m0 + r) * DE + cu.sl * 128 + wn * 64 + fq2 * 4;
#pragma unroll
            for (int n = 0; n < 4; ++n) { const f32x4 gg = acc[i][n] * rs, uu = acc[i][4 + n] * rs;
              const unsigned lo = pk_bf16(siluf_(gg[0]) * uu[0], siluf_(gg[1]) * uu[1]), hi = pk_bf16(siluf_(gg[2]) * uu[2], siluf_(gg[3]) * uu[3]);
              __hip_atomic_store((unsigned long long*)(dst + n * 16), ((unsigned long long)hi << 32) | lo, __ATOMIC_RELAXED, __HIP_MEMORY_SCOPE_AGENT); } }
          else { const int ts2 = ((const LAS int*)(lds + TAB_OFF + c_j * TAB_UNIT))[r]; const float gate = ((const LAS float*)(lds + TAB_OFF + c_j * TAB_UNIT + MROWS * 4))[r];
#pragma unroll
            for (int g = 0; g < 2; ++g) { bf16_t* dst = p.y + (size_t)ts2 * D + cu.sl * 256 + wn * 128 + g * 64 + fq2 * 16;
              u32x4 w0, w1;
              w0.x = pk_bf16(acc[i][g * 4 + 0][0] * gate, acc[i][g * 4 + 0][1] * gate); w0.y = pk_bf16(acc[i][g * 4 + 0][2] * gate, acc[i][g * 4 + 0][3] * gate);
              w0.z = pk_bf16(acc[i][g * 4 + 1][0] * gate, acc[i][g * 4 + 1][1] * gate); w0.w = pk_bf16(acc[i][g * 4 + 1][2] * gate, acc[i][g * 4 + 1][3] * gate);
              w1.x = pk_bf16(acc[i][g * 4 + 2][0] * gate, acc[i][g * 4 + 2][1] * gate); w1.y = pk_bf16(acc[i][g * 4 + 2][2] * gate, acc[i][g * 4 + 2][3] * gate);
              w1.z = pk_bf16(acc[i][g * 4 + 3][0] * gate, acc[i][g * 4 + 3][1] * gate); w1.w = pk_bf16(acc[i][g * 4 + 3][2] * gate, acc[i][g * 4 + 3][3] * gate);
              *(u32x4*)dst = w0; *(u32x4*)(dst + 8) = w1; } }
        }
#pragma unroll
        for (int n = 0; n < 8; ++n) acc[i][n] = (f32x4){0.f, 0.f, 0.f, 0.f};
      }
    };
    A_DMA(0, 0); B_ISSUE(0); B_WRITE(0); B_ISSUE(1);
    asm volatile("s_waitcnt vmcnt(8)" ::: "memory");
    asm volatile("s_waitcnt lgkmcnt(0)" ::: "memory"); __builtin_amdgcn_s_barrier();
#pragma unroll 1
    for (int s = 0; s < total; ++s) {
      B_WRITE((s + 1) & 1);
      A_DMA((s + 1) & 1, s + 1); B_ISSUE(s + 2);
      compute(s & 1);
      int sig_ = -1;
      if ((s + 1) % NK == 0) { epilogue(); __builtin_amdgcn_s_waitcnt(0x0F70); sig_ = cu.tile; if (s + 1 < total) { c_j = (s + 1) / NK; cu = unit_of(c_j); } }
      asm volatile("s_waitcnt vmcnt(8)" ::: "memory");
      asm volatile("s_waitcnt lgkmcnt(0)" ::: "memory"); __builtin_amdgcn_s_barrier();
      if (MODE == 0 && sig_ >= 0 && threadIdx.x == 0) __hip_atomic_fetch_add(p.moe_done + sig_, 1u, __ATOMIC_RELAXED, __HIP_MEMORY_SCOPE_AGENT);
    }
    asm volatile("s_waitcnt vmcnt(0)" ::: "memory");
#undef A_DMA
#undef B_ISSUE
#undef B_WRITE
  }
}
__device__ __forceinline__ void phase_final(const P& p, int bid, int nb) {
  const int lane = threadIdx.x & 63, w = (bid * NTHR + threadIdx.x) >> 6, nw = nb * (NTHR / 64);
  for (int r = w; r < T; r += nw) {
    const u32x2* src = (const u32x2*)(p.h16 + (size_t)r * D);
    const u32x2* y0 = (const u32x2*)(p.y + (size_t)(2 * r) * D); const u32x2* y1 = (const u32x2*)(p.y + (size_t)(2 * r + 1) * D);
    float4 v[8]; float ss = 0.f;
#pragma unroll
    for (int i = 0; i < 8; ++i) { const u32x2 hv = src[i * 64 + lane]; v[i].x = __uint_as_float(hv.x << 16); v[i].y = __uint_as_float(hv.x & 0xffff0000u); v[i].z = __uint_as_float(hv.y << 16); v[i].w = __uint_as_float(hv.y & 0xffff0000u);
      const u32x2 a = y0[i * 64 + lane], b = y1[i * 64 + lane];
      v[i].x += __uint_as_float(a.x << 16) + __uint_as_float(b.x << 16); v[i].y += __uint_as_float(a.x & 0xffff0000u) + __uint_as_float(b.x & 0xffff0000u);
      v[i].z += __uint_as_float(a.y << 16) + __uint_as_float(b.y << 16); v[i].w += __uint_as_float(a.y & 0xffff0000u) + __uint_as_float(b.y & 0xffff0000u);
      ss += v[i].x * v[i].x + v[i].y * v[i].y + v[i].z * v[i].z + v[i].w * v[i].w; }
    ss = wave_sum(ss);
    const float rs = rsqrtf(ss * (1.f / D) + EPS);
#pragma unroll
    for (int i = 0; i < 8; ++i) { const float4 gg = ((const float4*)p.final_g)[i * 64 + lane];
      float4 o; o.x = v[i].x * rs * gg.x; o.y = v[i].y * rs * gg.y; o.z = v[i].z * rs * gg.z; o.w = v[i].w * rs * gg.w;
      ((float4*)(p.out + (size_t)r * D))[i * 64 + lane] = o; }
  }
}

namespace pg8 {
#define PG8_LAS __attribute__((address_space(3)))
typedef unsigned short bf16_t;
typedef short bf16x8 __attribute__((ext_vector_type(8)));
typedef float f32x4 __attribute__((ext_vector_type(4)));
constexpr int BM = 256, BK = 64, HALF = 128, HTB = HALF * BK * 2, STAGE_BYTES = 8 * HTB;
__device__ __forceinline__ int lds_byte(int r, int c) { const int st = (r >> 4) * 2 + (c >> 5), rr = r & 15, cc = c & 31, ob = rr * 64 + cc * 2; return st * 1024 + (ob ^ (((ob >> 9) & 1) << 5)); }
__device__ __forceinline__ void stage_rc(int b, int& R, int& C) { const int st = b / 1024, sb = b % 1024, swz = sb ^ (((sb >> 9) & 1) << 5); R = (st >> 1) * 16 + swz / 64; C = (st & 1) * 32 + (swz % 64) / 2; }
__device__ __forceinline__ int perm32(int rho) { const int n = rho >> 4, i = rho & 15; return 8 * (i >> 2) + 4 * n + (i & 3); }
struct Unit { int pm, pn; };
struct Gemm { const bf16_t* A; const bf16_t* Bt; int M, N, K; };
struct ColMajorOrder { int nM, nwg, G, c;
  __device__ __forceinline__ bool next(int i, Unit& u) const { const int L = i * G + c; if (L >= nwg) return false; u.pm = L % nM; u.pn = L / nM; return true; }
  __device__ __forceinline__ void a_ready(const Unit&) const {}
  __device__ __forceinline__ void done(const Unit&) const {} };
template <class Epi, class Sched, bool ALIGN_EPI = false, bool SP2 = false>
__device__ __forceinline__ void gemm_phase(PG8_LAS unsigned char* lds, const Gemm g, const Sched& S, const Epi& E) {
    const int tid = threadIdx.x, wid = __builtin_amdgcn_readfirstlane(tid >> 6), lane = tid & 63, wr = wid >> 2, wc = wid & 3, fr = lane & 15, fq = lane >> 4;
    const int K = g.K, nt = K / BK;
    unsigned voffA[2], voffB[2];
#pragma unroll
    for (int i = 0; i < 2; ++i) { int R, C; stage_rc(tid * 16 + i * 8192, R, C); const int Rb = Epi::PERM ? ((R & ~31) + perm32(R & 31)) : R;
        voffA[i] = (unsigned)(R * K + C) * 2u; voffB[i] = (unsigned)(Rb * K + C) * 2u; }
    const size_t kstep = (size_t)(BK * 2);
    const size_t hstep = (size_t)HALF * K * 2;
    const size_t tstep = 2 * hstep;
    const unsigned ldsw = (unsigned)wid * 1024u;
    const int aoff = lds_byte(wr * 64 + fr, fq * 8), boff = lds_byte(wc * 32 + fr, fq * 8);
#define PG8_SA(b, h) (((b) * 2 + (h)) * HTB)
#define PG8_SB(b, h) ((4 + (b) * 2 + (h)) * HTB)
#define PG8_STAGE(bufoff, gbase, voff) do { _Pragma("unroll") for (int _i = 0; _i < 2; ++_i) \
        __builtin_amdgcn_global_load_lds((const unsigned*)((const char*)(gbase) + (voff)[_i]), (PG8_LAS unsigned*)(lds + (bufoff) + ldsw + _i * 8192), 16, 0, 0); } while (0)
#define PG8_LDA(dst, b, h) do { _Pragma("unroll") for (int m = 0; m < 4; ++m) _Pragma("unroll") for (int k = 0; k < 2; ++k) dst[m][k] = *(const PG8_LAS bf16x8*)(lds + PG8_SA(b, h) + aoff + m * 2048 + k * 1024); } while (0)
#define PG8_LDB(dst, b, h) do { _Pragma("unroll") for (int n = 0; n < 2; ++n) _Pragma("unroll") for (int k = 0; k < 2; ++k) dst[n][k] = *(const PG8_LAS bf16x8*)(lds + PG8_SB(b, h) + boff + n * 2048 + k * 1024); } while (0)
#define PG8_MMA(ai, bj, At, Bt) do { __builtin_amdgcn_s_setprio(1); _Pragma("unroll") for (int m = 0; m < 4; ++m) _Pragma("unroll") for (int n = 0; n < 2; ++n) _Pragma("unroll") for (int k = 0; k < 2; ++k) \
        acc[ai][bj][m][n] = __builtin_amdgcn_mfma_f32_16x16x32_bf16(Bt[n][k], At[m][k], acc[ai][bj][m][n], 0, 0, 0); __builtin_amdgcn_s_setprio(0); } while (0)
#define PG8_WAIT_V(n) asm volatile("s_waitcnt vmcnt(" #n ")" ::: "memory")
#define PG8_WAIT_L(n) asm volatile("s_waitcnt lgkmcnt(" #n ")" ::: "memory")
#define PG8_BAR __builtin_amdgcn_s_barrier()
#define PG8_SCHED __builtin_amdgcn_sched_barrier(0)
    Unit cur, nxt; int ui = 0;
    if (!S.next(0, cur)) return;
    f32x4 acc[2][2][4][2];
#pragma unroll
    for (int a = 0; a < 2; ++a)
#pragma unroll
        for (int b = 0; b < 2; ++b)
#pragma unroll
            for (int m = 0; m < 4; ++m)
#pragma unroll
                for (int n = 0; n < 2; ++n) acc[a][b][m][n] = (f32x4){0.f, 0.f, 0.f, 0.f};
    bf16x8 At[4][2], B0[2][2], B1[2][2];
    const char* cA = (const char*)g.A + (size_t)cur.pm * tstep; const char* cB = (const char*)g.Bt + (size_t)cur.pn * tstep;
    S.a_ready(cur);
    if constexpr (SP2) {
        PG8_STAGE(PG8_SB(0, 0), cB, voffB); PG8_STAGE(PG8_SB(0, 1), cB + hstep, voffB); PG8_STAGE(PG8_SA(0, 0), cA, voffA); PG8_STAGE(PG8_SA(0, 1), cA + hstep, voffA);
        if (wr == 1) PG8_BAR;
        PG8_WAIT_V(2); PG8_BAR;
        PG8_STAGE(PG8_SB(1, 0), cB + kstep, voffB); PG8_STAGE(PG8_SA(1, 0), cA + kstep, voffA); PG8_STAGE(PG8_SB(1, 1), cB + hstep + kstep, voffB);
        PG8_WAIT_V(6); PG8_BAR;
    } else {
        PG8_STAGE(PG8_SB(0, 0), cB, voffB); PG8_STAGE(PG8_SA(0, 0), cA, voffA); PG8_STAGE(PG8_SB(0, 1), cB + hstep, voffB); PG8_STAGE(PG8_SA(0, 1), cA + hstep, voffA);
        if (wr == 1) PG8_BAR;
        PG8_WAIT_V(4); PG8_BAR;
        PG8_STAGE(PG8_SB(1, 0), cB + kstep, voffB); PG8_STAGE(PG8_SA(1, 0), cA + kstep, voffA); PG8_STAGE(PG8_SB(1, 1), cB + hstep + kstep, voffB);
        PG8_WAIT_V(6); PG8_BAR;
    }
    for (;;) {
        const bool has_next = S.next(ui + 1, nxt);
        const char* nA = has_next ? (const char*)g.A + (size_t)nxt.pm * tstep : cA; const char* nB = has_next ? (const char*)g.Bt + (size_t)nxt.pn * tstep : cB;
        for (int t = 0; t < nt; t += 2) {
            const bool last = (t == nt - 2);
            const char* a1 = cA + (size_t)(t + 1) * kstep;
            const char* a2 = last ? nA : cA + (size_t)(t + 2) * kstep; const char* b2 = last ? nB : cB + (size_t)(t + 2) * kstep;
            const char* a3 = a2 + kstep; const char* b3 = b2 + kstep;
            if (last && has_next) S.a_ready(nxt);
            if constexpr (SP2) {
            PG8_LDB(B0, 0, 0); PG8_LDB(B1, 0, 1); PG8_SCHED; PG8_LDA(At, 0, 0); PG8_STAGE(PG8_SA(1, 1), a1 + hstep, voffA);
            PG8_WAIT_V(8); PG8_WAIT_L(0); PG8_BAR; PG8_MMA(0, 0, At, B0); PG8_MMA(0, 1, At, B1); PG8_BAR; PG8_SCHED;
            PG8_LDA(At, 0, 1); PG8_STAGE(PG8_SB(0, 0), b2, voffB); PG8_STAGE(PG8_SB(0, 1), b2 + hstep, voffB); PG8_STAGE(PG8_SA(0, 0), a2, voffA);
            PG8_WAIT_V(8); PG8_WAIT_L(0); PG8_BAR; PG8_MMA(1, 0, At, B0); PG8_MMA(1, 1, At, B1); PG8_BAR; PG8_SCHED;
            PG8_LDB(B0, 1, 0); PG8_LDB(B1, 1, 1); PG8_SCHED; PG8_LDA(At, 1, 0); PG8_STAGE(PG8_SA(0, 1), a2 + hstep, voffA);
            PG8_WAIT_V(8); PG8_WAIT_L(0); PG8_BAR; PG8_MMA(0, 0, At, B0); PG8_MMA(0, 1, At, B1); PG8_BAR; PG8_SCHED;
            PG8_LDA(At, 1, 1); PG8_STAGE(PG8_SB(1, 0), b3, voffB); PG8_STAGE(PG8_SB(1, 1), b3 + hstep, voffB); PG8_STAGE(PG8_SA(1, 0), a3, voffA);
            PG8_WAIT_V(8); PG8_WAIT_L(0); PG8_BAR; PG8_MMA(1, 0, At, B0); PG8_MMA(1, 1, At, B1); PG8_BAR; PG8_SCHED;
            } else {
            PG8_LDB(B0, 0, 0); PG8_SCHED; PG8_LDA(At, 0, 0); PG8_STAGE(PG8_SA(1, 1), a1 + hstep, voffA);
            PG8_WAIT_L(8); PG8_BAR; PG8_WAIT_L(0); PG8_MMA(0, 0, At, B0); PG8_BAR; PG8_SCHED;
            PG8_LDB(B1, 0, 1); PG8_STAGE(PG8_SB(0, 0), b2, voffB);
            PG8_BAR; PG8_WAIT_L(0); PG8_MMA(0, 1, At, B1); PG8_BAR;
            PG8_LDA(At, 0, 1); PG8_STAGE(PG8_SA(0, 0), a2, voffA);
            PG8_BAR; PG8_WAIT_L(0); PG8_MMA(1, 0, At, B0); PG8_BAR; PG8_SCHED;
            PG8_STAGE(PG8_SB(0, 1), b2 + hstep, voffB);
            PG8_WAIT_V(6); PG8_BAR; PG8_MMA(1, 1, At, B1); PG8_BAR;
            PG8_LDB(B0, 1, 0); PG8_SCHED; PG8_LDA(At, 1, 0); PG8_STAGE(PG8_SA(0, 1), a2 + hstep, voffA);
            PG8_WAIT_L(8); PG8_BAR; PG8_WAIT_L(0); PG8_MMA(0, 0, At, B0); PG8_BAR; PG8_SCHED;
            PG8_LDB(B1, 1, 1); PG8_STAGE(PG8_SB(1, 0), b3, voffB);
            PG8_BAR; PG8_WAIT_L(0); PG8_MMA(0, 1, At, B1); PG8_BAR;
            PG8_LDA(At, 1, 1); PG8_STAGE(PG8_SA(1, 0), a3, voffA);
            PG8_BAR; PG8_WAIT_L(0); PG8_MMA(1, 0, At, B0); PG8_BAR; PG8_SCHED;
            PG8_STAGE(PG8_SB(1, 1), b3 + hstep, voffB);
            PG8_WAIT_V(6); PG8_BAR; PG8_MMA(1, 1, At, B1); PG8_BAR;
            }
        }
        if constexpr (ALIGN_EPI) { if (wr == 0) PG8_BAR; }
        if constexpr (!Epi::AFTER_DRAIN) { E(acc, cur, wr, wc, fr, fq); S.done(cur); }
        if (!has_next) break;
#pragma unroll
        for (int a = 0; a < 2; ++a)
#pragma unroll
            for (int b = 0; b < 2; ++b)
#pragma unroll
                for (int m = 0; m < 4; ++m)
#pragma unroll
                    for (int n = 0; n < 2; ++n) acc[a][b][m][n] = (f32x4){0.f, 0.f, 0.f, 0.f};
        cur = nxt; cA = nA; cB = nB; ++ui;
        if constexpr (ALIGN_EPI) { if (wr == 1) PG8_BAR; }
    }
    PG8_WAIT_V(0);
    if constexpr (!ALIGN_EPI) { if (wr == 0) PG8_BAR; }
    PG8_BAR;
    if constexpr (Epi::AFTER_DRAIN) { E.fused(acc, cur, wr, wc, fr, fq, lds, wid, lane); S.done(cur); }
#undef PG8_SA
#undef PG8_SB
#undef PG8_STAGE
#undef PG8_LDA
#undef PG8_LDB
#undef PG8_MMA
#undef PG8_WAIT_V
#undef PG8_WAIT_L
#undef PG8_BAR
#undef PG8_SCHED
}
}

#define EPI_DRAIN() asm volatile("s_waitcnt vmcnt(0)" ::: "memory")
struct Epi1 {
  static constexpr bool PERM = false, AFTER_DRAIN = false; P p;
  __device__ __forceinline__ void operator()(const f32x4 (&acc)[2][2][4][2], const pg8::Unit& u, int wr, int wc, int fr, int fq) const {
    const int pn = u.pn;
    if (pn <= 4) {
      bf16_t* dst; int ld, c0; float* ssq; int sst;
      if (pn < 3) { dst = p.qlat; ld = QL; c0 = pn * 256; ssq = p.ssq_q + pn * 4 + wc; sst = 12; } else { dst = p.kvlat; ld = KVL; c0 = (pn - 3) * 256; ssq = p.ssq_kv + (pn - 3) * 4 + wc; sst = 8; }
#pragma unroll
      for (int ai = 0; ai < 2; ++ai)
#pragma unroll
        for (int m = 0; m < 4; ++m) { const int row = u.pm * 256 + ai * 128 + wr * 64 + m * 16 + fr; float s = 0.f;
#pragma unroll
          for (int bj = 0; bj < 2; ++bj)
#pragma unroll
            for (int n = 0; n < 2; ++n) { const f32x4 a = acc[ai][bj][m][n]; s += a[0] * a[0] + a[1] * a[1] + a[2] * a[2] + a[3] * a[3];
              u32x2 w; w.x = pk_bf16(a[0], a[1]); w.y = pk_bf16(a[2], a[3]); *(u32x2*)(dst + (size_t)row * ld + c0 + bj * 128 + wc * 32 + n * 16 + fq * 4) = w; }
          s += __shfl_xor(s, 16); s += __shfl_xor(s, 32);
          if (fq == 0) ssq[(size_t)row * sst] = s; }
    } else if (pn <= 12) {
#pragma unroll
      for (int n = 0; n < 2; ++n) { const int ch = (pn - 5) * 128 + wc * 32 + n * 16 + fq * 4; const float4 ba = *(const float4*)(p.b_glu + ch), bg = *(const float4*)(p.b_glu + 1024 + ch);
#pragma unroll
        for (int ai = 0; ai < 2; ++ai)
#pragma unroll
          for (int m = 0; m < 4; ++m) { const int row = u.pm * 256 + ai * 128 + wr * 64 + m * 16 + fr; const f32x4 a = acc[ai][0][m][n], g = acc[ai][1][m][n];
            u32x2 w; w.x = pk_bf16((a[0] + ba.x) * sigmoidf_(g[0] + bg.x), (a[1] + ba.y) * sigmoidf_(g[1] + bg.y));
            w.y = pk_bf16((a[2] + ba.z) * sigmoidf_(g[2] + bg.z), (a[3] + ba.w) * sigmoidf_(g[3] + bg.w));
            *(u32x2*)(p.cglu + (size_t)row * CC + ch) = w; } }
    } else if (wc == 0) {
#pragma unroll
      for (int ai = 0; ai < 2; ++ai)
#pragma unroll
        for (int m = 0; m < 4; ++m) { const int row = u.pm * 256 + ai * 128 + wr * 64 + m * 16 + fr; const int pos = row & (S - 1);
#pragma unroll
          for (int n = 0; n < 2; ++n) { const int j = n * 16 + fq * 4; const f32x4 x1 = acc[ai][0][m][n], x2 = acc[ai][1][m][n];
            const float4 cs0 = *(const float4*)(p.ropetab + (pos * 32 + j) * 2), cs1 = *(const float4*)(p.ropetab + (pos * 32 + j) * 2 + 4);
            u32x2 lo, hi;
            lo.x = pk_bf16(x1[0] * cs0.x - x2[0] * cs0.y, x1[1] * cs0.z - x2[1] * cs0.w); lo.y = pk_bf16(x1[2] * cs1.x - x2[2] * cs1.y, x1[3] * cs1.z - x2[3] * cs1.w);
            hi.x = pk_bf16(x2[0] * cs0.x + x1[0] * cs0.y, x2[1] * cs0.z + x1[1] * cs0.w); hi.y = pk_bf16(x2[2] * cs1.x + x1[2] * cs1.y, x2[3] * cs1.z + x1[3] * cs1.w);
            *(u32x2*)(p.krope + (size_t)row * RD + j) = lo; *(u32x2*)(p.krope + (size_t)row * RD + 32 + j) = hi; } }
    }
    EPI_DRAIN();
  }
};
struct Epi2q {
  static constexpr bool PERM = false, AFTER_DRAIN = false; P p;
  __device__ __forceinline__ void operator()(const f32x4 (&acc)[2][2][4][2], const pg8::Unit& u, int wr, int wc, int fr, int fq) const {
    const int pn = u.pn;
#pragma unroll
    for (int ai = 0; ai < 2; ++ai)
#pragma unroll
      for (int m = 0; m < 4; ++m) { const int row = u.pm * 256 + ai * 128 + wr * 64 + m * 16 + fr;
        float sq = 0.f;
#pragma unroll
        for (int i = 0; i < 12; i += 4) { const float4 v = *(const float4*)(p.ssq_q + (size_t)row * 12 + i); sq += v.x + v.y + v.z + v.w; }
        const float rs = rsqrtf(sq * (1.f / QL) + EPS);
        if (pn < 4) {
#pragma unroll
          for (int bj = 0; bj < 2; ++bj)
#pragma unroll
            for (int n = 0; n < 2; ++n) { const f32x4 a = acc[ai][bj][m][n]; u32x2 w; w.x = pk_bf16(a[0] * rs, a[1] * rs); w.y = pk_bf16(a[2] * rs, a[3] * rs);
              *(u32x2*)(p.q + (size_t)row * QW + (2 * pn + bj) * 192 + wc * 32 + n * 16 + fq * 4) = w; }
        } else { const int pos = row & (S - 1); bf16_t* dst = p.q + (size_t)row * QW + ((pn - 4) * 4 + wc) * 192 + 128;
#pragma unroll
          for (int n = 0; n < 2; ++n) { const int j = n * 16 + fq * 4; const f32x4 x1 = acc[ai][0][m][n] * rs, x2 = acc[ai][1][m][n] * rs;
            const float4 cs0 = *(const float4*)(p.ropetab + (pos * 32 + j) * 2), cs1 = *(const float4*)(p.ropetab + (pos * 32 + j) * 2 + 4);
            u32x2 lo, hi;
            lo.x = pk_bf16(x1[0] * cs0.x - x2[0] * cs0.y, x1[1] * cs0.z - x2[1] * cs0.w); lo.y = pk_bf16(x1[2] * cs1.x - x2[2] * cs1.y, x1[3] * cs1.z - x2[3] * cs1.w);
            hi.x = pk_bf16(x2[0] * cs0.x + x1[0] * cs0.y, x2[1] * cs0.z + x1[1] * cs0.w); hi.y = pk_bf16(x2[2] * cs1.x + x1[2] * cs1.y, x2[3] * cs1.z + x1[3] * cs1.w);
            *(u32x2*)(dst + j) = lo; *(u32x2*)(dst + 32 + j) = hi; } }
      }
    EPI_DRAIN();
  }
};
struct Epi2kv {
  static constexpr bool PERM = false, AFTER_DRAIN = false; P p;
  __device__ __forceinline__ void operator()(const f32x4 (&acc)[2][2][4][2], const pg8::Unit& u, int wr, int wc, int fr, int fq) const {
#pragma unroll
    for (int ai = 0; ai < 2; ++ai)
#pragma unroll
      for (int m = 0; m < 4; ++m) { const int row = u.pm * 256 + ai * 128 + wr * 64 + m * 16 + fr;
        const float4 v0 = *(const float4*)(p.ssq_kv + (size_t)row * 8), v1 = *(const float4*)(p.ssq_kv + (size_t)row * 8 + 4);
        const float rs = rsqrtf((v0.x + v0.y + v0.z + v0.w + v1.x + v1.y + v1.z + v1.w) * (1.f / KVL) + EPS);
#pragma unroll
        for (int bj = 0; bj < 2; ++bj)
#pragma unroll
          for (int n = 0; n < 2; ++n) { const f32x4 a = acc[ai][bj][m][n]; u32x2 w; w.x = pk_bf16(a[0] * rs, a[1] * rs); w.y = pk_bf16(a[2] * rs, a[3] * rs);
            *(u32x2*)(p.kv + (size_t)row * KVW + u.pn * 256 + bj * 128 + wc * 32 + n * 16 + fq * 4) = w; } }
    EPI_DRAIN();
  }
};
struct Epi3 {
  static constexpr bool PERM = true, AFTER_DRAIN = false; P p;
  __device__ __forceinline__ void operator()(const f32x4 (&acc)[2][2][4][2], const pg8::Unit& u, int wr, int wc, int fr, int fq) const {
    float4 g2[2][2];
#pragma unroll
    for (int bj = 0; bj < 2; ++bj)
#pragma unroll
      for (int n = 0; n < 2; ++n) g2[bj][n] = *(const float4*)(p.ln2_g + u.pn * 256 + bj * 128 + wc * 32 + fq * 8 + n * 4);
#pragma unroll
    for (int ai = 0; ai < 2; ++ai)
#pragma unroll
      for (int m = 0; m < 4; ++m) { const int row = u.pm * 256 + ai * 128 + wr * 64 + m * 16 + fr; float s = 0.f;
#pragma unroll
        for (int bj = 0; bj < 2; ++bj) { const size_t o_ = (size_t)row * D + u.pn * 256 + bj * 128 + wc * 32 + fq * 8;
          const float4 x0 = *(const float4*)(p.x + o_), x1 = *(const float4*)(p.x + o_ + 4); const f32x4 a0 = acc[ai][bj][m][0], a1 = acc[ai][bj][m][1];
          const float h0 = x0.x + a0[0], h1 = x0.y + a0[1], h2 = x0.z + a0[2], h3 = x0.w + a0[3], h4 = x1.x + a1[0], h5 = x1.y + a1[1], h6 = x1.z + a1[2], h7 = x1.w + a1[3];
          s += (h0 * h0 + h1 * h1) + (h2 * h2 + h3 * h3) + (h4 * h4 + h5 * h5) + (h6 * h6 + h7 * h7);
          *(u32x4*)(p.h16 + o_) = (u32x4){pk_bf16(h0, h1), pk_bf16(h2, h3), pk_bf16(h4, h5), pk_bf16(h6, h7)};
          const float4 ga = g2[bj][0], gb = g2[bj][1];
          *(u32x4*)(p.hn + o_) = (u32x4){pk_bf16(h0 * ga.x, h1 * ga.y), pk_bf16(h2 * ga.z, h3 * ga.w), pk_bf16(h4 * gb.x, h5 * gb.y), pk_bf16(h6 * gb.z, h7 * gb.w)}; }
        s += __shfl_xor(s, 16); s += __shfl_xor(s, 32);
        if (fq == 0) p.ssq_h[(size_t)row * 32 + u.pn * 4 + wc] = s; }
    EPI_DRAIN();
  }
};
__device__ __forceinline__ void phase_gemm1_pg8(const P& p, ldsp lds, int bid, int nb) {
  pg8::Gemm g; g.A = p.xn; g.Bt = p.WinT; g.M = T; g.N = NP1; g.K = D;
  pg8::ColMajorOrder S_; S_.nM = T / 256; S_.nwg = (T / 256) * (NP1 / 256); S_.G = nb; S_.c = bid;
  Epi1 E; E.p = p; pg8::gemm_phase<Epi1, pg8::ColMajorOrder, true, true>(lds, g, S_, E);
}
__device__ __forceinline__ void phase_gemm2_pg8(const P& p, ldsp lds, int bid, int nb) {
  { pg8::Gemm g; g.A = p.qlat; g.Bt = p.WuqT; g.M = T; g.N = QW; g.K = QL;
    pg8::ColMajorOrder S_; S_.nM = T / 256; S_.nwg = (T / 256) * (QW / 256); S_.G = nb; S_.c = bid;
    Epi2q E; E.p = p; pg8::gemm_phase<Epi2q, pg8::ColMajorOrder, true, true>(lds, g, S_, E); }
  { pg8::Gemm g; g.A = p.kvlat; g.Bt = p.WukvT; g.M = T; g.N = KVW; g.K = KVL;
    pg8::ColMajorOrder S_; S_.nM = T / 256; S_.nwg = (T / 256) * (KVW / 256); S_.G = nb; S_.c = (bid + 192) % nb;
    Epi2kv E; E.p = p; pg8::gemm_phase<Epi2kv, pg8::ColMajorOrder, true, true>(lds, g, S_, E); }
}
__device__ __forceinline__ void phase_gemm3_pg8(const P& p, ldsp lds, int bid, int nb) {
  pg8::Gemm g; g.A = p.mix; g.Bt = p.WoT; g.M = T; g.N = D; g.K = D;
  pg8::ColMajorOrder S_; S_.nM = T / 256; S_.nwg = (T / 256) * (D / 256); S_.G = nb; S_.c = bid;
  Epi3 E; E.p = p; pg8::gemm_phase<Epi3, pg8::ColMajorOrder, true, true>(lds, g, S_, E);
}
#define XB_TMO      128
#define XB_XCNT(j)  (256  + 64 * (j))
#define XB_XSUB(j)  (1280 + 64 * (j))
#define XB_XGEN(j)  (2304 + 64 * (j))
#define XB_TOP      3328
#define XB_TOPGEN   3392
#define XCD_BAR_WORDS 3456
#define XB_SPIN_CAP (1u << 20)
__device__ __forceinline__ unsigned xb_ld(unsigned* p)              { return __hip_atomic_load(p, __ATOMIC_RELAXED, __HIP_MEMORY_SCOPE_AGENT); }
__device__ __forceinline__ unsigned xb_add(unsigned* p, unsigned v) { return __hip_atomic_fetch_add(p, v, __ATOMIC_RELAXED, __HIP_MEMORY_SCOPE_AGENT); }
__device__ __forceinline__ unsigned xb_xcc_id() { return (unsigned)__builtin_amdgcn_s_getreg((3 << 11) | 20) & 0xFu; }
#define XB_SPIN(cond, bar) do { unsigned _sp = 0; while (cond) { __builtin_amdgcn_s_sleep(1); \
    if ((++_sp & 255u) == 0u) { if (xb_ld(&(bar)[XB_TMO])) break; if (_sp > XB_SPIN_CAP) { atomicAdd(&(bar)[XB_TMO], 1u); break; } } } } while (0)
struct XcdBarrier { unsigned* bar; unsigned x; volatile LAS unsigned* st; };
__device__ __forceinline__ XcdBarrier xcd_barrier_post(unsigned* bar, volatile LAS unsigned* st) {
  XcdBarrier b; b.bar = bar; b.x = xb_xcc_id(); b.st = st;
  if (threadIdx.x == 0) (void)xb_add(&bar[XB_XCNT(b.x)], 1u);
  return b;
}
__device__ __forceinline__ void xcd_barrier_complete(unsigned* bar, unsigned x, unsigned& nloc, unsigned& nx) {
  const unsigned G = gridDim.x * gridDim.y * gridDim.z;
  unsigned sum, cnt, mine, sp = 0u;
  for (;;) {
    sum = 0u; cnt = 0u; mine = 0u;
#pragma unroll
    for (unsigned j = 0; j < 16; ++j) { const unsigned c = xb_ld(&bar[XB_XCNT(j)]); sum += c; cnt += (c > 0u) ? 1u : 0u; mine = (j == x) ? c : mine; }
    if (sum == G) break;
    __builtin_amdgcn_s_sleep(1);
    if ((++sp & 255u) == 0u) { if (xb_ld(&bar[XB_TMO])) break; if (sp > XB_SPIN_CAP) { atomicAdd(&bar[XB_TMO], 1u); break; } }
  }
  nloc = mine > 0u ? mine : 1u; nx = cnt > 0u ? cnt : 1u;
}
__device__ __forceinline__ void xcd_barrier(const XcdBarrier& b) {
  asm volatile("s_waitcnt vmcnt(0)" ::: "memory");
  __syncthreads();
  if (threadIdx.x == 0) {
    unsigned* bar = b.bar;
    __builtin_amdgcn_s_waitcnt(0);
    unsigned nloc = b.st[0], nx = b.st[1];
    if (nloc == 0u) { xcd_barrier_complete(bar, b.x, nloc, nx); b.st[0] = nloc; b.st[1] = nx; }
    const unsigned old = xb_add(&bar[XB_XSUB(b.x)], 1u);
    const unsigned gen = old / nloc;
    if (old + 1u == (gen + 1u) * nloc) {
      __builtin_amdgcn_fence(__ATOMIC_RELEASE, "agent");
      asm volatile("s_waitcnt vmcnt(0)" ::: "memory");
      const unsigned og = xb_add(&bar[XB_TOP], 1u);
      const unsigned tg = og / nx;
      if (og + 1u == (tg + 1u) * nx) xb_add(&bar[XB_TOPGEN], 1u);
      else XB_SPIN(xb_ld(&bar[XB_TOPGEN]) == tg, bar);
      __builtin_amdgcn_fence(__ATOMIC_ACQUIRE, "agent");
      xb_add(&bar[XB_XGEN(b.x)], 1u);
      asm volatile("s_waitcnt vmcnt(0)" ::: "memory");
    } else {
      XB_SPIN(xb_ld(&bar[XB_XGEN(b.x)]) == gen, bar);
      __builtin_amdgcn_fence(__ATOMIC_ACQUIRE, "agent");
      asm volatile("s_waitcnt vmcnt(0)" ::: "memory");
    }
  }
  __syncthreads();
}

__global__ __launch_bounds__(NTHR, 2) void mega_fwd(P p) {
  extern __shared__ __attribute__((aligned(16))) unsigned char smem[];
  ldsp lds = (ldsp)smem;
  volatile LAS unsigned* st = (volatile LAS unsigned*)(lds + LDS_BYTES - 16);
  if (threadIdx.x == 0) { st[0] = 0u; st[1] = 0u; st[2] = 0u; st[3] = 0u; }
  __syncthreads();
  const XcdBarrier bar = xcd_barrier_post(p.bar, st);
  const int bid = blockIdx.x, nb = gridDim.x;
  phase_prep(p, lds, bid, nb); rmsnorm_rows_dev(p.x, p.ln1_g, p.xn, bid, nb);
  xcd_barrier(bar);
  phase_gemm1_pg8(p, lds, bid, nb);
  xcd_barrier(bar);
  phase_gemm2_pg8(p, lds, bid, nb); phase_conv(p, lds, bid, nb);
  xcd_barrier(bar);
  phase_attn(p, lds, bid, nb);
  xcd_barrier(bar);
  phase_gemm3_pg8(p, lds, bid, nb);
  xcd_barrier(bar);
  phase_route2(p, lds, bid, nb);
  xcd_barrier(bar);
  moe_stream<0>(p, lds, bid, nb);
  moe_wide<1>(p, lds, bid, nb);
  xcd_barrier(bar);
  phase_final(p, bid, nb);
}

static size_t carve(size_t& off, size_t bytes) { const size_t o = off; off += (bytes + 255) & ~(size_t)255; return o; }

extern "C" void kernel_launch(void* const* d_in, const int* in_sizes, int n_in, void* d_out, int out_size, void* d_ws, size_t ws_size, hipStream_t stream) {
  P p{};
  const float** pin = (const float**)&p.x;
  for (int i = 0; i < 22; ++i) pin[i] = (const float*)d_in[i];
  p.out = (float*)d_out;
  char* ws = (char*)d_ws; size_t off = 0;
  p.cnt = (int*)(ws + carve(off, 4096));
  p.bar = (unsigned*)(ws + carve(off, XCD_BAR_WORDS * 4));
  p.moe_done = (unsigned*)(ws + carve(off, 1024));
  p.ssq_h = (float*)(ws + carve(off, (size_t)T * 32 * 4));
  p.rstd_h = (float*)(ws + carve(off, (size_t)T * 4));
  p.h16 = (bf16_t*)(ws + carve(off, (size_t)T * D * 2));
  p.xn = (bf16_t*)(ws + carve(off, (size_t)T * D * 2));
  p.qlat = (bf16_t*)(ws + carve(off, (size_t)T * QL * 2));
  p.kvlat = (bf16_t*)(ws + carve(off, (size_t)T * KVL * 2));
  p.krope = (bf16_t*)(ws + carve(off, (size_t)T * RD * 2));
  p.cglu = (bf16_t*)(ws + carve(off, (size_t)T * CC * 2));
  p.q = (bf16_t*)(ws + carve(off, (size_t)T * QW * 2));
  p.kv = (bf16_t*)(ws + carve(off, (size_t)T * KVW * 2));
  p.mix = (bf16_t*)(ws + carve(off, (size_t)T * D * 2));
  p.hn = (bf16_t*)(ws + carve(off, (size_t)T * D * 2));
  p.hb = (bf16_t*)(ws + carve(off, (size_t)MAXTILES * 256 * DE * 2));
  p.y = (bf16_t*)(ws + carve(off, (size_t)2 * T * D * 2));
  p.ssq_q = (float*)(ws + carve(off, (size_t)T * 12 * 4));
  p.ssq_kv = (float*)(ws + carve(off, (size_t)T * 8 * 4));
  p.h = (float*)(ws + carve(off, (size_t)T * D * 4));
  p.rlog = (float*)(ws + carve(off, (size_t)RSLABS * T * RLD * 4));
  p.convtmp = (float*)(ws + carve(off, (size_t)T * CC * 4));
  p.ropetab = (float*)(ws + carve(off, (size_t)S * 32 * 2 * 4));
  p.list_gate = (float*)(ws + carve(off, (size_t)NE * LCAP * 4));
  p.list_tok = (int*)(ws + carve(off, (size_t)NE * LCAP * 4));
  p.WinT = (bf16_t*)(ws + carve(off, (size_t)NP1 * D * 2));
  p.WuqT = (bf16_t*)(ws + carve(off, (size_t)QW * QL * 2));
  p.WukvT = (bf16_t*)(ws + carve(off, (size_t)KVW * KVL * 2));
  p.WoT = (bf16_t*)(ws + carve(off, (size_t)D * D * 2));
  p.WrT = (bf16_t*)(ws + carve(off, (size_t)256 * D * 2));
  if (off > ws_size) { fprintf(stderr, "kernel_launch: workspace too small (%zu > %zu)\n", off, ws_size); return; }

  static int grid = 0;
  if (grid == 0) {
    int dev = 0, cus = 0, per_cu = 0;
    (void)hipGetDevice(&dev); (void)hipDeviceGetAttribute(&cus, hipDeviceAttributeMultiprocessorCount, dev);
    (void)hipFuncSetAttribute((const void*)mega_fwd, hipFuncAttributeMaxDynamicSharedMemorySize, LDS_BYTES);
    if (hipOccupancyMaxActiveBlocksPerMultiprocessor(&per_cu, (const void*)mega_fwd, NTHR, LDS_BYTES) != hipSuccess || per_cu < 1) { fprintf(stderr, "kernel_launch: occupancy query failed (%d)\n", per_cu); per_cu = 1; }
    (void)hipGetLastError();
    grid = cus * per_cu;
    fprintf(stderr, "kernel_launch: %d CUs x %d = grid %d\n", cus, per_cu, grid);
  }
  (void)hipMemsetAsync(p.bar, 0, XCD_BAR_WORDS * 4, stream);
  mega_fwd<<<grid, NTHR, LDS_BYTES, stream>>>(p);
}
```

```cpp
#include <hip/hip_runtime.h>
#include <cstdint>
#include <cstdio>
#include <type_traits>

typedef unsigned short bf16_t;

constexpr int T = 8192, D = 2048, S = 2048, NB = 4, H = 8;
constexpr int QL = 768, KVL = 512, RD = 64, CC = 1024, INC = 3392;
constexpr int QW = 1536  , KVW = 2048  ;
constexpr int NE = 64, DE = 512, NG = 8, EPG = 8, NRL = 72  ;
constexpr int CW = 31;
constexpr float EPS = 1e-6f;
constexpr int RSLABS = 8, RLD = 128;
constexpr int LCAP = T;
constexpr int MAXTILES = 128;

__device__ __forceinline__ float bf2f(bf16_t v) { return __uint_as_float(((unsigned)v) << 16); }
__device__ __forceinline__ bf16_t f2bf(float f) { unsigned u = __float_as_uint(f); u += 0x7fffu + ((u >> 16) & 1u); return (bf16_t)(u >> 16); }
__device__ __forceinline__ float sigmoidf_(float x) { return __builtin_amdgcn_rcpf(1.f + __builtin_amdgcn_exp2f(-1.4426950408889634f * x)); }
__device__ __forceinline__ float siluf_(float x) { return x * sigmoidf_(x); }

struct P {
  const float *x, *ln1_g, *w_in, *b_glu, *q_norm_g, *w_uq, *kv_norm_g, *w_ukv, *w_dw, *b_dw, *conv_ln_g, *conv_ln_b, *w_o, *ln2_g,
      *w_group, *b_group, *w_router, *b_router, *w_gate, *w_up, *w_down, *final_g;
  float* out;
  bf16_t *xn, *qlat, *kvlat, *krope, *cglu, *q, *kv, *mix, *hn, *hb, *y;
  float *ssq_q, *ssq_kv, *h, *rlog, *convtmp, *ropetab, *list_gate;
  int *cnt, *list_tok;
  bf16_t *WinT, *WuqT, *WukvT, *WoT, *WrT;
  unsigned* bar;
  unsigned* moe_done;
  float *ssq_h, *rstd_h;
  bf16_t* h16;
};

__device__ __forceinline__ float wave_sum(float v) {
#pragma unroll
  for (int o = 32; o > 0; o >>= 1) v += __shfl_xor(v, o);
  return v;
}
#define LAS __attribute__((address_space(3)))
typedef LAS unsigned char* ldsp;
typedef short bf16x8 __attribute__((ext_vector_type(8)));
typedef short s16x4 __attribute__((ext_vector_type(4)));
typedef float f32x4 __attribute__((ext_vector_type(4)));
typedef unsigned u32x2 __attribute__((ext_vector_type(2)));
typedef unsigned u32x4 __attribute__((ext_vector_type(4)));
constexpr int NTHR = 512, BM = 256, BK = 64, TILE_B = BM * BK * 2, STAGE_B = 2 * TILE_B, LDS_BYTES = 150528;
constexpr int NP1 = 3584;

__device__ __forceinline__ unsigned pk_bf16(float lo, float hi) { unsigned r; asm("v_cvt_pk_bf16_f32 %0, %1, %2" : "=v"(r) : "v"(lo), "v"(hi)); return r; }
__device__ __forceinline__ int lds_byte(int r, int c) { const int st = (r >> 4) * 2 + (c >> 5), ob = (r & 15) * 64 + (c & 31) * 2; return st * 1024 + (ob ^ (((ob >> 9) & 1) << 5)); }
__device__ __forceinline__ void stage_rc(int b, int& R, int& C) { const int st = b >> 10, sb = b & 1023, swz = sb ^ (((sb >> 9) & 1) << 5); R = (st >> 1) * 16 + swz / 64; C = (st & 1) * 32 + (swz % 64) / 2; }
__device__ __forceinline__ int trf(int k) { return ((k & 3) << 2) | ((k >> 2) & 3); }
__device__ __forceinline__ int tr_byte(int k, int n) { return (n >> 7) * 16384 + 256 * k + 16 * ((((n & 127) >> 3)) ^ trf(k)) + (n & 7) * 2; }

struct ColSrc { const float* src; int ld; int c; };
template <int WHICH> __device__ __forceinline__ ColSrc colmap(const P& p, int q) {
  ColSrc r; r.src = nullptr; r.ld = 0; r.c = -1;
  if (WHICH == 0) { r.src = p.w_in; r.ld = INC;
    if (q < 1280) r.c = q;
    else if (q < 3328) { const int pl = q - 1280, t = pl >> 8, j = pl & 255; r.c = 1344 + (j >> 7) * 1024 + t * 128 + (j & 127); }
    else { const int j = q - 3328; if (j < 32) r.c = 1280 + j; else if (j >= 128 && j < 160) r.c = 1280 + 32 + (j - 128); } }
  else if (WHICH == 1) { r.src = p.w_uq; r.ld = QW;
    if (q < 1024) { const int t = q >> 8, j = q & 255; r.c = (2 * t + (j >> 7)) * 192 + (j & 127); }
    else { const int t = (q - 1024) >> 8, j = q & 255, bj = j >> 7, wcc = (j >> 5) & 3, d = j & 31; r.c = (t * 4 + wcc) * 192 + 128 + bj * 32 + d; } }
  else if (WHICH == 2) { r.src = p.w_ukv; r.ld = KVW; r.c = q; }
  else if (WHICH == 3) { r.src = p.w_o; r.ld = D; r.c = q; }
  else { if (q < NG) { r.src = p.w_group; r.ld = NG; r.c = q; } else if (q < NRL) { r.src = p.w_router; r.ld = NE; r.c = q - NG; } }
  return r;
}
struct PrepDesc { bf16_t* dst; const float* gain; int K, kt, pt, which; };
__device__ __forceinline__ ColSrc colmap_rt(const P& p, int which, int q) {
  switch (which) { case 0: return colmap<0>(p, q); case 1: return colmap<1>(p, q); case 2: return colmap<2>(p, q); case 3: return colmap<3>(p, q); default: return colmap<4>(p, q); }
}
constexpr int PU0 = (D / 64) * (NP1 / 64), PU1 = (QL / 64) * (QW / 64), PU2 = (KVL / 64) * (KVW / 64), PU3 = (D / 64) * (D / 64), PU4 = (D / 64) * (256 / 64), PUT = PU0 + PU1 + PU2 + PU3 + PU4;
__device__ __forceinline__ PrepDesc prep_desc(const P& p, int u) {
  PrepDesc d; int v = u;
  if (v < PU0) { d.dst = p.WinT; d.gain = nullptr; d.K = D; d.kt = v % (D / 64); d.pt = v / (D / 64); d.which = 0; return d; } v -= PU0;
  if (v < PU1) { d.dst = p.WuqT; d.gain = p.q_norm_g; d.K = QL; d.kt = v % (QL / 64); d.pt = v / (QL / 64); d.which = 1; return d; } v -= PU1;
  if (v < PU2) { d.dst = p.WukvT; d.gain = p.kv_norm_g; d.K = KVL; d.kt = v % (KVL / 64); d.pt = v / (KVL / 64); d.which = 2; return d; } v -= PU2;
  if (v < PU3) { d.dst = p.WoT; d.gain = nullptr; d.K = D; d.kt = v % (D / 64); d.pt = v / (D / 64); d.which = 3; return d; } v -= PU3;
  d.dst = p.WrT; d.gain = nullptr; d.K = D; d.kt = v % (D / 64); d.pt = v / (D / 64); d.which = 4; return d;
}
__device__ __forceinline__ void phase_prep(const P& p, ldsp lds, int bid, int nb) {
  const int t = threadIdx.x, nl = t & 63, ksub = t >> 6, pl = t >> 3, kc = t & 7;
  for (int u0 = bid; u0 < PUT; u0 += 4 * nb) {
    float v[4][8];
#pragma unroll
    for (int b = 0; b < 4; ++b) { const int u = u0 + b * nb;
#pragma unroll
      for (int kk = 0; kk < 8; ++kk) v[b][kk] = 0.f;
      if (u < PUT) { const PrepDesc d = prep_desc(p, u); const ColSrc cs = colmap_rt(p, d.which, d.pt * 64 + nl);
        if (cs.c >= 0) {
#pragma unroll
          for (int kk = 0; kk < 8; ++kk) { const int k = d.kt * 64 + kk * 8 + ksub; float x = cs.src[(size_t)k * cs.ld + cs.c]; if (d.gain) x *= d.gain[k]; v[b][kk] = x; } } } }
#pragma unroll
    for (int b = 0; b < 4; ++b) { LAS float* tl = (LAS float*)(lds + b * 16640);
#pragma unroll
      for (int kk = 0; kk < 8; ++kk) tl[(kk * 8 + ksub) * 65 + nl] = v[b][kk]; }
    __syncthreads();
#pragma unroll
    for (int b = 0; b < 4; ++b) { const int u = u0 + b * nb;
      if (u < PUT) { const PrepDesc d = prep_desc(p, u); const LAS float* tl = (const LAS float*)(lds + b * 16640);
        u32x4 w;
        w.x = pk_bf16(tl[(kc * 8 + 0) * 65 + pl], tl[(kc * 8 + 1) * 65 + pl]); w.y = pk_bf16(tl[(kc * 8 + 2) * 65 + pl], tl[(kc * 8 + 3) * 65 + pl]);
        w.z = pk_bf16(tl[(kc * 8 + 4) * 65 + pl], tl[(kc * 8 + 5) * 65 + pl]); w.w = pk_bf16(tl[(kc * 8 + 6) * 65 + pl], tl[(kc * 8 + 7) * 65 + pl]);
        *(u32x4*)(d.dst + (size_t)(d.pt * 64 + pl) * d.K + d.kt * 64 + kc * 8) = w; } }
    __syncthreads();
  }
  for (int i = bid * NTHR + threadIdx.x; i < S * 32; i += nb * NTHR) { const int pos = i >> 5, f = i & 31;
    const float ang = (float)pos * powf(10000.f, -(float)f / 32.f); p.ropetab[2 * i] = cosf(ang); p.ropetab[2 * i + 1] = sinf(ang); }
  if (bid == 0) for (int i = threadIdx.x; i < NE * 32; i += NTHR) p.cnt[i] = 0;
  if (bid == (nb > 1 ? 1 : 0) && threadIdx.x < 256) p.moe_done[threadIdx.x] = 0u;
}
__device__ __forceinline__ void rmsnorm_rows_dev(const float* __restrict__ in, const float* __restrict__ g, bf16_t* __restrict__ out, int bid, int nb) {
  const int lane = threadIdx.x & 63, w = (bid * NTHR + threadIdx.x) >> 6, nw = nb * (NTHR / 64);
  for (int r = w; r < T; r += 2 * nw) {
    const int r1 = min(r + nw, T - 1); const bool has1 = r + nw < T;
    const float4* s0 = (const float4*)(in + (size_t)r * D); const float4* s1 = (const float4*)(in + (size_t)r1 * D);
    float4 v0[8], v1[8]; float q0 = 0.f, q1 = 0.f;
#pragma unroll
    for (int i = 0; i < 8; ++i) { v0[i] = s0[i * 64 + lane]; v1[i] = s1[i * 64 + lane]; }
#pragma unroll
    for (int i = 0; i < 8; ++i) { q0 += v0[i].x * v0[i].x + v0[i].y * v0[i].y + v0[i].z * v0[i].z + v0[i].w * v0[i].w; q1 += v1[i].x * v1[i].x + v1[i].y * v1[i].y + v1[i].z * v1[i].z + v1[i].w * v1[i].w; }
    q0 = wave_sum(q0); q1 = wave_sum(q1);
    const float rs0 = rsqrtf(q0 * (1.f / D) + EPS), rs1 = rsqrtf(q1 * (1.f / D) + EPS);
#pragma unroll
    for (int i = 0; i < 8; ++i) { const float4 gg = ((const float4*)g)[i * 64 + lane];
      u32x2 o; o.x = pk_bf16(v0[i].x * rs0 * gg.x, v0[i].y * rs0 * gg.y); o.y = pk_bf16(v0[i].z * rs0 * gg.z, v0[i].w * rs0 * gg.w);
      ((u32x2*)(out + (size_t)r * D))[i * 64 + lane] = o;
      if (has1) { u32x2 o1; o1.x = pk_bf16(v1[i].x * rs1 * gg.x, v1[i].y * rs1 * gg.y); o1.y = pk_bf16(v1[i].z * rs1 * gg.z, v1[i].w * rs1 * gg.w);
        ((u32x2*)(out + (size_t)r1 * D))[i * 64 + lane] = o1; } }
  }
}

namespace att {
typedef float f32x16 __attribute__((ext_vector_type(16)));
constexpr int KVBLK = 64, SHM_V = 64 * 128 * 2, SHM_KN = 64 * 128 * 2, SHM_KR = 64 * 64 * 2, SHM_BUF = SHM_V + SHM_KN + SHM_KR;
constexpr float SCALE = 0.07216878364870322f, THR = 8.f;
#define KSWZ(row, colB) ((row) * 256 + ((colB) ^ (((row) & 7) << 4)))
#define KRSWZ(row, colB) ((row) * 128 + ((colB) ^ ((((row) >> 1) & 7) << 4)))
#define SBAR() __builtin_amdgcn_sched_barrier(0)
__device__ __forceinline__ int crow(int r, int hi) { return (r & 3) + 8 * (r >> 2) + 4 * hi; }
__device__ __forceinline__ unsigned cvtpk(float lo, float hi) { unsigned r; asm volatile("v_cvt_pk_bf16_f32 %0, %1, %2" : "=v"(r) : "v"(lo), "v"(hi)); return r; }
__device__ __forceinline__ void partialSM(f32x16& p0, f32x16& p1, float& m_reg, float& mn, float& alpha) {
  constexpr float C = SCALE * 1.4426950408889634f;
  float pmax = p0[0];
#pragma unroll
  for (int r = 1; r < 16; ++r) pmax = fmaxf(pmax, p0[r]);
#pragma unroll
  for (int r = 0; r < 16; ++r) pmax = fmaxf(pmax, p1[r]);
  { auto rr = __builtin_amdgcn_permlane32_swap(__float_as_uint(pmax), __float_as_uint(pmax), false, false);
    pmax = fmaxf(__uint_as_float(rr[0]), __uint_as_float(rr[1])); }
  if (__builtin_expect(__all(pmax - m_reg <= THR / SCALE), 1)) { mn = m_reg; alpha = 1.f; }
  else { mn = fmaxf(m_reg, pmax); alpha = __builtin_amdgcn_exp2f((m_reg - mn) * C); m_reg = mn; }
  const float mnC = -mn * C;
#pragma unroll
  for (int r = 0; r < 16; ++r) p0[r] = fmaf(p0[r], C, mnC);
#pragma unroll
  for (int r = 0; r < 16; ++r) p1[r] = fmaf(p1[r], C, mnC);
#pragma unroll
  for (int r = 0; r < 16; ++r) p0[r] = __builtin_amdgcn_exp2f(p0[r]);
}
__device__ __forceinline__ void finishSM(f32x16& p0, f32x16& p1, float alpha, float& l_reg, bf16x8& pa0, bf16x8& pa1, bf16x8& pa2, bf16x8& pa3) {
#pragma unroll
  for (int r = 0; r < 16; ++r) p1[r] = __builtin_amdgcn_exp2f(p1[r]);
  float ps = 0;
#pragma unroll
  for (int r = 0; r < 16; ++r) ps += p0[r];
#pragma unroll
  for (int r = 0; r < 16; ++r) ps += p1[r];
  { auto rr = __builtin_amdgcn_permlane32_swap(__float_as_uint(ps), __float_as_uint(ps), false, false);
    ps = __uint_as_float(rr[0]) + __uint_as_float(rr[1]); }
  l_reg = l_reg * alpha + ps;
#define PK4(P_, BASE, OUT) do { unsigned a0 = cvtpk(P_[BASE + 0], P_[BASE + 1]), a1 = cvtpk(P_[BASE + 2], P_[BASE + 3]);   \
    unsigned b0 = cvtpk(P_[BASE + 4], P_[BASE + 5]), b1 = cvtpk(P_[BASE + 6], P_[BASE + 7]);                              \
    auto r0 = __builtin_amdgcn_permlane32_swap(a0, b0, false, false); auto r1 = __builtin_amdgcn_permlane32_swap(a1, b1, false, false); \
    u32x4 w = {r0[0], r1[0], r0[1], r1[1]}; OUT = *reinterpret_cast<bf16x8*>(&w); } while (0)
  PK4(p0, 0, pa0); PK4(p0, 8, pa1); PK4(p1, 0, pa2); PK4(p1, 8, pa3);
#undef PK4
}
__device__ __forceinline__ void qkt(f32x16& p0, f32x16& p1, ldsp Kn, ldsp Kr, const bf16x8 (&qr)[8], ldsp qrl, int r32, int hi) {
  asm volatile("" : "+v"(r32), "+v"(hi));
  p0 = f32x16{}; p1 = f32x16{};
#pragma unroll
  for (int d0 = 0; d0 < 8; ++d0) { const int cb = (d0 * 16 + hi * 8) * 2;
    const bf16x8 b0 = *(const LAS bf16x8*)(Kn + KSWZ(r32, cb)); const bf16x8 b1 = *(const LAS bf16x8*)(Kn + KSWZ(32 + r32, cb));
    p0 = __builtin_amdgcn_mfma_f32_32x32x16_bf16(b0, qr[d0], p0, 0, 0, 0); p1 = __builtin_amdgcn_mfma_f32_32x32x16_bf16(b1, qr[d0], p1, 0, 0, 0); }
#pragma unroll
  for (int d0 = 0; d0 < 4; ++d0) { const int cb = (d0 * 16 + hi * 8) * 2;
    const bf16x8 b0 = *(const LAS bf16x8*)(Kr + KRSWZ(r32, cb)); const bf16x8 b1 = *(const LAS bf16x8*)(Kr + KRSWZ(32 + r32, cb));
    const bf16x8 qf = *(const LAS bf16x8*)(qrl + KSWZ(r32, cb + 128));
    p0 = __builtin_amdgcn_mfma_f32_32x32x16_bf16(b0, qf, p0, 0, 0, 0); p1 = __builtin_amdgcn_mfma_f32_32x32x16_bf16(b1, qf, p1, 0, 0, 0); }
}
__device__ __forceinline__ int v_st(int k, int c) { const int kk = (k & ~0xC) | ((k & 4) << 1) | ((k & 8) >> 1); return ((kk >> 3) * 4 + (c >> 5)) * 512 + ((kk & 7) * 32 + (c & 31)) * 2; }
__device__ __forceinline__ int v_rd_base(int lane) { return ((lane & 3) << 3) | (((lane >> 2) & 3) << 6) | (((lane >> 4) & 1) << 5) | (((lane >> 5) & 1) << 8); }
__device__ __forceinline__ s16x4 trr(ldsp vb, int off) { return __builtin_amdgcn_ds_read_tr16_b64_v4i16((LAS s16x4*)(vb + off)); }
__device__ __forceinline__ void pv_one(f32x16& od, ldsp vb, int d0, bf16x8 pa0, bf16x8 pa1, bf16x8 pa2, bf16x8 pa3) {
#define VOFF(ks, half) (d0 * 512 + (ks) * 4096 + (half) * 2048)
  const s16x4 l0 = trr(vb, VOFF(0, 0)), h0 = trr(vb, VOFF(0, 1)), l1 = trr(vb, VOFF(1, 0)), h1 = trr(vb, VOFF(1, 1));
  const s16x4 l2 = trr(vb, VOFF(2, 0)), h2 = trr(vb, VOFF(2, 1)), l3 = trr(vb, VOFF(3, 0)), h3 = trr(vb, VOFF(3, 1));
#undef VOFF
#define PK(L, H_) (bf16x8){L[0], L[1], L[2], L[3], H_[0], H_[1], H_[2], H_[3]}
  od = __builtin_amdgcn_mfma_f32_32x32x16_bf16(pa0, PK(l0, h0), od, 0, 0, 0);
  od = __builtin_amdgcn_mfma_f32_32x32x16_bf16(pa1, PK(l1, h1), od, 0, 0, 0);
  od = __builtin_amdgcn_mfma_f32_32x32x16_bf16(pa2, PK(l2, h2), od, 0, 0, 0);
  od = __builtin_amdgcn_mfma_f32_32x32x16_bf16(pa3, PK(l3, h3), od, 0, 0, 0);
  SBAR();
#undef PK
}
__device__ __forceinline__ void pv_all(f32x16 (&o)[4], ldsp vb, bf16x8 pa0, bf16x8 pa1, bf16x8 pa2, bf16x8 pa3) {
  pv_one(o[0], vb, 0, pa0, pa1, pa2, pa3); pv_one(o[1], vb, 1, pa0, pa1, pa2, pa3); pv_one(o[2], vb, 2, pa0, pa1, pa2, pa3); pv_one(o[3], vb, 3, pa0, pa1, pa2, pa3);
}
__device__ __forceinline__ void attn_unit(const bf16_t* __restrict__ Qb, const bf16_t* __restrict__ Kh, const bf16_t* __restrict__ Krp, bf16_t* __restrict__ Ob, ldsp lds) {
  int tid = threadIdx.x; asm volatile("" : "+v"(tid));
  const int wid = tid >> 6, lane = tid & 63, r32 = lane & 31, hi = lane >> 5;
  LAS float* ws = (LAS float*)(lds + 2 * SHM_BUF) + wid * 64; LAS float* li_l = ws; LAS float* al_l = ws + 32;
  float m_reg = -1e30f, l_reg = 0; f32x16 o[4] = {}; bf16x8 qr[8];
  const bf16_t* Qw = Qb + (size_t)(wid * 32 + r32) * QW + hi * 8;
#pragma unroll
  for (int d0 = 0; d0 < 8; ++d0) qr[d0] = *(const bf16x8*)(Qw + d0 * 16);
  ldsp qrl = lds + 2 * SHM_BUF + 2048 + wid * 8192;
#pragma unroll
  for (int d0 = 0; d0 < 8; ++d0) *(LAS bf16x8*)(qrl + KSWZ(r32, (d0 * 16 + hi * 8) * 2)) = *(const bf16x8*)(Qw + 64 + d0 * 16);
  const int sr = tid >> 4, sc = (tid & 15) * 8, vst0 = v_st(sr, sc), vst1 = v_st(32 + sr, sc);
  const int rr_ = tid >> 3, rc_ = (tid & 7) * 8;
  const int vrb = v_rd_base(lane);
  bf16x8 vs0, vs1, ks0, ks1, krs;
#define VB(b) (lds + (b) * SHM_BUF)
#define KNB(b) (lds + (b) * SHM_BUF + SHM_V)
#define KRB(b) (lds + (b) * SHM_BUF + SHM_V + SHM_KN)
#define SLOAD(k0) do { const bf16_t* kp0 = Kh + (size_t)((k0) + sr) * KVW + sc; const bf16_t* kp1 = Kh + (size_t)((k0) + 32 + sr) * KVW + sc; \
    vs0 = *(const bf16x8*)(kp0 + 128); vs1 = *(const bf16x8*)(kp1 + 128); ks0 = *(const bf16x8*)kp0; ks1 = *(const bf16x8*)kp1; \
    krs = *(const bf16x8*)(Krp + (size_t)((k0) + rr_) * RD + rc_); } while (0)
#define SWRITE(b) do { *(LAS bf16x8*)(VB(b) + vst0) = vs0; *(LAS bf16x8*)(VB(b) + vst1) = vs1; \
    *(LAS bf16x8*)(KNB(b) + KSWZ(sr, sc * 2)) = ks0; *(LAS bf16x8*)(KNB(b) + KSWZ(32 + sr, sc * 2)) = ks1; \
    *(LAS bf16x8*)(KRB(b) + KRSWZ(rr_, rc_ * 2)) = krs; } while (0)
#define RESC(a) do { if (__any((a) < 1.f)) { if (hi == 0) al_l[r32] = (a); asm volatile("s_waitcnt lgkmcnt(0)" ::: "memory"); \
    _Pragma("unroll") for (int d = 0; d < 4; ++d) _Pragma("unroll") for (int r = 0; r < 16; ++r) o[d][r] *= al_l[crow(r, hi)]; } } while (0)
  f32x16 pA0, pA1, pB0, pB1; float mnA, mnB, alA, alB; bf16x8 pa0, pa1, pa2, pa3; constexpr int NT = S / KVBLK;
  SLOAD(0); SWRITE(0); __syncthreads();
  qkt(pA0, pA1, KNB(0), KRB(0), qr, qrl, r32, hi); partialSM(pA0, pA1, m_reg, mnA, alA);
  SLOAD(KVBLK); SWRITE(1); __syncthreads();
  for (int j = 1; j + 1 < NT; j += 2) {
    SBAR(); qkt(pB0, pB1, KNB(1), KRB(1), qr, qrl, r32, hi);
    finishSM(pA0, pA1, alA, l_reg, pa0, pa1, pa2, pa3); SBAR();
    SLOAD((j + 1) * KVBLK); SBAR();
    pv_all(o, VB(0) + vrb, pa0, pa1, pa2, pa3); partialSM(pB0, pB1, m_reg, mnB, alB);
    __syncthreads(); SWRITE(0);
    RESC(alB); __syncthreads();
    SBAR(); qkt(pA0, pA1, KNB(0), KRB(0), qr, qrl, r32, hi);
    finishSM(pB0, pB1, alB, l_reg, pa0, pa1, pa2, pa3); SBAR();
    SLOAD((j + 2) * KVBLK); SBAR();
    pv_all(o, VB(1) + vrb, pa0, pa1, pa2, pa3); partialSM(pA0, pA1, m_reg, mnA, alA);
    __syncthreads(); SWRITE(1);
    RESC(alA); __syncthreads();
  }
  SBAR(); qkt(pB0, pB1, KNB(1), KRB(1), qr, qrl, r32, hi);
  finishSM(pA0, pA1, alA, l_reg, pa0, pa1, pa2, pa3); SBAR();
  pv_all(o, VB(0) + vrb, pa0, pa1, pa2, pa3); partialSM(pB0, pB1, m_reg, mnB, alB);
  __syncthreads(); RESC(alB);
  finishSM(pB0, pB1, alB, l_reg, pa0, pa1, pa2, pa3); SBAR();
  pv_all(o, VB(1) + vrb, pa0, pa1, pa2, pa3);
  if (hi == 0) li_l[r32] = l_reg; asm volatile("s_waitcnt lgkmcnt(0)" ::: "memory");
  float rli[16];
#pragma unroll
  for (int r = 0; r < 16; ++r) rli[r] = __builtin_amdgcn_rcpf(li_l[crow(r, hi)]);
  bf16_t* Ow = Ob + (size_t)(wid * 32) * D;
#pragma unroll
  for (int r = 0; r < 16; ++r) { const int orow = crow(r, hi);
#pragma unroll
    for (int d0 = 0; d0 < 4; ++d0) Ow[(size_t)orow * D + d0 * 32 + r32] = f2bf(o[d0][r] * rli[r]); }
  __syncthreads();
#undef VB
#undef KNB
#undef KRB
#undef SLOAD
#undef SWRITE
#undef RESC
}
}
__device__ __forceinline__ void phase_attn(const P& p, ldsp lds, int bid, int nb) {
  for (int u = bid; u < NB * H * (S / 256); u += nb) {
    const int qb = u & 7, h = (u >> 3) & 7, b = u >> 6;
    const size_t row0 = (size_t)b * S + qb * 256;
    att::attn_unit(p.q + row0 * QW + h * 192, p.kv + (size_t)b * S * KVW + h * 256, p.krope + (size_t)b * S * RD, p.mix + row0 * D + h * 128, lds);
  }
}


__device__ __forceinline__ void phase_conv(const P& p, ldsp lds, int bid, int nb) {
  LAS float* red = (LAS float*)lds;
  for (int u = bid; u < T / 16; u += nb) {
    int tid = threadIdx.x; asm volatile("" : "+v"(tid));
    const int wid = tid >> 6, lane = tid & 63, ch = tid * 2;
    const int t0 = u * 16, b = t0 / S, s0 = t0 % S;
    float w0[CW], w1[CW];
#pragma unroll
    for (int j = 0; j < CW; ++j) { const float2 wv = *(const float2*)(p.w_dw + j * CC + ch); w0[j] = wv.x; w1[j] = wv.y; }
    const float2 bd = *(const float2*)(p.b_dw + ch);
    float a0[16], a1[16];
#pragma unroll
    for (int i = 0; i < 16; ++i) { a0[i] = bd.x; a1[i] = bd.y; }
#pragma unroll
    for (int rr = 0; rr < 46; ++rr) { const int s = s0 - 15 + rr; float v0 = 0.f, v1 = 0.f;
      { const int scl = min(max(s, 0), S - 1); const unsigned raw = *(const unsigned*)(p.cglu + ((size_t)b * S + scl) * CC + ch);
        const bool ok = (s >= 0 && s < S); v0 = ok ? __uint_as_float(raw << 16) : 0.f; v1 = ok ? __uint_as_float(raw & 0xffff0000u) : 0.f; }
#pragma unroll
      for (int i = 0; i < 16; ++i) { const int j = rr - i; if (j >= 0 && j < CW) { a0[i] += w0[j] * v0; a1[i] += w1[j] * v1; } } }
#pragma unroll
    for (int i = 0; i < 16; ++i) { const float sm = wave_sum(a0[i] + a1[i]), sq = wave_sum(a0[i] * a0[i] + a1[i] * a1[i]);
      if (lane == 0) { red[wid * 32 + i] = sm; red[wid * 32 + 16 + i] = sq; } }
    __syncthreads();
    if (tid < 32) { float t = 0.f;
#pragma unroll
      for (int w = 0; w < 8; ++w) t += red[w * 32 + tid];
      red[256 + tid] = t; }
    __syncthreads();
    const float2 lg = *(const float2*)(p.conv_ln_g + ch), lb = *(const float2*)(p.conv_ln_b + ch);
#pragma unroll
    for (int i = 0; i < 16; ++i) { const float mu = red[256 + i] * (1.f / CC), var = red[256 + 16 + i] * (1.f / CC) - mu * mu; const float rs = rsqrtf(fmaxf(var, 0.f) + EPS);
      const float y0 = (a0[i] - mu) * rs * lg.x + lb.x, y1 = (a1[i] - mu) * rs * lg.y + lb.y;
      *(unsigned*)(p.mix + (size_t)(t0 + i) * D + CC + ch) = pk_bf16(siluf_(y0), siluf_(y1)); }
    __syncthreads();
  }
}

__device__ __forceinline__ void phase_route2(const P& p, ldsp lds, int bid, int nb) {
  constexpr int RS = 4096 + 16;
  const int tid = threadIdx.x, wid = tid >> 6, lane = tid & 63, fr = lane & 15, fq = lane >> 4;
  for (int u = bid; u < T / 32; u += nb) {
    const int t0 = u * 32;
    __syncthreads();
#pragma unroll
    for (int i = 0; i < 16; ++i) { const int c = i * 512 + tid, r = c >> 8, pc = c & 255;
      *(LAS u32x4*)(lds + r * RS + pc * 16) = *(const u32x4*)(p.hn + (size_t)(t0 + r) * D + pc * 8); }
    __syncthreads();
    f32x4 acc[2][5];
#pragma unroll
    for (int m = 0; m < 2; ++m)
#pragma unroll
      for (int n = 0; n < 5; ++n) acc[m][n] = (f32x4){0.f, 0.f, 0.f, 0.f};
#pragma unroll 2
    for (int ks = 0; ks < 8; ++ks) { const int k0 = wid * 256 + ks * 32 + fq * 8;
      bf16x8 Bf[5];
#pragma unroll
      for (int n = 0; n < 5; ++n) Bf[n] = *(const bf16x8*)(p.WrT + (size_t)(n * 16 + fr) * D + k0);
      const bf16x8 A0 = *(const LAS bf16x8*)(lds + fr * RS + k0 * 2), A1 = *(const LAS bf16x8*)(lds + (16 + fr) * RS + k0 * 2);
#pragma unroll
      for (int n = 0; n < 5; ++n) { acc[0][n] = __builtin_amdgcn_mfma_f32_16x16x32_bf16(Bf[n], A0, acc[0][n], 0, 0, 0); acc[1][n] = __builtin_amdgcn_mfma_f32_16x16x32_bf16(Bf[n], A1, acc[1][n], 0, 0, 0); } }
    __syncthreads();
    LAS float* part = (LAS float*)lds;
#pragma unroll
    for (int m = 0; m < 2; ++m)
#pragma unroll
      for (int n = 0; n < 5; ++n) *(LAS f32x4*)(part + (wid * 32 + m * 16 + fr) * 80 + n * 16 + fq * 4) = acc[m][n];
    __syncthreads();
    LAS float* lg_ = part + 8 * 32 * 80;
    for (int o = tid; o < 32 * 80; o += NTHR) { float s = 0.f;
#pragma unroll
      for (int w = 0; w < 8; ++w) s += part[w * 2560 + o];
      lg_[o] = s; }
    __syncthreads();
    if (tid < 32) { const int t = t0 + tid; const LAS float* L_ = lg_ + tid * 80;
      float sq = 0.f;
#pragma unroll
      for (int i = 0; i < 32; i += 4) { const float4 v = *(const float4*)(p.ssq_h + (size_t)t * 32 + i); sq += (v.x + v.y) + (v.z + v.w); }
      const float rs = rsqrtf(sq * (1.f / D) + EPS); p.rstd_h[t] = rs;
      float lg[NG];
#pragma unroll
      for (int j = 0; j < NG; ++j) lg[j] = L_[j] * rs + p.b_group[j];
      int gs = 0; float gm = lg[0];
#pragma unroll
      for (int j = 1; j < NG; ++j) if (lg[j] > gm) { gm = lg[j]; gs = j; }
      float gsum = 0.f;
#pragma unroll
      for (int j = 0; j < NG; ++j) gsum += __expf(lg[j] - gm);
      const float pg = 1.f / gsum;
      float el[EPG];
#pragma unroll
      for (int j = 0; j < EPG; ++j) el[j] = L_[NG + gs * EPG + j] * rs + p.b_router[gs * EPG + j];
      int i1 = 0; float m1 = el[0];
#pragma unroll
      for (int j = 1; j < EPG; ++j) if (el[j] > m1) { m1 = el[j]; i1 = j; }
      int i2 = -1; float m2 = -1e30f;
#pragma unroll
      for (int j = 0; j < EPG; ++j) if (j != i1 && el[j] > m2) { m2 = el[j]; i2 = j; }
      const float e2 = __expf(m2 - m1); const float w1 = 1.f / (1.f + e2), w2 = e2 / (1.f + e2);
      const int ea = gs * EPG + i1, eb = gs * EPG + i2;
      const int pa = atomicAdd(&p.cnt[ea * 32], 1); p.list_tok[ea * LCAP + pa] = t * 2; p.list_gate[ea * LCAP + pa] = pg * w1;
      const int pb = atomicAdd(&p.cnt[eb * 32], 1); p.list_tok[eb * LCAP + pb] = t * 2 + 1; p.list_gate[eb * LCAP + pb] = pg * w2;
    }
  }
}
__device__ __forceinline__ int trw(int k, int c) { return (c >> 4) * 2080 + (k >> 4) * 512 + (((k & 15) * 32) ^ (((k >> 3) & 1) << 7)) + (c & 15) * 2; }
struct MoeUnit { int e, m0, count, sl, start, tile; };
template <int MODE, int PROBE = 0>
__device__ __forceinline__ void moe_stream(const P& p, ldsp lds, int bid, int nb) {
  constexpr int NS = MODE == 0 ? 8 : 16, NK = MODE == 0 ? D / BK : DE / BK, MROWS = 320, NFM = 5, MA_B = MROWS * 128, MSTAGE = MA_B + 16640 + 256;
  constexpr int TAB_OFF = 2 * MSTAGE + 1024, TAB_UNIT = MROWS * 8, CAP = (LDS_BYTES - 16 - TAB_OFF) / TAB_UNIT;
  LAS int* ts = (LAS int*)(lds + 2 * MSTAGE);
  LAS int* stt = ts + 80; LAS int* cntl = ts + 160;
  __syncthreads();
  if (threadIdx.x < NE) cntl[threadIdx.x] = p.cnt[threadIdx.x * 32];
  __syncthreads();
  if (threadIdx.x == 0) { int s = 0, r = 0; for (int e = 0; e < NE; ++e) { const int c = cntl[e]; ts[e] = s; stt[e] = r; s += (c + MROWS - 1) / MROWS; r += c; } ts[NE] = s; stt[NE] = r; }
  __syncthreads();
  const int ntile = ts[NE];
  int xcd, slot, nslots, nloc;
  if ((nb & 7) == 0) { xcd = bid & 7; slot = bid >> 3; nslots = nb >> 3; nloc = ((ntile - xcd + 7) >> 3) * NS; }
  else { xcd = 0; slot = bid; nslots = nb; nloc = ntile * NS; }
  int nu_all = nloc > slot ? (nloc - slot + nslots - 1) / nslots : 0, doff = 0;
  if (MODE == 1) {
    const int nlu = nloc / 2, ubase = nlu / nslots, urem = nlu % nslots, Tt = (4 * nlu + nloc + nslots - 1) / nslots;
    int rem = nloc; nu_all = 0;
    for (int k = 0; k < nslots; ++k) { const int sidx = (k + urem) % nslots, U = sidx < urem ? ubase + 1 : ubase; const int d = min(max(0, Tt - 4 * U), rem);
      if (sidx == slot) { doff = nloc - rem; nu_all = d; } rem -= d; }
  }
  int tid = threadIdx.x; asm volatile("" : "+v"(tid));
  const int wid = tid >> 6, lane = tid & 63, wm = wid >> 1, wn = wid & 1, fr = lane & 15, fq = lane >> 4;
  const bf16_t* abase = MODE == 0 ? p.hn : p.hb;
  constexpr int LDB = (PROBE & 1) ? 128 : (MODE == 0 ? DE : D);
  for (int c0 = 0; c0 < nu_all; c0 += CAP) {
    const int nu = min(CAP, nu_all - c0), total = nu * NK;
    auto unit_of = [&](int j) { MoeUnit u; const int l = MODE == 0 ? slot + (c0 + j) * nslots : doff + c0 + j; const int tile = ((nb & 7) == 0) ? (l / NS) * 8 + xcd : l / NS; u.sl = l % NS; u.tile = tile;
      int e = 0;
#pragma unroll 1
      for (int s = 32; s > 0; s >>= 1) if (e + s < NE && ts[e + s] <= tile) e += s;
      u.e = e; u.m0 = (tile - ts[e]) * MROWS; u.count = min(MROWS, cntl[e] - u.m0); u.start = stt[e]; return u; };
    __syncthreads();
    for (int j = 0; j < nu; ++j) { const MoeUnit u = unit_of(j);
      for (int r = threadIdx.x; r < MROWS; r += NTHR) { const int rr = min(r, u.count - 1);
        if (MODE == 0) { const int tk = p.list_tok[u.e * LCAP + u.m0 + rr] >> 1; ((LAS unsigned*)(lds + TAB_OFF + j * TAB_UNIT))[r] = (unsigned)(tk * D); ((LAS float*)(lds + TAB_OFF + j * TAB_UNIT + MROWS * 4))[r] = p.rstd_h[tk]; }
        else { ((LAS int*)(lds + TAB_OFF + j * TAB_UNIT))[r] = p.list_tok[u.e * LCAP + u.m0 + rr]; ((LAS float*)(lds + TAB_OFF + j * TAB_UNIT + MROWS * 4))[r] = p.list_gate[u.e * LCAP + u.m0 + rr]; } } }
    asm volatile("s_waitcnt vmcnt(0)" ::: "memory");
    __syncthreads();
    unsigned ao[NFM]; int a_j = -1, a_tile = -1;
    auto a_setup = [&](int j) { const MoeUnit u = unit_of(j); a_j = j;
      if (MODE == 1 && u.tile != a_tile) {
        if (wid == 0) { unsigned sp = 0; while (__hip_atomic_load(p.moe_done + u.tile, __ATOMIC_RELAXED, __HIP_MEMORY_SCOPE_AGENT) < 8u) { __builtin_amdgcn_s_sleep(8); if (++sp > (1u << 22)) break; }
          __builtin_amdgcn_fence(__ATOMIC_ACQUIRE, "agent"); asm volatile("s_waitcnt vmcnt(0)" ::: "memory"); }
        __syncthreads(); a_tile = u.tile; }
#pragma unroll
      for (int i = 0; i < NFM; ++i) { int R, C; stage_rc(wid * 1024 + i * 8192 + lane * 16, R, C);
        if (MODE == 0) ao[i] = ((const LAS unsigned*)(lds + TAB_OFF + j * TAB_UNIT))[R] + C; else ao[i] = (unsigned)((u.start + u.m0 + min(R, u.count - 1)) * DE + C); } };
    const float* bsrc = nullptr; int b_j = -1;
    auto b_setup = [&](int j) { const MoeUnit u = unit_of(j); b_j = j; const int tc = (lane & 31) * 4;
      if (PROBE & 1) { if (MODE == 0) bsrc = p.w_gate + (size_t)((u.tile * NS + u.sl) & 255) * D * 128 + (size_t)(8 * wid + (lane >> 5)) * 128 + tc; else bsrc = p.w_down + (size_t)((u.tile * NS + u.sl) & 1023) * DE * 128 + (size_t)(8 * wid + (lane >> 5)) * 128 + tc; }
      else if (MODE == 0) { const int jj = tc & 63; bsrc = (jj < 32 ? p.w_gate : p.w_up) + (size_t)u.e * D * DE + (size_t)(8 * wid + (lane >> 5)) * DE + u.sl * 64 + (tc >> 6) * 32 + (jj & 31); }
      else bsrc = p.w_down + (size_t)u.e * DE * D + (size_t)(8 * wid + (lane >> 5)) * D + u.sl * 128 + tc; };
    u32x4 ar0[NFM]; float4 br0[4], br1[4];
    f32x4 acc[NFM][4];
#pragma unroll
    for (int i = 0; i < NFM; ++i)
#pragma unroll
      for (int n = 0; n < 4; ++n) acc[i][n] = (f32x4){0.f, 0.f, 0.f, 0.f};
#define A_ISSUE(AR, pos_) do { const int pos = min((pos_), total - 1); const int j_ = pos / NK, kt_ = pos % NK; if (j_ != a_j) a_setup(j_); \
      _Pragma("unroll") for (int i = 0; i < NFM; ++i) AR[i] = *(const u32x4*)(abase + ao[i] + kt_ * BK); } while (0)
#define B_ISSUE(BR, pos_) do { const int pos = min((pos_), total - 1); const int j_ = pos / NK, kt_ = pos % NK; if (j_ != b_j) b_setup(j_); \
      _Pragma("unroll") for (int q = 0; q < 4; ++q) BR[q] = *(const float4*)(bsrc + (size_t)(kt_ * BK + 2 * q) * LDB); } while (0)
#define A_WRITE(AR, buf) do { int t_ = tid; asm volatile("" : "+v"(t_)); const int w_i = t_ >> 6, l_i = t_ & 63; \
      _Pragma("unroll") for (int i = 0; i < NFM; ++i) *(LAS u32x4*)(lds + (buf) * MSTAGE + w_i * 1024 + i * 8192 + l_i * 16) = AR[i]; } while (0)
#define B_WRITE(BR, buf) do { int t_ = tid; asm volatile("" : "+v"(t_)); const int w_i = t_ >> 6, l_i = t_ & 63; \
      _Pragma("unroll") for (int q = 0; q < 4; ++q) { u32x2 w_; w_.x = pk_bf16(BR[q].x, BR[q].y); w_.y = pk_bf16(BR[q].z, BR[q].w); \
      const int tc_ = (l_i & 31) * 4, ic_ = MODE == 1 ? ((tc_ & 64) | (((tc_ >> 2) & 3) << 4) | (((tc_ >> 4) & 3) << 2)) : tc_;     \
      *(LAS u32x2*)(lds + (buf) * MSTAGE + MA_B + trw(8 * w_i + 2 * q + (l_i >> 5), ic_)) = w_; } } while (0)
    int c_j = 0; MoeUnit cu = unit_of(0); int nvf = max(0, min(NFM, ((cu.count + 15) / 16 - wm + 3) >> 2));
    auto compute_nf = [&](int buf, auto nfc) {
      constexpr int NF = decltype(nfc)::value;
      ldsp sb = lds + buf * MSTAGE;
      int t_ = tid; asm volatile("" : "+v"(t_));
      const int wn_ = (t_ >> 6) & 1, wm_ = t_ >> 7, fr_ = t_ & 15, fq_ = (t_ >> 4) & 3, q_ = fr_ >> 2, pp_ = fr_ & 3;
      const int lp0 = (fq_ >> 1) * 512 + (fq_ & 1) * 256 + ((fq_ & 1) << 7) + q_ * 32 + pp_ * 8;
      const int trb0 = MA_B + wn_ * 4 * 2080 + lp0, trb1 = MA_B + wn_ * 4 * 2080 + (lp0 ^ 128);
      const int afb = lds_byte(wm_ * 16 + fr_, fq_ * 8);
#pragma unroll
      for (int ks = 0; ks < 2; ++ks) {
        bf16x8 Bf[4];
#pragma unroll
        for (int n = 0; n < 4; ++n) {
          const s16x4 lo = __builtin_amdgcn_ds_read_tr16_b64_v4i16((LAS s16x4*)(sb + trb0 + n * 2080 + ks * 1024));
          const s16x4 hi = __builtin_amdgcn_ds_read_tr16_b64_v4i16((LAS s16x4*)(sb + trb1 + n * 2080 + ks * 1024));
          Bf[n] = __builtin_shufflevector(lo, hi, 0, 1, 2, 3, 4, 5, 6, 7); }
        bf16x8 At[NF];
#pragma unroll
        for (int i = 0; i < NF; ++i) At[i] = *(const LAS bf16x8*)(sb + afb + i * 8192 + ks * 1024);
#pragma unroll
        for (int i = 0; i < NF; ++i)
#pragma unroll
          for (int n = 0; n < 4; ++n) acc[i][n] = __builtin_amdgcn_mfma_f32_16x16x32_bf16(Bf[n], At[i], acc[i][n], 0, 0, 0);
        __builtin_amdgcn_sched_barrier(0);
      }
    };
    auto compute = [&](int buf) {
      if (nvf <= 4) compute_nf(buf, std::integral_constant<int, 4>()); else compute_nf(buf, std::integral_constant<int, 5>()); };
    auto epilogue = [&]() {
      int fr2 = fr, fq2 = fq; asm volatile("" : "+v"(fr2), "+v"(fq2));
#pragma unroll
      for (int i = 0; i < NFM; ++i) { const int r = (wm + 4 * i) * 16 + fr2;
        if (r < cu.count) {
          if (MODE == 0) { bf16_t* dst = ((PROBE & 1) ? (bf16_t*)p.convtmp : p.hb) + (size_t)(cu.start + cu.m0 + r) * DE + cu.sl * 64 + wn * 32 + fq2 * 4;
            const float rs = ((const LAS float*)(lds + TAB_OFF + c_j * TAB_UNIT + MROWS * 4))[r];
#pragma unroll
            for (int n = 0; n < 2; ++n) { const f32x4 g = acc[i][n] * rs, uu = acc[i][n + 2] * rs;
              const unsigned lo = pk_bf16(siluf_(g[0]) * uu[0], siluf_(g[1]) * uu[1]), hi = pk_bf16(siluf_(g[2]) * uu[2], siluf_(g[3]) * uu[3]);
              __hip_atomic_store((unsigned long long*)(dst + n * 16), ((unsigned long long)hi << 32) | lo, __ATOMIC_RELAXED, __HIP_MEMORY_SCOPE_AGENT); } }
          else { const int ts2 = ((const LAS int*)(lds + TAB_OFF + c_j * TAB_UNIT))[r]; const float gate = ((const LAS float*)(lds + TAB_OFF + c_j * TAB_UNIT + MROWS * 4))[r];
            bf16_t* dst = p.y + (size_t)ts2 * D + cu.sl * 128 + wn * 64 + fq2 * 16;
            u32x4 w0, w1;
            w0.x = pk_bf16(acc[i][0][0] * gate, acc[i][0][1] * gate); w0.y = pk_bf16(acc[i][0][2] * gate, acc[i][0][3] * gate); w0.z = pk_bf16(acc[i][1][0] * gate, acc[i][1][1] * gate); w0.w = pk_bf16(acc[i][1][2] * gate, acc[i][1][3] * gate);
            w1.x = pk_bf16(acc[i][2][0] * gate, acc[i][2][1] * gate); w1.y = pk_bf16(acc[i][2][2] * gate, acc[i][2][3] * gate); w1.z = pk_bf16(acc[i][3][0] * gate, acc[i][3][1] * gate); w1.w = pk_bf16(acc[i][3][2] * gate, acc[i][3][3] * gate);
            if (!(PROBE & 16)) { *(u32x4*)dst = w0; *(u32x4*)(dst + 8) = w1; } else asm volatile("" :: "v"(w0.x), "v"(w1.x)); }
        }
#pragma unroll
        for (int n = 0; n < 4; ++n) acc[i][n] = (f32x4){0.f, 0.f, 0.f, 0.f};
      }
    };
    A_ISSUE(ar0, 0); B_ISSUE(br0, 0); A_WRITE(ar0, 0); B_WRITE(br0, 0);
    B_ISSUE(br1, 1); A_ISSUE(ar0, 1); B_ISSUE(br0, 2);
    __syncthreads();
#define STEP(s, BRW, ARW) do { \
      if (!(PROBE & 4)) A_WRITE(ar0, ((s) + 1) & 1); if (!(PROBE & 32)) B_WRITE(BRW, ((s) + 1) & 1); else asm volatile("" :: "v"(BRW[0].x), "v"(BRW[1].x), "v"(BRW[2].x), "v"(BRW[3].x)); \
      if (!(PROBE & 4)) A_ISSUE(ar0, (s) + 2); if (!(PROBE & 8)) B_ISSUE(BRW, (s) + 3); \
      if (!(PROBE & 2)) compute((s) & 1); \
      int sig_ = -1; \
      if (((s) + 1) % NK == 0) { epilogue(); __builtin_amdgcn_s_waitcnt(0x0F70); sig_ = cu.tile; if ((s) + 1 < total) { c_j = ((s) + 1) / NK; cu = unit_of(c_j); nvf = max(0, min(NFM, ((cu.count + 15) / 16 - wm + 3) >> 2)); } } \
      asm volatile("s_waitcnt lgkmcnt(0)" ::: "memory"); __builtin_amdgcn_s_barrier(); \
      if (MODE == 0 && !PROBE && sig_ >= 0 && threadIdx.x == 0) __hip_atomic_fetch_add(p.moe_done + sig_, 1u, __ATOMIC_RELAXED, __HIP_MEMORY_SCOPE_AGENT);     \
      } while (0)
    for (int s = 0; s < total; s += 2) { STEP(s, br1, ar1); STEP(s + 1, br0, ar0); }
    asm volatile("s_waitcnt vmcnt(0)" ::: "memory");
#undef STEP
#undef A_ISSUE
#undef B_ISSUE
#undef A_WRITE
#undef B_WRITE
  }
}
__device__ __forceinline__ void phase_final(const P& p, int bid, int nb) {
  const int lane = threadIdx.x & 63, w = (bid * NTHR + threadIdx.x) >> 6, nw = nb * (NTHR / 64);
  for (int r = w; r < T; r += nw) {
    const u32x2* src = (const u32x2*)(p.h16 + (size_t)r * D);
    const u32x2* y0 = (const u32x2*)(p.y + (size_t)(2 * r) * D); const u32x2* y1 = (const u32x2*)(p.y + (size_t)(2 * r + 1) * D);
    float4 v[8]; float ss = 0.f;
#pragma unroll
    for (int i = 0; i < 8; ++i) { const u32x2 hv = src[i * 64 + lane]; v[i].x = __uint_as_float(hv.x << 16); v[i].y = __uint_as_float(hv.x & 0xffff0000u); v[i].z = __uint_as_float(hv.y << 16); v[i].w = __uint_as_float(hv.y & 0xffff0000u);
      const u32x2 a = y0[i * 64 + lane], b = y1[i * 64 + lane];
      v[i].x += __uint_as_float(a.x << 16) + __uint_as_float(b.x << 16); v[i].y += __uint_as_float(a.x & 0xffff0000u) + __uint_as_float(b.x & 0xffff0000u);
      v[i].z += __uint_as_float(a.y << 16) + __uint_as_float(b.y << 16); v[i].w += __uint_as_float(a.y & 0xffff0000u) + __uint_as_float(b.y & 0xffff0000u);
      ss += v[i].x * v[i].x + v[i].y * v[i].y + v[i].z * v[i].z + v[i].w * v[i].w; }
    ss = wave_sum(ss);
    const float rs = rsqrtf(ss * (1.f / D) + EPS);
#pragma unroll
    for (int i = 0; i < 8; ++i) { const float4 gg = ((const float4*)p.final_g)[i * 64 + lane];
      float4 o; o.x = v[i].x * rs * gg.x; o.y = v[i].y * rs * gg.y; o.z = v[i].z * rs * gg.z; o.w = v[i].w * rs * gg.w;
      ((float4*)(p.out + (size_t)r * D))[i * 64 + lane] = o; }
  }
}

namespace pg8 {
#define PG8_LAS __attribute__((address_space(3)))
typedef unsigned short bf16_t;
typedef short bf16x8 __attribute__((ext_vector_type(8)));
typedef float f32x4 __attribute__((ext_vector_type(4)));
constexpr int BM = 256, BK = 64, HALF = 128, HTB = HALF * BK * 2, STAGE_BYTES = 8 * HTB;
__device__ __forceinline__ int lds_byte(int r, int c) { const int st = (r >> 4) * 2 + (c >> 5), rr = r & 15, cc = c & 31, ob = rr * 64 + cc * 2; return st * 1024 + (ob ^ (((ob >> 9) & 1) << 5)); }
__device__ __forceinline__ void stage_rc(int b, int& R, int& C) { const int st = b / 1024, sb = b % 1024, swz = sb ^ (((sb >> 9) & 1) << 5); R = (st >> 1) * 16 + swz / 64; C = (st & 1) * 32 + (swz % 64) / 2; }
__device__ __forceinline__ int perm32(int rho) { const int n = rho >> 4, i = rho & 15; return 8 * (i >> 2) + 4 * n + (i & 3); }
struct Unit { int pm, pn; };
struct Gemm { const bf16_t* A; const bf16_t* Bt; int M, N, K; };
struct ColMajorOrder { int nM, nwg, G, c;
  __device__ __forceinline__ bool next(int i, Unit& u) const { const int L = i * G + c; if (L >= nwg) return false; u.pm = L % nM; u.pn = L / nM; return true; }
  __device__ __forceinline__ void a_ready(const Unit&) const {}
  __device__ __forceinline__ void done(const Unit&) const {} };
template <class Epi, class Sched, bool ALIGN_EPI = false, bool SP2 = false>
__device__ __forceinline__ void gemm_phase(PG8_LAS unsigned char* lds, const Gemm g, const Sched& S, const Epi& E) {
    const int tid = threadIdx.x, wid = __builtin_amdgcn_readfirstlane(tid >> 6), lane = tid & 63, wr = wid >> 2, wc = wid & 3, fr = lane & 15, fq = lane >> 4;
    const int K = g.K, nt = K / BK;
    unsigned voffA[2], voffB[2];
#pragma unroll
    for (int i = 0; i < 2; ++i) { int R, C; stage_rc(tid * 16 + i * 8192, R, C); const int Rb = Epi::PERM ? ((R & ~31) + perm32(R & 31)) : R;
        voffA[i] = (unsigned)(R * K + C) * 2u; voffB[i] = (unsigned)(Rb * K + C) * 2u; }
    const size_t kstep = (size_t)(BK * 2);
    const size_t hstep = (size_t)HALF * K * 2;
    const size_t tstep = 2 * hstep;
    const unsigned ldsw = (unsigned)wid * 1024u;
    const int aoff = lds_byte(wr * 64 + fr, fq * 8), boff = lds_byte(wc * 32 + fr, fq * 8);
#define PG8_SA(b, h) (((b) * 2 + (h)) * HTB)
#define PG8_SB(b, h) ((4 + (b) * 2 + (h)) * HTB)
#define PG8_STAGE(bufoff, gbase, voff) do { _Pragma("unroll") for (int _i = 0; _i < 2; ++_i) \
        __builtin_amdgcn_global_load_lds((const unsigned*)((const char*)(gbase) + (voff)[_i]), (PG8_LAS unsigned*)(lds + (bufoff) + ldsw + _i * 8192), 16, 0, 0); } while (0)
#define PG8_LDA(dst, b, h) do { _Pragma("unroll") for (int m = 0; m < 4; ++m) _Pragma("unroll") for (int k = 0; k < 2; ++k) dst[m][k] = *(const PG8_LAS bf16x8*)(lds + PG8_SA(b, h) + aoff + m * 2048 + k * 1024); } while (0)
#define PG8_LDB(dst, b, h) do { _Pragma("unroll") for (int n = 0; n < 2; ++n) _Pragma("unroll") for (int k = 0; k < 2; ++k) dst[n][k] = *(const PG8_LAS bf16x8*)(lds + PG8_SB(b, h) + boff + n * 2048 + k * 1024); } while (0)
#define PG8_MMA(ai, bj, At, Bt) do { __builtin_amdgcn_s_setprio(1); _Pragma("unroll") for (int m = 0; m < 4; ++m) _Pragma("unroll") for (int n = 0; n < 2; ++n) _Pragma("unroll") for (int k = 0; k < 2; ++k) \
        acc[ai][bj][m][n] = __builtin_amdgcn_mfma_f32_16x16x32_bf16(Bt[n][k], At[m][k], acc[ai][bj][m][n], 0, 0, 0); __builtin_amdgcn_s_setprio(0); } while (0)
#define PG8_WAIT_V(n) asm volatile("s_waitcnt vmcnt(" #n ")" ::: "memory")
#define PG8_WAIT_L(n) asm volatile("s_waitcnt lgkmcnt(" #n ")" ::: "memory")
#define PG8_BAR __builtin_amdgcn_s_barrier()
#define PG8_SCHED __builtin_amdgcn_sched_barrier(0)
    Unit cur, nxt; int ui = 0;
    if (!S.next(0, cur)) return;
    f32x4 acc[2][2][4][2];
#pragma unroll
    for (int a = 0; a < 2; ++a)
#pragma unroll
        for (int b = 0; b < 2; ++b)
#pragma unroll
            for (int m = 0; m < 4; ++m)
#pragma unroll
                for (int n = 0; n < 2; ++n) acc[a][b][m][n] = (f32x4){0.f, 0.f, 0.f, 0.f};
    bf16x8 At[4][2], B0[2][2], B1[2][2];
    const char* cA = (const char*)g.A + (size_t)cur.pm * tstep; const char* cB = (const char*)g.Bt + (size_t)cur.pn * tstep;
    S.a_ready(cur);
    if constexpr (SP2) {
        PG8_STAGE(PG8_SB(0, 0), cB, voffB); PG8_STAGE(PG8_SB(0, 1), cB + hstep, voffB); PG8_STAGE(PG8_SA(0, 0), cA, voffA); PG8_STAGE(PG8_SA(0, 1), cA + hstep, voffA);
        if (wr == 1) PG8_BAR;
        PG8_WAIT_V(2); PG8_BAR;
        PG8_STAGE(PG8_SB(1, 0), cB + kstep, voffB); PG8_STAGE(PG8_SA(1, 0), cA + kstep, voffA); PG8_STAGE(PG8_SB(1, 1), cB + hstep + kstep, voffB);
        PG8_WAIT_V(6); PG8_BAR;
    } else {
        PG8_STAGE(PG8_SB(0, 0), cB, voffB); PG8_STAGE(PG8_SA(0, 0), cA, voffA); PG8_STAGE(PG8_SB(0, 1), cB + hstep, voffB); PG8_STAGE(PG8_SA(0, 1), cA + hstep, voffA);
        if (wr == 1) PG8_BAR;
        PG8_WAIT_V(4); PG8_BAR;
        PG8_STAGE(PG8_SB(1, 0), cB + kstep, voffB); PG8_STAGE(PG8_SA(1, 0), cA + kstep, voffA); PG8_STAGE(PG8_SB(1, 1), cB + hstep + kstep, voffB);
        PG8_WAIT_V(6); PG8_BAR;
    }
    for (;;) {
        const bool has_next = S.next(ui + 1, nxt);
        const char* nA = has_next ? (const char*)g.A + (size_t)nxt.pm * tstep : cA; const char* nB = has_next ? (const char*)g.Bt + (size_t)nxt.pn * tstep : cB;
        for (int t = 0; t < nt; t += 2) {
            const bool last = (t == nt - 2);
            const char* a1 = cA + (size_t)(t + 1) * kstep;
            const char* a2 = last ? nA : cA + (size_t)(t + 2) * kstep; const char* b2 = last ? nB : cB + (size_t)(t + 2) * kstep;
            const char* a3 = a2 + kstep; const char* b3 = b2 + kstep;
            if (last && has_next) S.a_ready(nxt);
            if constexpr (SP2) {
            PG8_LDB(B0, 0, 0); PG8_LDB(B1, 0, 1); PG8_SCHED; PG8_LDA(At, 0, 0); PG8_STAGE(PG8_SA(1, 1), a1 + hstep, voffA);
            PG8_WAIT_V(8); PG8_WAIT_L(0); PG8_BAR; PG8_MMA(0, 0, At, B0); PG8_MMA(0, 1, At, B1); PG8_BAR; PG8_SCHED;
            PG8_LDA(At, 0, 1); PG8_STAGE(PG8_SB(0, 0), b2, voffB); PG8_STAGE(PG8_SB(0, 1), b2 + hstep, voffB); PG8_STAGE(PG8_SA(0, 0), a2, voffA);
            PG8_WAIT_V(8); PG8_WAIT_L(0); PG8_BAR; PG8_MMA(1, 0, At, B0); PG8_MMA(1, 1, At, B1); PG8_BAR; PG8_SCHED;
            PG8_LDB(B0, 1, 0); PG8_LDB(B1, 1, 1); PG8_SCHED; PG8_LDA(At, 1, 0); PG8_STAGE(PG8_SA(0, 1), a2 + hstep, voffA);
            PG8_WAIT_V(8); PG8_WAIT_L(0); PG8_BAR; PG8_MMA(0, 0, At, B0); PG8_MMA(0, 1, At, B1); PG8_BAR; PG8_SCHED;
            PG8_LDA(At, 1, 1); PG8_STAGE(PG8_SB(1, 0), b3, voffB); PG8_STAGE(PG8_SB(1, 1), b3 + hstep, voffB); PG8_STAGE(PG8_SA(1, 0), a3, voffA);
            PG8_WAIT_V(8); PG8_WAIT_L(0); PG8_BAR; PG8_MMA(1, 0, At, B0); PG8_MMA(1, 1, At, B1); PG8_BAR; PG8_SCHED;
            } else {
            PG8_LDB(B0, 0, 0); PG8_SCHED; PG8_LDA(At, 0, 0); PG8_STAGE(PG8_SA(1, 1), a1 + hstep, voffA);
            PG8_WAIT_L(8); PG8_BAR; PG8_WAIT_L(0); PG8_MMA(0, 0, At, B0); PG8_BAR; PG8_SCHED;
            PG8_LDB(B1, 0, 1); PG8_STAGE(PG8_SB(0, 0), b2, voffB);
            PG8_BAR; PG8_WAIT_L(0); PG8_MMA(0, 1, At, B1); PG8_BAR;
            PG8_LDA(At, 0, 1); PG8_STAGE(PG8_SA(0, 0), a2, voffA);
            PG8_BAR; PG8_WAIT_L(0); PG8_MMA(1, 0, At, B0); PG8_BAR; PG8_SCHED;
            PG8_STAGE(PG8_SB(0, 1), b2 + hstep, voffB);
            PG8_WAIT_V(6); PG8_BAR; PG8_MMA(1, 1, At, B1); PG8_BAR;
            PG8_LDB(B0, 1, 0); PG8_SCHED; PG8_LDA(At, 1, 0); PG8_STAGE(PG8_SA(0, 1), a2 + hstep, voffA);
            PG8_WAIT_L(8); PG8_BAR; PG8_WAIT_L(0); PG8_MMA(0, 0, At, B0); PG8_BAR; PG8_SCHED;
            PG8_LDB(B1, 1, 1); PG8_STAGE(PG8_SB(1, 0), b3, voffB);
            PG8_BAR; PG8_WAIT_L(0); PG8_MMA(0, 1, At, B1); PG8_BAR;
            PG8_LDA(At, 1, 1); PG8_STAGE(PG8_SA(1, 0), a3, voffA);
            PG8_BAR; PG8_WAIT_L(0); PG8_MMA(1, 0, At, B0); PG8_BAR; PG8_SCHED;
            PG8_STAGE(PG8_SB(1, 1), b3 + hstep, voffB);
            PG8_WAIT_V(6); PG8_BAR; PG8_MMA(1, 1, At, B1); PG8_BAR;
            }
        }
        if constexpr (ALIGN_EPI) { if (wr == 0) PG8_BAR; }
        if constexpr (!Epi::AFTER_DRAIN) { E(acc, cur, wr, wc, fr, fq); S.done(cur); }
        if (!has_next) break;
#pragma unroll
        for (int a = 0; a < 2; ++a)
#pragma unroll
            for (int b = 0; b < 2; ++b)
#pragma unroll
                for (int m = 0; m < 4; ++m)
#pragma unroll
                    for (int n = 0; n < 2; ++n) acc[a][b][m][n] = (f32x4){0.f, 0.f, 0.f, 0.f};
        cur = nxt; cA = nA; cB = nB; ++ui;
        if constexpr (ALIGN_EPI) { if (wr == 1) PG8_BAR; }
    }
    PG8_WAIT_V(0);
    if constexpr (!ALIGN_EPI) { if (wr == 0) PG8_BAR; }
    PG8_BAR;
    if constexpr (Epi::AFTER_DRAIN) { E.fused(acc, cur, wr, wc, fr, fq, lds, wid, lane); S.done(cur); }
#undef PG8_SA
#undef PG8_SB
#undef PG8_STAGE
#undef PG8_LDA
#undef PG8_LDB
#undef PG8_MMA
#undef PG8_WAIT_V
#undef PG8_WAIT_L
#undef PG8_BAR
#undef PG8_SCHED
}
}

#define EPI_DRAIN() asm volatile("s_waitcnt vmcnt(0)" ::: "memory")
struct Epi1 {
  static constexpr bool PERM = false, AFTER_DRAIN = false; P p;
  __device__ __forceinline__ void operator()(const f32x4 (&acc)[2][2][4][2], const pg8::Unit& u, int wr, int wc, int fr, int fq) const {
    const int pn = u.pn;
    if (pn <= 4) {
      bf16_t* dst; int ld, c0; float* ssq; int sst;
      if (pn < 3) { dst = p.qlat; ld = QL; c0 = pn * 256; ssq = p.ssq_q + pn * 4 + wc; sst = 12; } else { dst = p.kvlat; ld = KVL; c0 = (pn - 3) * 256; ssq = p.ssq_kv + (pn - 3) * 4 + wc; sst = 8; }
#pragma unroll
      for (int ai = 0; ai < 2; ++ai)
#pragma unroll
        for (int m = 0; m < 4; ++m) { const int row = u.pm * 256 + ai * 128 + wr * 64 + m * 16 + fr; float s = 0.f;
#pragma unroll
          for (int bj = 0; bj < 2; ++bj)
#pragma unroll
            for (int n = 0; n < 2; ++n) { const f32x4 a = acc[ai][bj][m][n]; s += a[0] * a[0] + a[1] * a[1] + a[2] * a[2] + a[3] * a[3];
              u32x2 w; w.x = pk_bf16(a[0], a[1]); w.y = pk_bf16(a[2], a[3]); *(u32x2*)(dst + (size_t)row * ld + c0 + bj * 128 + wc * 32 + n * 16 + fq * 4) = w; }
          s += __shfl_xor(s, 16); s += __shfl_xor(s, 32);
          if (fq == 0) ssq[(size_t)row * sst] = s; }
    } else if (pn <= 12) {
#pragma unroll
      for (int n = 0; n < 2; ++n) { const int ch = (pn - 5) * 128 + wc * 32 + n * 16 + fq * 4; const float4 ba = *(const float4*)(p.b_glu + ch), bg = *(const float4*)(p.b_glu + 1024 + ch);
#pragma unroll
        for (int ai = 0; ai < 2; ++ai)
#pragma unroll
          for (int m = 0; m < 4; ++m) { const int row = u.pm * 256 + ai * 128 + wr * 64 + m * 16 + fr; const f32x4 a = acc[ai][0][m][n], g = acc[ai][1][m][n];
            u32x2 w; w.x = pk_bf16((a[0] + ba.x) * sigmoidf_(g[0] + bg.x), (a[1] + ba.y) * sigmoidf_(g[1] + bg.y));
            w.y = pk_bf16((a[2] + ba.z) * sigmoidf_(g[2] + bg.z), (a[3] + ba.w) * sigmoidf_(g[3] + bg.w));
            *(u32x2*)(p.cglu + (size_t)row * CC + ch) = w; } }
    } else if (wc == 0) {
#pragma unroll
      for (int ai = 0; ai < 2; ++ai)
#pragma unroll
        for (int m = 0; m < 4; ++m) { const int row = u.pm * 256 + ai * 128 + wr * 64 + m * 16 + fr; const int pos = row & (S - 1);
#pragma unroll
          for (int n = 0; n < 2; ++n) { const int j = n * 16 + fq * 4; const f32x4 x1 = acc[ai][0][m][n], x2 = acc[ai][1][m][n];
            const float4 cs0 = *(const float4*)(p.ropetab + (pos * 32 + j) * 2), cs1 = *(const float4*)(p.ropetab + (pos * 32 + j) * 2 + 4);
            u32x2 lo, hi;
            lo.x = pk_bf16(x1[0] * cs0.x - x2[0] * cs0.y, x1[1] * cs0.z - x2[1] * cs0.w); lo.y = pk_bf16(x1[2] * cs1.x - x2[2] * cs1.y, x1[3] * cs1.z - x2[3] * cs1.w);
            hi.x = pk_bf16(x2[0] * cs0.x + x1[0] * cs0.y, x2[1] * cs0.z + x1[1] * cs0.w); hi.y = pk_bf16(x2[2] * cs1.x + x1[2] * cs1.y, x2[3] * cs1.z + x1[3] * cs1.w);
            *(u32x2*)(p.krope + (size_t)row * RD + j) = lo; *(u32x2*)(p.krope + (size_t)row * RD + 32 + j) = hi; } }
    }
    EPI_DRAIN();
  }
};
struct Epi2q {
  static constexpr bool PERM = false, AFTER_DRAIN = false; P p;
  __device__ __forceinline__ void operator()(const f32x4 (&acc)[2][2][4][2], const pg8::Unit& u, int wr, int wc, int fr, int fq) const {
    const int pn = u.pn;
#pragma unroll
    for (int ai = 0; ai < 2; ++ai)
#pragma unroll
      for (int m = 0; m < 4; ++m) { const int row = u.pm * 256 + ai * 128 + wr * 64 + m * 16 + fr;
        float sq = 0.f;
#pragma unroll
        for (int i = 0; i < 12; i += 4) { const float4 v = *(const float4*)(p.ssq_q + (size_t)row * 12 + i); sq += v.x + v.y + v.z + v.w; }
        const float rs = rsqrtf(sq * (1.f / QL) + EPS);
        if (pn < 4) {
#pragma unroll
          for (int bj = 0; bj < 2; ++bj)
#pragma unroll
            for (int n = 0; n < 2; ++n) { const f32x4 a = acc[ai][bj][m][n]; u32x2 w; w.x = pk_bf16(a[0] * rs, a[1] * rs); w.y = pk_bf16(a[2] * rs, a[3] * rs);
              *(u32x2*)(p.q + (size_t)row * QW + (2 * pn + bj) * 192 + wc * 32 + n * 16 + fq * 4) = w; }
        } else { const int pos = row & (S - 1); bf16_t* dst = p.q + (size_t)row * QW + ((pn - 4) * 4 + wc) * 192 + 128;
#pragma unroll
          for (int n = 0; n < 2; ++n) { const int j = n * 16 + fq * 4; const f32x4 x1 = acc[ai][0][m][n] * rs, x2 = acc[ai][1][m][n] * rs;
            const float4 cs0 = *(const float4*)(p.ropetab + (pos * 32 + j) * 2), cs1 = *(const float4*)(p.ropetab + (pos * 32 + j) * 2 + 4);
            u32x2 lo, hi;
            lo.x = pk_bf16(x1[0] * cs0.x - x2[0] * cs0.y, x1[1] * cs0.z - x2[1] * cs0.w); lo.y = pk_bf16(x1[2] * cs1.x - x2[2] * cs1.y, x1[3] * cs1.z - x2[3] * cs1.w);
            hi.x = pk_bf16(x2[0] * cs0.x + x1[0] * cs0.y, x2[1] * cs0.z + x1[1] * cs0.w); hi.y = pk_bf16(x2[2] * cs1.x + x1[2] * cs1.y, x2[3] * cs1.z + x1[3] * cs1.w);
            *(u32x2*)(dst + j) = lo; *(u32x2*)(dst + 32 + j) = hi; } }
      }
    EPI_DRAIN();
  }
};
struct Epi2kv {
  static constexpr bool PERM = false, AFTER_DRAIN = false; P p;
  __device__ __forceinline__ void operator()(const f32x4 (&acc)[2][2][4][2], const pg8::Unit& u, int wr, int wc, int fr, int fq) const {
#pragma unroll
    for (int ai = 0; ai < 2; ++ai)
#pragma unroll
      for (int m = 0; m < 4; ++m) { const int row = u.pm * 256 + ai * 128 + wr * 64 + m * 16 + fr;
        const float4 v0 = *(const float4*)(p.ssq_kv + (size_t)row * 8), v1 = *(const float4*)(p.ssq_kv + (size_t)row * 8 + 4);
        const float rs = rsqrtf((v0.x + v0.y + v0.z + v0.w + v1.x + v1.y + v1.z + v1.w) * (1.f / KVL) + EPS);
#pragma unroll
        for (int bj = 0; bj < 2; ++bj)
#pragma unroll
          for (int n = 0; n < 2; ++n) { const f32x4 a = acc[ai][bj][m][n]; u32x2 w; w.x = pk_bf16(a[0] * rs, a[1] * rs); w.y = pk_bf16(a[2] * rs, a[3] * rs);
            *(u32x2*)(p.kv + (size_t)row * KVW + u.pn * 256 + bj * 128 + wc * 32 + n * 16 + fq * 4) = w; } }
    EPI_DRAIN();
  }
};
struct Epi3 {
  static constexpr bool PERM = true, AFTER_DRAIN = false; P p;
  __device__ __forceinline__ void operator()(const f32x4 (&acc)[2][2][4][2], const pg8::Unit& u, int wr, int wc, int fr, int fq) const {
    float4 g2[2][2];
#pragma unroll
    for (int bj = 0; bj < 2; ++bj)
#pragma unroll
      for (int n = 0; n < 2; ++n) g2[bj][n] = *(const float4*)(p.ln2_g + u.pn * 256 + bj * 128 + wc * 32 + fq * 8 + n * 4);
#pragma unroll
    for (int ai = 0; ai < 2; ++ai)
#pragma unroll
      for (int m = 0; m < 4; ++m) { const int row = u.pm * 256 + ai * 128 + wr * 64 + m * 16 + fr; float s = 0.f;
#pragma unroll
        for (int bj = 0; bj < 2; ++bj) { const size_t o_ = (size_t)row * D + u.pn * 256 + bj * 128 + wc * 32 + fq * 8;
          const float4 x0 = *(const float4*)(p.x + o_), x1 = *(const float4*)(p.x + o_ + 4); const f32x4 a0 = acc[ai][bj][m][0], a1 = acc[ai][bj][m][1];
          const float h0 = x0.x + a0[0], h1 = x0.y + a0[1], h2 = x0.z + a0[2], h3 = x0.w + a0[3], h4 = x1.x + a1[0], h5 = x1.y + a1[1], h6 = x1.z + a1[2], h7 = x1.w + a1[3];
          s += (h0 * h0 + h1 * h1) + (h2 * h2 + h3 * h3) + (h4 * h4 + h5 * h5) + (h6 * h6 + h7 * h7);
          *(u32x4*)(p.h16 + o_) = (u32x4){pk_bf16(h0, h1), pk_bf16(h2, h3), pk_bf16(h4, h5), pk_bf16(h6, h7)};
          const float4 ga = g2[bj][0], gb = g2[bj][1];
          *(u32x4*)(p.hn + o_) = (u32x4){pk_bf16(h0 * ga.x, h1 * ga.y), pk_bf16(h2 * ga.z, h3 * ga.w), pk_bf16(h4 * gb.x, h5 * gb.y), pk_bf16(h6 * gb.z, h7 * gb.w)}; }
        s += __shfl_xor(s, 16); s += __shfl_xor(s, 32);
        if (fq == 0) p.ssq_h[(size_t)row * 32 + u.pn * 4 + wc] = s; }
    EPI_DRAIN();
  }
};
__device__ __forceinline__ void phase_gemm1_pg8(const P& p, ldsp lds, int bid, int nb) {
  pg8::Gemm g; g.A = p.xn; g.Bt = p.WinT; g.M = T; g.N = NP1; g.K = D;
  pg8::ColMajorOrder S_; S_.nM = T / 256; S_.nwg = (T / 256) * (NP1 / 256); S_.G = nb; S_.c = bid;
  Epi1 E; E.p = p; pg8::gemm_phase<Epi1, pg8::ColMajorOrder, true, true>(lds, g, S_, E);
}
__device__ __forceinline__ void phase_gemm2_pg8(const P& p, ldsp lds, int bid, int nb) {
  { pg8::Gemm g; g.A = p.qlat; g.Bt = p.WuqT; g.M = T; g.N = QW; g.K = QL;
    pg8::ColMajorOrder S_; S_.nM = T / 256; S_.nwg = (T / 256) * (QW / 256); S_.G = nb; S_.c = bid;
    Epi2q E; E.p = p; pg8::gemm_phase<Epi2q, pg8::ColMajorOrder, true, true>(lds, g, S_, E); }
  { pg8::Gemm g; g.A = p.kvlat; g.Bt = p.WukvT; g.M = T; g.N = KVW; g.K = KVL;
    pg8::ColMajorOrder S_; S_.nM = T / 256; S_.nwg = (T / 256) * (KVW / 256); S_.G = nb; S_.c = (bid + 192) % nb;
    Epi2kv E; E.p = p; pg8::gemm_phase<Epi2kv, pg8::ColMajorOrder, true, true>(lds, g, S_, E); }
}
__device__ __forceinline__ void phase_gemm3_pg8(const P& p, ldsp lds, int bid, int nb) {
  pg8::Gemm g; g.A = p.mix; g.Bt = p.WoT; g.M = T; g.N = D; g.K = D;
  pg8::ColMajorOrder S_; S_.nM = T / 256; S_.nwg = (T / 256) * (D / 256); S_.G = nb; S_.c = bid;
  Epi3 E; E.p = p; pg8::gemm_phase<Epi3, pg8::ColMajorOrder, true, true>(lds, g, S_, E);
}
#define XB_TMO      128
#define XB_XCNT(j)  (256  + 64 * (j))
#define XB_XSUB(j)  (1280 + 64 * (j))
#define XB_XGEN(j)  (2304 + 64 * (j))
#define XB_TOP      3328
#define XB_TOPGEN   3392
#define XCD_BAR_WORDS 3456
#define XB_SPIN_CAP (1u << 20)
__device__ __forceinline__ unsigned xb_ld(unsigned* p)              { return __hip_atomic_load(p, __ATOMIC_RELAXED, __HIP_MEMORY_SCOPE_AGENT); }
__device__ __forceinline__ unsigned xb_add(unsigned* p, unsigned v) { return __hip_atomic_fetch_add(p, v, __ATOMIC_RELAXED, __HIP_MEMORY_SCOPE_AGENT); }
__device__ __forceinline__ unsigned xb_xcc_id() { return (unsigned)__builtin_amdgcn_s_getreg((3 << 11) | 20) & 0xFu; }
#define XB_SPIN(cond, bar) do { unsigned _sp = 0; while (cond) { __builtin_amdgcn_s_sleep(1); \
    if ((++_sp & 255u) == 0u) { if (xb_ld(&(bar)[XB_TMO])) break; if (_sp > XB_SPIN_CAP) { atomicAdd(&(bar)[XB_TMO], 1u); break; } } } } while (0)
struct XcdBarrier { unsigned* bar; unsigned x; volatile LAS unsigned* st; };
__device__ __forceinline__ XcdBarrier xcd_barrier_post(unsigned* bar, volatile LAS unsigned* st) {
  XcdBarrier b; b.bar = bar; b.x = xb_xcc_id(); b.st = st;
  if (threadIdx.x == 0) (void)xb_add(&bar[XB_XCNT(b.x)], 1u);
  return b;
}
__device__ __forceinline__ void xcd_barrier_complete(unsigned* bar, unsigned x, unsigned& nloc, unsigned& nx) {
  const unsigned G = gridDim.x * gridDim.y * gridDim.z;
  unsigned sum, cnt, mine, sp = 0u;
  for (;;) {
    sum = 0u; cnt = 0u; mine = 0u;
#pragma unroll
    for (unsigned j = 0; j < 16; ++j) { const unsigned c = xb_ld(&bar[XB_XCNT(j)]); sum += c; cnt += (c > 0u) ? 1u : 0u; mine = (j == x) ? c : mine; }
    if (sum == G) break;
    __builtin_amdgcn_s_sleep(1);
    if ((++sp & 255u) == 0u) { if (xb_ld(&bar[XB_TMO])) break; if (sp > XB_SPIN_CAP) { atomicAdd(&bar[XB_TMO], 1u); break; } }
  }
  nloc = mine > 0u ? mine : 1u; nx = cnt > 0u ? cnt : 1u;
}
__device__ __forceinline__ void xcd_barrier(const XcdBarrier& b) {
  asm volatile("s_waitcnt vmcnt(0)" ::: "memory");
  __syncthreads();
  if (threadIdx.x == 0) {
    unsigned* bar = b.bar;
    __builtin_amdgcn_s_waitcnt(0);
    unsigned nloc = b.st[0], nx = b.st[1];
    if (nloc == 0u) { xcd_barrier_complete(bar, b.x, nloc, nx); b.st[0] = nloc; b.st[1] = nx; }
    const unsigned old = xb_add(&bar[XB_XSUB(b.x)], 1u);
    const unsigned gen = old / nloc;
    if (old + 1u == (gen + 1u) * nloc) {
      __builtin_amdgcn_fence(__ATOMIC_RELEASE, "agent");
      asm volatile("s_waitcnt vmcnt(0)" ::: "memory");
      const unsigned og = xb_add(&bar[XB_TOP], 1u);
      const unsigned tg = og / nx;
      if (og + 1u == (tg + 1u) * nx) xb_add(&bar[XB_TOPGEN], 1u);
      else XB_SPIN(xb_ld(&bar[XB_TOPGEN]) == tg, bar);
      __builtin_amdgcn_fence(__ATOMIC_ACQUIRE, "agent");
      xb_add(&bar[XB_XGEN(b.x)], 1u);
      asm volatile("s_waitcnt vmcnt(0)" ::: "memory");
    } else {
      XB_SPIN(xb_ld(&bar[XB_XGEN(b.x)]) == gen, bar);
      __builtin_amdgcn_fence(__ATOMIC_ACQUIRE, "agent");
      asm volatile("s_waitcnt vmcnt(0)" ::: "memory");
    }
  }
  __syncthreads();
}

__global__ __launch_bounds__(NTHR, 2) void mega_fwd(P p) {
  extern __shared__ __attribute__((aligned(16))) unsigned char smem[];
  ldsp lds = (ldsp)smem;
  volatile LAS unsigned* st = (volatile LAS unsigned*)(lds + LDS_BYTES - 16);
  if (threadIdx.x == 0) { st[0] = 0u; st[1] = 0u; st[2] = 0u; st[3] = 0u; }
  __syncthreads();
  const XcdBarrier bar = xcd_barrier_post(p.bar, st);
  const int bid = blockIdx.x, nb = gridDim.x;
  phase_prep(p, lds, bid, nb); rmsnorm_rows_dev(p.x, p.ln1_g, p.xn, bid, nb);
  xcd_barrier(bar);
  phase_gemm1_pg8(p, lds, bid, nb);
  xcd_barrier(bar);
  phase_gemm2_pg8(p, lds, bid, nb); phase_conv(p, lds, bid, nb);
  xcd_barrier(bar);
  phase_attn(p, lds, bid, nb);
  xcd_barrier(bar);
  phase_gemm3_pg8(p, lds, bid, nb);
  xcd_barrier(bar);
  phase_route2(p, lds, bid, nb);
  xcd_barrier(bar);
  moe_stream<0>(p, lds, bid, nb);
  moe_stream<1>(p, lds, bid, nb);
  xcd_barrier(bar);
  phase_final(p, bid, nb);
}

static size_t carve(size_t& off, size_t bytes) { const size_t o = off; off += (bytes + 255) & ~(size_t)255; return o; }

extern "C" void kernel_launch(void* const* d_in, const int* in_sizes, int n_in, void* d_out, int out_size, void* d_ws, size_t ws_size, hipStream_t stream) {
  P p{};
  const float** pin = (const float**)&p.x;
  for (int i = 0; i < 22; ++i) pin[i] = (const float*)d_in[i];
  p.out = (float*)d_out;
  char* ws = (char*)d_ws; size_t off = 0;
  p.cnt = (int*)(ws + carve(off, NE * 32 * 4));
  p.bar = (unsigned*)(ws + carve(off, XCD_BAR_WORDS * 4));
  p.moe_done = (unsigned*)(ws + carve(off, 1024));
  p.ssq_h = (float*)(ws + carve(off, (size_t)T * 32 * 4));
  p.rstd_h = (float*)(ws + carve(off, (size_t)T * 4));
  p.h16 = (bf16_t*)(ws + carve(off, (size_t)T * D * 2));
  p.xn = (bf16_t*)(ws + carve(off, (size_t)T * D * 2));
  p.qlat = (bf16_t*)(ws + carve(off, (size_t)T * QL * 2));
  p.kvlat = (bf16_t*)(ws + carve(off, (size_t)T * KVL * 2));
  p.krope = (bf16_t*)(ws + carve(off, (size_t)T * RD * 2));
  p.cglu = (bf16_t*)(ws + carve(off, (size_t)T * CC * 2));
  p.q = (bf16_t*)(ws + carve(off, (size_t)T * QW * 2));
  p.kv = (bf16_t*)(ws + carve(off, (size_t)T * KVW * 2));
  p.mix = (bf16_t*)(ws + carve(off, (size_t)T * D * 2));
  p.hn = (bf16_t*)(ws + carve(off, (size_t)T * D * 2));
  p.hb = (bf16_t*)(ws + carve(off, (size_t)MAXTILES * 256 * DE * 2));
  p.y = (bf16_t*)(ws + carve(off, (size_t)2 * T * D * 2));
  p.ssq_q = (float*)(ws + carve(off, (size_t)T * 12 * 4));
  p.ssq_kv = (float*)(ws + carve(off, (size_t)T * 8 * 4));
  p.h = (float*)(ws + carve(off, (size_t)T * D * 4));
  p.rlog = (float*)(ws + carve(off, (size_t)RSLABS * T * RLD * 4));
  p.convtmp = (float*)(ws + carve(off, (size_t)T * CC * 4));
  p.ropetab = (float*)(ws + carve(off, (size_t)S * 32 * 2 * 4));
  p.list_gate = (float*)(ws + carve(off, (size_t)NE * LCAP * 4));
  p.list_tok = (int*)(ws + carve(off, (size_t)NE * LCAP * 4));
  p.WinT = (bf16_t*)(ws + carve(off, (size_t)NP1 * D * 2));
  p.WuqT = (bf16_t*)(ws + carve(off, (size_t)QW * QL * 2));
  p.WukvT = (bf16_t*)(ws + carve(off, (size_t)KVW * KVL * 2));
  p.WoT = (bf16_t*)(ws + carve(off, (size_t)D * D * 2));
  p.WrT = (bf16_t*)(ws + carve(off, (size_t)256 * D * 2));
  if (off > ws_size) { fprintf(stderr, "kernel_launch: workspace too small (%zu > %zu)\n", off, ws_size); return; }

  static int grid = 0;
  if (grid == 0) {
    int dev = 0, cus = 0, per_cu = 0;
    (void)hipGetDevice(&dev); (void)hipDeviceGetAttribute(&cus, hipDeviceAttributeMultiprocessorCount, dev);
    (void)hipFuncSetAttribute((const void*)mega_fwd, hipFuncAttributeMaxDynamicSharedMemorySize, LDS_BYTES);
    if (hipOccupancyMaxActiveBlocksPerMultiprocessor(&per_cu, (const void*)mega_fwd, NTHR, LDS_BYTES) != hipSuccess || per_cu < 1) { fprintf(stderr, "kernel_launch: occupancy query failed (%d)\n", per_cu); per_cu = 1; }
    (void)hipGetLastError();
    grid = cus * per_cu;
    fprintf(stderr, "kernel_launch: %d CUs x %d = grid %d\n", cus, per_cu, grid);
  }
  (void)hipMemsetAsync(p.bar, 0, XCD_BAR_WORDS * 4, stream);
  mega_fwd<<<grid, NTHR, LDS_BYTES, stream>>>(p);
}
```

```cpp
#include <hip/hip_runtime.h>
#include <cstdint>
#include <cstdio>
#include <type_traits>

typedef unsigned short bf16_t;

constexpr int T = 8192, D = 2048, S = 2048, NB = 4, H = 8;
constexpr int QL = 768, KVL = 512, RD = 64, CC = 1024, INC = 3392;
constexpr int QW = 1536  , KVW = 2048  ;
constexpr int NE = 64, DE = 512, NG = 8, EPG = 8, NRL = 72  ;
constexpr int CW = 31;
constexpr float EPS = 1e-6f;
constexpr int RSLABS = 8, RLD = 128;
constexpr int LCAP = T;
constexpr int MAXTILES = 128;

__device__ __forceinline__ float bf2f(bf16_t v) { return __uint_as_float(((unsigned)v) << 16); }
__device__ __forceinline__ bf16_t f2bf(float f) { unsigned u = __float_as_uint(f); u += 0x7fffu + ((u >> 16) & 1u); return (bf16_t)(u >> 16); }
__device__ __forceinline__ float sigmoidf_(float x) { return __builtin_amdgcn_rcpf(1.f + __builtin_amdgcn_exp2f(-1.4426950408889634f * x)); }
__device__ __forceinline__ float siluf_(float x) { return x * sigmoidf_(x); }

struct P {
  const float *x, *ln1_g, *w_in, *b_glu, *q_norm_g, *w_uq, *kv_norm_g, *w_ukv, *w_dw, *b_dw, *conv_ln_g, *conv_ln_b, *w_o, *ln2_g,
      *w_group, *b_group, *w_router, *b_router, *w_gate, *w_up, *w_down, *final_g;
  float* out;
  bf16_t *xn, *qlat, *kvlat, *krope, *cglu, *q, *kv, *mix, *hn, *hb, *y;
  float *ssq_q, *ssq_kv, *h, *rlog, *convtmp, *ropetab, *list_gate;
  int *cnt, *list_tok;
  bf16_t *WinT, *WuqT, *WukvT, *WoT, *WrT;
  unsigned* bar;
  unsigned* moe_done;
  float *ssq_h, *rstd_h;
  bf16_t* h16;
};

__device__ __forceinline__ float wave_sum(float v) {
#pragma unroll
  for (int o = 32; o > 0; o >>= 1) v += __shfl_xor(v, o);
  return v;
}
#define LAS __attribute__((address_space(3)))
typedef LAS unsigned char* ldsp;
typedef short bf16x8 __attribute__((ext_vector_type(8)));
typedef short s16x4 __attribute__((ext_vector_type(4)));
typedef float f32x4 __attribute__((ext_vector_type(4)));
typedef unsigned u32x2 __attribute__((ext_vector_type(2)));
typedef unsigned u32x4 __attribute__((ext_vector_type(4)));
constexpr int NTHR = 512, BM = 256, BK = 64, TILE_B = BM * BK * 2, STAGE_B = 2 * TILE_B, LDS_BYTES = 150528;
constexpr int NP1 = 3584;

__device__ __forceinline__ unsigned pk_bf16(float lo, float hi) { unsigned r; asm("v_cvt_pk_bf16_f32 %0, %1, %2" : "=v"(r) : "v"(lo), "v"(hi)); return r; }
__device__ __forceinline__ int lds_byte(int r, int c) { const int st = (r >> 4) * 2 + (c >> 5), ob = (r & 15) * 64 + (c & 31) * 2; return st * 1024 + (ob ^ (((ob >> 9) & 1) << 5)); }
__device__ __forceinline__ void stage_rc(int b, int& R, int& C) { const int st = b >> 10, sb = b & 1023, swz = sb ^ (((sb >> 9) & 1) << 5); R = (st >> 1) * 16 + swz / 64; C = (st & 1) * 32 + (swz % 64) / 2; }
__device__ __forceinline__ int trf(int k) { return ((k & 3) << 2) | ((k >> 2) & 3); }
__device__ __forceinline__ int tr_byte(int k, int n) { return (n >> 7) * 16384 + 256 * k + 16 * ((((n & 127) >> 3)) ^ trf(k)) + (n & 7) * 2; }

struct ColSrc { const float* src; int ld; int c; };
template <int WHICH> __device__ __forceinline__ ColSrc colmap(const P& p, int q) {
  ColSrc r; r.src = nullptr; r.ld = 0; r.c = -1;
  if (WHICH == 0) { r.src = p.w_in; r.ld = INC;
    if (q < 1280) r.c = q;
    else if (q < 3328) { const int pl = q - 1280, t = pl >> 8, j = pl & 255; r.c = 1344 + (j >> 7) * 1024 + t * 128 + (j & 127); }
    else { const int j = q - 3328; if (j < 32) r.c = 1280 + j; else if (j >= 128 && j < 160) r.c = 1280 + 32 + (j - 128); } }
  else if (WHICH == 1) { r.src = p.w_uq; r.ld = QW;
    if (q < 1024) { const int t = q >> 8, j = q & 255; r.c = (2 * t + (j >> 7)) * 192 + (j & 127); }
    else { const int t = (q - 1024) >> 8, j = q & 255, bj = j >> 7, wcc = (j >> 5) & 3, d = j & 31; r.c = (t * 4 + wcc) * 192 + 128 + bj * 32 + d; } }
  else if (WHICH == 2) { r.src = p.w_ukv; r.ld = KVW; r.c = q; }
  else if (WHICH == 3) { r.src = p.w_o; r.ld = D; r.c = q; }
  else { if (q < NG) { r.src = p.w_group; r.ld = NG; r.c = q; } else if (q < NRL) { r.src = p.w_router; r.ld = NE; r.c = q - NG; } }
  return r;
}
struct PrepDesc { bf16_t* dst; const float* gain; int K, kt, pt, which; };
__device__ __forceinline__ ColSrc colmap_rt(const P& p, int which, int q) {
  switch (which) { case 0: return colmap<0>(p, q); case 1: return colmap<1>(p, q); case 2: return colmap<2>(p, q); case 3: return colmap<3>(p, q); default: return colmap<4>(p, q); }
}
constexpr int PU0 = (D / 64) * (NP1 / 64), PU1 = (QL / 64) * (QW / 64), PU2 = (KVL / 64) * (KVW / 64), PU3 = (D / 64) * (D / 64), PU4 = (D / 64) * (256 / 64), PUT = PU0 + PU1 + PU2 + PU3 + PU4;
__device__ __forceinline__ PrepDesc prep_desc(const P& p, int u) {
  PrepDesc d; int v = u;
  if (v < PU0) { d.dst = p.WinT; d.gain = nullptr; d.K = D; d.kt = v % (D / 64); d.pt = v / (D / 64); d.which = 0; return d; } v -= PU0;
  if (v < PU1) { d.dst = p.WuqT; d.gain = p.q_norm_g; d.K = QL; d.kt = v % (QL / 64); d.pt = v / (QL / 64); d.which = 1; return d; } v -= PU1;
  if (v < PU2) { d.dst = p.WukvT; d.gain = p.kv_norm_g; d.K = KVL; d.kt = v % (KVL / 64); d.pt = v / (KVL / 64); d.which = 2; return d; } v -= PU2;
  if (v < PU3) { d.dst = p.WoT; d.gain = nullptr; d.K = D; d.kt = v % (D / 64); d.pt = v / (D / 64); d.which = 3; return d; } v -= PU3;
  d.dst = p.WrT; d.gain = nullptr; d.K = D; d.kt = v % (D / 64); d.pt = v / (D / 64); d.which = 4; return d;
}
__device__ __forceinline__ void phase_prep(const P& p, ldsp lds, int bid, int nb) {
  const int t = threadIdx.x, nl = t & 63, ksub = t >> 6, pl = t >> 3, kc = t & 7;
  for (int u0 = bid; u0 < PUT; u0 += 4 * nb) {
    float v[4][8];
#pragma unroll
    for (int b = 0; b < 4; ++b) { const int u = u0 + b * nb;
#pragma unroll
      for (int kk = 0; kk < 8; ++kk) v[b][kk] = 0.f;
      if (u < PUT) { const PrepDesc d = prep_desc(p, u); const ColSrc cs = colmap_rt(p, d.which, d.pt * 64 + nl);
        if (cs.c >= 0) {
#pragma unroll
          for (int kk = 0; kk < 8; ++kk) { const int k = d.kt * 64 + kk * 8 + ksub; float x = cs.src[(size_t)k * cs.ld + cs.c]; if (d.gain) x *= d.gain[k]; v[b][kk] = x; } } } }
#pragma unroll
    for (int b = 0; b < 4; ++b) { LAS float* tl = (LAS float*)(lds + b * 16640);
#pragma unroll
      for (int kk = 0; kk < 8; ++kk) tl[(kk * 8 + ksub) * 65 + nl] = v[b][kk]; }
    __syncthreads();
#pragma unroll
    for (int b = 0; b < 4; ++b) { const int u = u0 + b * nb;
      if (u < PUT) { const PrepDesc d = prep_desc(p, u); const LAS float* tl = (const LAS float*)(lds + b * 16640);
        u32x4 w;
        w.x = pk_bf16(tl[(kc * 8 + 0) * 65 + pl], tl[(kc * 8 + 1) * 65 + pl]); w.y = pk_bf16(tl[(kc * 8 + 2) * 65 + pl], tl[(kc * 8 + 3) * 65 + pl]);
        w.z = pk_bf16(tl[(kc * 8 + 4) * 65 + pl], tl[(kc * 8 + 5) * 65 + pl]); w.w = pk_bf16(tl[(kc * 8 + 6) * 65 + pl], tl[(kc * 8 + 7) * 65 + pl]);
        *(u32x4*)(d.dst + (size_t)(d.pt * 64 + pl) * d.K + d.kt * 64 + kc * 8) = w; } }
    __syncthreads();
  }
  for (int i = bid * NTHR + threadIdx.x; i < S * 32; i += nb * NTHR) { const int pos = i >> 5, f = i & 31;
    const float ang = (float)pos * powf(10000.f, -(float)f / 32.f); p.ropetab[2 * i] = cosf(ang); p.ropetab[2 * i + 1] = sinf(ang); }
  if (bid == 0) for (int i = threadIdx.x; i < NE * 32; i += NTHR) p.cnt[i] = 0;
  if (bid == (nb > 1 ? 1 : 0) && threadIdx.x < 256) p.moe_done[threadIdx.x] = 0u;
}
__device__ __forceinline__ void rmsnorm_rows_dev(const float* __restrict__ in, const float* __restrict__ g, bf16_t* __restrict__ out, int bid, int nb) {
  const int lane = threadIdx.x & 63, w = (bid * NTHR + threadIdx.x) >> 6, nw = nb * (NTHR / 64);
  for (int r = w; r < T; r += 2 * nw) {
    const int r1 = min(r + nw, T - 1); const bool has1 = r + nw < T;
    const float4* s0 = (const float4*)(in + (size_t)r * D); const float4* s1 = (const float4*)(in + (size_t)r1 * D);
    float4 v0[8], v1[8]; float q0 = 0.f, q1 = 0.f;
#pragma unroll
    for (int i = 0; i < 8; ++i) { v0[i] = s0[i * 64 + lane]; v1[i] = s1[i * 64 + lane]; }
#pragma unroll
    for (int i = 0; i < 8; ++i) { q0 += v0[i].x * v0[i].x + v0[i].y * v0[i].y + v0[i].z * v0[i].z + v0[i].w * v0[i].w; q1 += v1[i].x * v1[i].x + v1[i].y * v1[i].y + v1[i].z * v1[i].z + v1[i].w * v1[i].w; }
    q0 = wave_sum(q0); q1 = wave_sum(q1);
    const float rs0 = rsqrtf(q0 * (1.f / D) + EPS), rs1 = rsqrtf(q1 * (1.f / D) + EPS);
#pragma unroll
    for (int i = 0; i < 8; ++i) { const float4 gg = ((const float4*)g)[i * 64 + lane];
      u32x2 o; o.x = pk_bf16(v0[i].x * rs0 * gg.x, v0[i].y * rs0 * gg.y); o.y = pk_bf16(v0[i].z * rs0 * gg.z, v0[i].w * rs0 * gg.w);
      ((u32x2*)(out + (size_t)r * D))[i * 64 + lane] = o;
      if (has1) { u32x2 o1; o1.x = pk_bf16(v1[i].x * rs1 * gg.x, v1[i].y * rs1 * gg.y); o1.y = pk_bf16(v1[i].z * rs1 * gg.z, v1[i].w * rs1 * gg.w);
        ((u32x2*)(out + (size_t)r1 * D))[i * 64 + lane] = o1; } }
  }
}

namespace att {
typedef float f32x16 __attribute__((ext_vector_type(16)));
constexpr int KVBLK = 64, SHM_V = 64 * 128 * 2, SHM_KN = 64 * 128 * 2, SHM_KR = 64 * 64 * 2, SHM_BUF = SHM_V + SHM_KN + SHM_KR;
constexpr float SCALE = 0.07216878364870322f, THR = 8.f;
#define KSWZ(row, colB) ((row) * 256 + ((colB) ^ (((row) & 7) << 4)))
#define KRSWZ(row, colB) ((row) * 128 + ((colB) ^ ((((row) >> 1) & 7) << 4)))
#define SBAR() __builtin_amdgcn_sched_barrier(0)
__device__ __forceinline__ int crow(int r, int hi) { return (r & 3) + 8 * (r >> 2) + 4 * hi; }
__device__ __forceinline__ unsigned cvtpk(float lo, float hi) { unsigned r; asm volatile("v_cvt_pk_bf16_f32 %0, %1, %2" : "=v"(r) : "v"(lo), "v"(hi)); return r; }
__device__ __forceinline__ void partialSM(f32x16& p0, f32x16& p1, float& m_reg, float& mn, float& alpha) {
  constexpr float C = SCALE * 1.4426950408889634f;
  float pmax = p0[0];
#pragma unroll
  for (int r = 1; r < 16; ++r) pmax = fmaxf(pmax, p0[r]);
#pragma unroll
  for (int r = 0; r < 16; ++r) pmax = fmaxf(pmax, p1[r]);
  { auto rr = __builtin_amdgcn_permlane32_swap(__float_as_uint(pmax), __float_as_uint(pmax), false, false);
    pmax = fmaxf(__uint_as_float(rr[0]), __uint_as_float(rr[1])); }
  if (__builtin_expect(__all(pmax - m_reg <= THR / SCALE), 1)) { mn = m_reg; alpha = 1.f; }
  else { mn = fmaxf(m_reg, pmax); alpha = __builtin_amdgcn_exp2f((m_reg - mn) * C); m_reg = mn; }
  const float mnC = -mn * C;
#pragma unroll
  for (int r = 0; r < 16; ++r) p0[r] = fmaf(p0[r], C, mnC);
#pragma unroll
  for (int r = 0; r < 16; ++r) p1[r] = fmaf(p1[r], C, mnC);
#pragma unroll
  for (int r = 0; r < 16; ++r) p0[r] = __builtin_amdgcn_exp2f(p0[r]);
}
__device__ __forceinline__ void finishSM(f32x16& p0, f32x16& p1, float alpha, float& l_reg, bf16x8& pa0, bf16x8& pa1, bf16x8& pa2, bf16x8& pa3) {
#pragma unroll
  for (int r = 0; r < 16; ++r) p1[r] = __builtin_amdgcn_exp2f(p1[r]);
  float ps = 0;
#pragma unroll
  for (int r = 0; r < 16; ++r) ps += p0[r];
#pragma unroll
  for (int r = 0; r < 16; ++r) ps += p1[r];
  { auto rr = __builtin_amdgcn_permlane32_swap(__float_as_uint(ps), __float_as_uint(ps), false, false);
    ps = __uint_as_float(rr[0]) + __uint_as_float(rr[1]); }
  l_reg = l_reg * alpha + ps;
#define PK4(P_, BASE, OUT) do { unsigned a0 = cvtpk(P_[BASE + 0], P_[BASE + 1]), a1 = cvtpk(P_[BASE + 2], P_[BASE + 3]);   \
    unsigned b0 = cvtpk(P_[BASE + 4], P_[BASE + 5]), b1 = cvtpk(P_[BASE + 6], P_[BASE + 7]);                              \
    auto r0 = __builtin_amdgcn_permlane32_swap(a0, b0, false, false); auto r1 = __builtin_amdgcn_permlane32_swap(a1, b1, false, false); \
    u32x4 w = {r0[0], r1[0], r0[1], r1[1]}; OUT = *reinterpret_cast<bf16x8*>(&w); } while (0)
  PK4(p0, 0, pa0); PK4(p0, 8, pa1); PK4(p1, 0, pa2); PK4(p1, 8, pa3);
#undef PK4
}
__device__ __forceinline__ void qkt(f32x16& p0, f32x16& p1, ldsp Kn, ldsp Kr, const bf16x8 (&qr)[8], ldsp qrl, int r32, int hi) {
  asm volatile("" : "+v"(r32), "+v"(hi));
  p0 = f32x16{}; p1 = f32x16{};
#pragma unroll
  for (int d0 = 0; d0 < 8; ++d0) { const int cb = (d0 * 16 + hi * 8) * 2;
    const bf16x8 b0 = *(const LAS bf16x8*)(Kn + KSWZ(r32, cb)); const bf16x8 b1 = *(const LAS bf16x8*)(Kn + KSWZ(32 + r32, cb));
    p0 = __builtin_amdgcn_mfma_f32_32x32x16_bf16(b0, qr[d0], p0, 0, 0, 0); p1 = __builtin_amdgcn_mfma_f32_32x32x16_bf16(b1, qr[d0], p1, 0, 0, 0); }
#pragma unroll
  for (int d0 = 0; d0 < 4; ++d0) { const int cb = (d0 * 16 + hi * 8) * 2;
    const bf16x8 b0 = *(const LAS bf16x8*)(Kr + KRSWZ(r32, cb)); const bf16x8 b1 = *(const LAS bf16x8*)(Kr + KRSWZ(32 + r32, cb));
    const bf16x8 qf = *(const LAS bf16x8*)(qrl + KSWZ(r32, cb + 128));
    p0 = __builtin_amdgcn_mfma_f32_32x32x16_bf16(b0, qf, p0, 0, 0, 0); p1 = __builtin_amdgcn_mfma_f32_32x32x16_bf16(b1, qf, p1, 0, 0, 0); }
}
__device__ __forceinline__ int v_st(int k, int c) { const int kk = (k & ~0xC) | ((k & 4) << 1) | ((k & 8) >> 1); return ((kk >> 3) * 4 + (c >> 5)) * 512 + ((kk & 7) * 32 + (c & 31)) * 2; }
__device__ __forceinline__ int v_rd_base(int lane) { return ((lane & 3) << 3) | (((lane >> 2) & 3) << 6) | (((lane >> 4) & 1) << 5) | (((lane >> 5) & 1) << 8); }
__device__ __forceinline__ s16x4 trr(ldsp vb, int off) { return __builtin_amdgcn_ds_read_tr16_b64_v4i16((LAS s16x4*)(vb + off)); }
__device__ __forceinline__ void pv_one(f32x16& od, ldsp vb, int d0, bf16x8 pa0, bf16x8 pa1, bf16x8 pa2, bf16x8 pa3) {
#define VOFF(ks, half) (d0 * 512 + (ks) * 4096 + (half) * 2048)
  const s16x4 l0 = trr(vb, VOFF(0, 0)), h0 = trr(vb, VOFF(0, 1)), l1 = trr(vb, VOFF(1, 0)), h1 = trr(vb, VOFF(1, 1));
  const s16x4 l2 = trr(vb, VOFF(2, 0)), h2 = trr(vb, VOFF(2, 1)), l3 = trr(vb, VOFF(3, 0)), h3 = trr(vb, VOFF(3, 1));
#undef VOFF
#define PK(L, H_) (bf16x8){L[0], L[1], L[2], L[3], H_[0], H_[1], H_[2], H_[3]}
  od = __builtin_amdgcn_mfma_f32_32x32x16_bf16(pa0, PK(l0, h0), od, 0, 0, 0);
  od = __builtin_amdgcn_mfma_f32_32x32x16_bf16(pa1, PK(l1, h1), od, 0, 0, 0);
  od = __builtin_amdgcn_mfma_f32_32x32x16_bf16(pa2, PK(l2, h2), od, 0, 0, 0);
  od = __builtin_amdgcn_mfma_f32_32x32x16_bf16(pa3, PK(l3, h3), od, 0, 0, 0);
  SBAR();
#undef PK
}
__device__ __forceinline__ void pv_all(f32x16 (&o)[4], ldsp vb, bf16x8 pa0, bf16x8 pa1, bf16x8 pa2, bf16x8 pa3) {
  pv_one(o[0], vb, 0, pa0, pa1, pa2, pa3); pv_one(o[1], vb, 1, pa0, pa1, pa2, pa3); pv_one(o[2], vb, 2, pa0, pa1, pa2, pa3); pv_one(o[3], vb, 3, pa0, pa1, pa2, pa3);
}
__device__ __forceinline__ void attn_unit(const bf16_t* __restrict__ Qb, const bf16_t* __restrict__ Kh, const bf16_t* __restrict__ Krp, bf16_t* __restrict__ Ob, ldsp lds) {
  int tid = threadIdx.x; asm volatile("" : "+v"(tid));
  const int wid = tid >> 6, lane = tid & 63, r32 = lane & 31, hi = lane >> 5;
  LAS float* ws = (LAS float*)(lds + 2 * SHM_BUF) + wid * 64; LAS float* li_l = ws; LAS float* al_l = ws + 32;
  float m_reg = -1e30f, l_reg = 0; f32x16 o[4] = {}; bf16x8 qr[8];
  const bf16_t* Qw = Qb + (size_t)(wid * 32 + r32) * QW + hi * 8;
#pragma unroll
  for (int d0 = 0; d0 < 8; ++d0) qr[d0] = *(const bf16x8*)(Qw + d0 * 16);
  ldsp qrl = lds + 2 * SHM_BUF + 2048 + wid * 8192;
#pragma unroll
  for (int d0 = 0; d0 < 8; ++d0) *(LAS bf16x8*)(qrl + KSWZ(r32, (d0 * 16 + hi * 8) * 2)) = *(const bf16x8*)(Qw + 64 + d0 * 16);
  const int sr = tid >> 4, sc = (tid & 15) * 8, vst0 = v_st(sr, sc), vst1 = v_st(32 + sr, sc);
  const int rr_ = tid >> 3, rc_ = (tid & 7) * 8;
  const int vrb = v_rd_base(lane);
  bf16x8 vs0, vs1, ks0, ks1, krs;
#define VB(b) (lds + (b) * SHM_BUF)
#define KNB(b) (lds + (b) * SHM_BUF + SHM_V)
#define KRB(b) (lds + (b) * SHM_BUF + SHM_V + SHM_KN)
#define SLOAD(k0) do { const bf16_t* kp0 = Kh + (size_t)((k0) + sr) * KVW + sc; const bf16_t* kp1 = Kh + (size_t)((k0) + 32 + sr) * KVW + sc; \
    vs0 = *(const bf16x8*)(kp0 + 128); vs1 = *(const bf16x8*)(kp1 + 128); ks0 = *(const bf16x8*)kp0; ks1 = *(const bf16x8*)kp1; \
    krs = *(const bf16x8*)(Krp + (size_t)((k0) + rr_) * RD + rc_); } while (0)
#define SWRITE(b) do { *(LAS bf16x8*)(VB(b) + vst0) = vs0; *(LAS bf16x8*)(VB(b) + vst1) = vs1; \
    *(LAS bf16x8*)(KNB(b) + KSWZ(sr, sc * 2)) = ks0; *(LAS bf16x8*)(KNB(b) + KSWZ(32 + sr, sc * 2)) = ks1; \
    *(LAS bf16x8*)(KRB(b) + KRSWZ(rr_, rc_ * 2)) = krs; } while (0)
#define RESC(a) do { if (__any((a) < 1.f)) { if (hi == 0) al_l[r32] = (a); asm volatile("s_waitcnt lgkmcnt(0)" ::: "memory"); \
    _Pragma("unroll") for (int d = 0; d < 4; ++d) _Pragma("unroll") for (int r = 0; r < 16; ++r) o[d][r] *= al_l[crow(r, hi)]; } } while (0)
  f32x16 pA0, pA1, pB0, pB1; float mnA, mnB, alA, alB; bf16x8 pa0, pa1, pa2, pa3; constexpr int NT = S / KVBLK;
  SLOAD(0); SWRITE(0); __syncthreads();
  qkt(pA0, pA1, KNB(0), KRB(0), qr, qrl, r32, hi); partialSM(pA0, pA1, m_reg, mnA, alA);
  SLOAD(KVBLK); SWRITE(1); __syncthreads();
  for (int j = 1; j + 1 < NT; j += 2) {
    SBAR(); qkt(pB0, pB1, KNB(1), KRB(1), qr, qrl, r32, hi);
    finishSM(pA0, pA1, alA, l_reg, pa0, pa1, pa2, pa3); SBAR();
    SLOAD((j + 1) * KVBLK); SBAR();
    pv_all(o, VB(0) + vrb, pa0, pa1, pa2, pa3); partialSM(pB0, pB1, m_reg, mnB, alB);
    __syncthreads(); SWRITE(0);
    RESC(alB); __syncthreads();
    SBAR(); qkt(pA0, pA1, KNB(0), KRB(0), qr, qrl, r32, hi);
    finishSM(pB0, pB1, alB, l_reg, pa0, pa1, pa2, pa3); SBAR();
    SLOAD((j + 2) * KVBLK); SBAR();
    pv_all(o, VB(1) + vrb, pa0, pa1, pa2, pa3); partialSM(pA0, pA1, m_reg, mnA, alA);
    __syncthreads(); SWRITE(1);
    RESC(alA); __syncthreads();
  }
  SBAR(); qkt(pB0, pB1, KNB(1), KRB(1), qr, qrl, r32, hi);
  finishSM(pA0, pA1, alA, l_reg, pa0, pa1, pa2, pa3); SBAR();
  pv_all(o, VB(0) + vrb, pa0, pa1, pa2, pa3); partialSM(pB0, pB1, m_reg, mnB, alB);
  __syncthreads(); RESC(alB);
  finishSM(pB0, pB1, alB, l_reg, pa0, pa1, pa2, pa3); SBAR();
  pv_all(o, VB(1) + vrb, pa0, pa1, pa2, pa3);
  if (hi == 0) li_l[r32] = l_reg; asm volatile("s_waitcnt lgkmcnt(0)" ::: "memory");
  float rli[16];
#pragma unroll
  for (int r = 0; r < 16; ++r) rli[r] = __builtin_amdgcn_rcpf(li_l[crow(r, hi)]);
  bf16_t* Ow = Ob + (size_t)(wid * 32) * D;
#pragma unroll
  for (int r = 0; r < 16; ++r) { const int orow = crow(r, hi);
#pragma unroll
    for (int d0 = 0; d0 < 4; ++d0) Ow[(size_t)orow * D + d0 * 32 + r32] = f2bf(o[d0][r] * rli[r]); }
  __syncthreads();
#undef VB
#undef KNB
#undef KRB
#undef SLOAD
#undef SWRITE
#undef RESC
}
}
__device__ __forceinline__ void phase_attn(const P& p, ldsp lds, int bid, int nb) {
  for (int u = bid; u < NB * H * (S / 256); u += nb) {
    const int qb = u & 7, h = (u >> 3) & 7, b = u >> 6;
    const size_t row0 = (size_t)b * S + qb * 256;
    att::attn_unit(p.q + row0 * QW + h * 192, p.kv + (size_t)b * S * KVW + h * 256, p.krope + (size_t)b * S * RD, p.mix + row0 * D + h * 128, lds);
  }
}


typedef float f32x2 __attribute__((ext_vector_type(2)));
__device__ __forceinline__ float half32_sum(float v) {
  v += __builtin_bit_cast(float, __builtin_amdgcn_ds_swizzle(__builtin_bit_cast(int, v), 0x401F));
  v += __builtin_bit_cast(float, __builtin_amdgcn_update_dpp(0, __builtin_bit_cast(int, v), 0x128, 0xf, 0xf, false));
  v += __builtin_bit_cast(float, __builtin_amdgcn_update_dpp(0, __builtin_bit_cast(int, v), 0x124, 0xf, 0xf, false));
  v += __builtin_bit_cast(float, __builtin_amdgcn_update_dpp(0, __builtin_bit_cast(int, v), 0x122, 0xf, 0xf, false));
  v += __builtin_bit_cast(float, __builtin_amdgcn_update_dpp(0, __builtin_bit_cast(int, v), 0x121, 0xf, 0xf, false));
  return v;
}
__device__ __forceinline__ void phase_conv(const P& p, ldsp lds, int bid, int nb) {
  LAS float* red = (LAS float*)lds;
  for (int u = bid; u < T / 16; u += nb) {
    int tid = threadIdx.x; asm volatile("" : "+v"(tid));
    const int wid = tid >> 6, lane = tid & 63, ch = tid * 2;
    const int t0 = u * 16, b = t0 / S, s0 = t0 % S;
    f32x2 w[CW];
#pragma unroll
    for (int j = 0; j < CW; ++j) w[j] = *(const f32x2*)(p.w_dw + j * CC + ch);
    const f32x2 bd = *(const f32x2*)(p.b_dw + ch);
    f32x2 a[16];
#pragma unroll
    for (int i = 0; i < 16; ++i) a[i] = bd;
#pragma unroll
    for (int rr = 0; rr < 46; ++rr) { const int s = s0 - 15 + rr; f32x2 v;
      { const int scl = min(max(s, 0), S - 1); const unsigned raw = *(const unsigned*)(p.cglu + ((size_t)b * S + scl) * CC + ch);
        const bool ok = (s >= 0 && s < S); v.x = ok ? __uint_as_float(raw << 16) : 0.f; v.y = ok ? __uint_as_float(raw & 0xffff0000u) : 0.f; }
#pragma unroll
      for (int i = 0; i < 16; ++i) { const int j = rr - i; if (j >= 0 && j < CW) a[i] = __builtin_elementwise_fma(w[j], v, a[i]); } }
    float hs[16];
#pragma unroll
    for (int i = 0; i < 16; ++i) { const float sm = a[i].x + a[i].y; const f32x2 sq2 = a[i] * a[i]; const float sq = sq2.x + sq2.y;
      auto rr2 = __builtin_amdgcn_permlane32_swap(__float_as_uint(sm), __float_as_uint(sq), false, false);
      hs[i] = __uint_as_float(rr2[0]) + __uint_as_float(rr2[1]); }
#pragma unroll
    for (int i = 0; i < 16; ++i) hs[i] = half32_sum(hs[i]);
    if ((lane & 31) == 0) {
#pragma unroll
      for (int i = 0; i < 16; ++i) red[wid * 32 + (lane >> 5) * 16 + i] = hs[i]; }
    __syncthreads();
    if (tid < 32) { float t = 0.f;
#pragma unroll
      for (int w8 = 0; w8 < 8; ++w8) t += red[w8 * 32 + tid];
      red[256 + tid] = t; }
    __syncthreads();
    const f32x2 lg = *(const f32x2*)(p.conv_ln_g + ch), lb = *(const f32x2*)(p.conv_ln_b + ch);
#pragma unroll
    for (int i = 0; i < 16; ++i) { const float mu = red[256 + i] * (1.f / CC), var = red[256 + 16 + i] * (1.f / CC) - mu * mu; const float rs = rsqrtf(fmaxf(var, 0.f) + EPS);
      const f32x2 y = (a[i] - mu) * (rs * lg) + lb;
      *(unsigned*)(p.mix + (size_t)(t0 + i) * D + CC + ch) = pk_bf16(siluf_(y.x), siluf_(y.y)); }
    __syncthreads();
  }
}
__device__ __forceinline__ void phase_route2(const P& p, ldsp lds, int bid, int nb) {
  constexpr int RS = 4096 + 16;
  const int tid = threadIdx.x, wid = tid >> 6, lane = tid & 63, fr = lane & 15, fq = lane >> 4;
  for (int u = bid; u < T / 32; u += nb) {
    const int t0 = u * 32;
    __syncthreads();
#pragma unroll
    for (int i = 0; i < 16; ++i) { const int c = i * 512 + tid, r = c >> 8, pc = c & 255;
      *(LAS u32x4*)(lds + r * RS + pc * 16) = *(const u32x4*)(p.hn + (size_t)(t0 + r) * D + pc * 8); }
    __syncthreads();
    f32x4 acc[2][5];
#pragma unroll
    for (int m = 0; m < 2; ++m)
#pragma unroll
      for (int n = 0; n < 5; ++n) acc[m][n] = (f32x4){0.f, 0.f, 0.f, 0.f};
#pragma unroll 2
    for (int ks = 0; ks < 8; ++ks) { const int k0 = wid * 256 + ks * 32 + fq * 8;
      bf16x8 Bf[5];
#pragma unroll
      for (int n = 0; n < 5; ++n) Bf[n] = *(const bf16x8*)(p.WrT + (size_t)(n * 16 + fr) * D + k0);
      const bf16x8 A0 = *(const LAS bf16x8*)(lds + fr * RS + k0 * 2), A1 = *(const LAS bf16x8*)(lds + (16 + fr) * RS + k0 * 2);
#pragma unroll
      for (int n = 0; n < 5; ++n) { acc[0][n] = __builtin_amdgcn_mfma_f32_16x16x32_bf16(Bf[n], A0, acc[0][n], 0, 0, 0); acc[1][n] = __builtin_amdgcn_mfma_f32_16x16x32_bf16(Bf[n], A1, acc[1][n], 0, 0, 0); } }
    __syncthreads();
    LAS float* part = (LAS float*)lds;
#pragma unroll
    for (int m = 0; m < 2; ++m)
#pragma unroll
      for (int n = 0; n < 5; ++n) *(LAS f32x4*)(part + (wid * 32 + m * 16 + fr) * 80 + n * 16 + fq * 4) = acc[m][n];
    __syncthreads();
    LAS float* lg_ = part + 8 * 32 * 80;
    for (int o = tid; o < 32 * 80; o += NTHR) { float s = 0.f;
#pragma unroll
      for (int w = 0; w < 8; ++w) s += part[w * 2560 + o];
      lg_[o] = s; }
    __syncthreads();
    if (tid < 32) { const int t = t0 + tid; const LAS float* L_ = lg_ + tid * 80;
      float sq = 0.f;
#pragma unroll
      for (int i = 0; i < 32; i += 4) { const float4 v = *(const float4*)(p.ssq_h + (size_t)t * 32 + i); sq += (v.x + v.y) + (v.z + v.w); }
      const float rs = rsqrtf(sq * (1.f / D) + EPS); p.rstd_h[t] = rs;
      float lg[NG];
#pragma unroll
      for (int j = 0; j < NG; ++j) lg[j] = L_[j] * rs + p.b_group[j];
      int gs = 0; float gm = lg[0];
#pragma unroll
      for (int j = 1; j < NG; ++j) if (lg[j] > gm) { gm = lg[j]; gs = j; }
      float gsum = 0.f;
#pragma unroll
      for (int j = 0; j < NG; ++j) gsum += __expf(lg[j] - gm);
      const float pg = 1.f / gsum;
      float el[EPG];
#pragma unroll
      for (int j = 0; j < EPG; ++j) el[j] = L_[NG + gs * EPG + j] * rs + p.b_router[gs * EPG + j];
      int i1 = 0; float m1 = el[0];
#pragma unroll
      for (int j = 1; j < EPG; ++j) if (el[j] > m1) { m1 = el[j]; i1 = j; }
      int i2 = -1; float m2 = -1e30f;
#pragma unroll
      for (int j = 0; j < EPG; ++j) if (j != i1 && el[j] > m2) { m2 = el[j]; i2 = j; }
      const float e2 = __expf(m2 - m1); const float w1 = 1.f / (1.f + e2), w2 = e2 / (1.f + e2);
      const int ea = gs * EPG + i1, eb = gs * EPG + i2;
      const int pa = atomicAdd(&p.cnt[ea * 32], 1); p.list_tok[ea * LCAP + pa] = t * 2; p.list_gate[ea * LCAP + pa] = pg * w1;
      const int pb = atomicAdd(&p.cnt[eb * 32], 1); p.list_tok[eb * LCAP + pb] = t * 2 + 1; p.list_gate[eb * LCAP + pb] = pg * w2;
    }
  }
}
__device__ __forceinline__ int trw(int k, int c) { return (c >> 4) * 2080 + (k >> 4) * 512 + (((k & 15) * 32) ^ (((k >> 3) & 1) << 7)) + (c & 15) * 2; }
struct MoeUnit { int e, m0, count, sl, start, tile; };
template <int MODE, int PROBE = 0>
__device__ __forceinline__ void moe_stream(const P& p, ldsp lds, int bid, int nb) {
  constexpr int NS = MODE == 0 ? 8 : 16, NK = MODE == 0 ? D / BK : DE / BK, MROWS = 320, NFM = 5, MA_B = MROWS * 128, MSTAGE = MA_B + 16640 + 256;
  constexpr int TAB_OFF = 2 * MSTAGE + 1024, TAB_UNIT = MROWS * 8, CAP = (LDS_BYTES - 16 - TAB_OFF) / TAB_UNIT;
  LAS int* ts = (LAS int*)(lds + 2 * MSTAGE);
  LAS int* stt = ts + 80; LAS int* cntl = ts + 160;
  __syncthreads();
  if (threadIdx.x < NE) cntl[threadIdx.x] = p.cnt[threadIdx.x * 32];
  __syncthreads();
  if (threadIdx.x == 0) { int s = 0, r = 0; for (int e = 0; e < NE; ++e) { const int c = cntl[e]; ts[e] = s; stt[e] = r; s += (c + MROWS - 1) / MROWS; r += c; } ts[NE] = s; stt[NE] = r; }
  __syncthreads();
  const int ntile = ts[NE];
  int xcd, slot, nslots, nloc;
  if ((nb & 7) == 0) { xcd = bid & 7; slot = bid >> 3; nslots = nb >> 3; nloc = ((ntile - xcd + 7) >> 3) * NS; }
  else { xcd = 0; slot = bid; nslots = nb; nloc = ntile * NS; }
  int nu_all = nloc > slot ? (nloc - slot + nslots - 1) / nslots : 0, doff = 0;
  if (MODE == 1) {
    const int nlu = nloc / 2, ubase = nlu / nslots, urem = nlu % nslots, Tt = (4 * nlu + nloc + nslots - 1) / nslots;
    int rem = nloc; nu_all = 0;
    for (int k = 0; k < nslots; ++k) { const int sidx = (k + urem) % nslots, U = sidx < urem ? ubase + 1 : ubase; const int d = min(max(0, Tt - 4 * U), rem);
      if (sidx == slot) { doff = nloc - rem; nu_all = d; } rem -= d; }
  }
  int tid = threadIdx.x; asm volatile("" : "+v"(tid));
  const int wid = tid >> 6, lane = tid & 63, wm = wid >> 1, wn = wid & 1, fr = lane & 15, fq = lane >> 4;
  const bf16_t* abase = MODE == 0 ? p.hn : p.hb;
  constexpr int LDB = (PROBE & 1) ? 128 : (MODE == 0 ? DE : D);
  for (int c0 = 0; c0 < nu_all; c0 += CAP) {
    const int nu = min(CAP, nu_all - c0), total = nu * NK;
    auto unit_of = [&](int j) { MoeUnit u; const int l = MODE == 0 ? slot + (c0 + j) * nslots : doff + c0 + j; const int tile = ((nb & 7) == 0) ? (l / NS) * 8 + xcd : l / NS; u.sl = l % NS; u.tile = tile;
      int e = 0;
#pragma unroll 1
      for (int s = 32; s > 0; s >>= 1) if (e + s < NE && ts[e + s] <= tile) e += s;
      u.e = e; u.m0 = (tile - ts[e]) * MROWS; u.count = min(MROWS, cntl[e] - u.m0); u.start = stt[e]; return u; };
    __syncthreads();
    for (int j = 0; j < nu; ++j) { const MoeUnit u = unit_of(j);
      for (int r = threadIdx.x; r < MROWS; r += NTHR) { const int rr = min(r, u.count - 1);
        if (MODE == 0) { const int tk = p.list_tok[u.e * LCAP + u.m0 + rr] >> 1; ((LAS unsigned*)(lds + TAB_OFF + j * TAB_UNIT))[r] = (unsigned)(tk * D); ((LAS float*)(lds + TAB_OFF + j * TAB_UNIT + MROWS * 4))[r] = p.rstd_h[tk]; }
        else { ((LAS int*)(lds + TAB_OFF + j * TAB_UNIT))[r] = p.list_tok[u.e * LCAP + u.m0 + rr]; ((LAS float*)(lds + TAB_OFF + j * TAB_UNIT + MROWS * 4))[r] = p.list_gate[u.e * LCAP + u.m0 + rr]; } } }
    asm volatile("s_waitcnt vmcnt(0)" ::: "memory");
    __syncthreads();
    unsigned ao[NFM]; int a_j = -1, a_tile = -1;
    auto a_setup = [&](int j) { const MoeUnit u = unit_of(j); a_j = j;
      if (MODE == 1 && u.tile != a_tile) {
        if (wid == 0) { unsigned sp = 0; while (__hip_atomic_load(p.moe_done + u.tile, __ATOMIC_RELAXED, __HIP_MEMORY_SCOPE_AGENT) < 8u) { __builtin_amdgcn_s_sleep(8); if (++sp > (1u << 22)) break; }
          __builtin_amdgcn_fence(__ATOMIC_ACQUIRE, "agent"); asm volatile("s_waitcnt vmcnt(0)" ::: "memory"); }
        __syncthreads(); a_tile = u.tile; }
#pragma unroll
      for (int i = 0; i < NFM; ++i) { int R, C; stage_rc(wid * 1024 + i * 8192 + lane * 16, R, C);
        if (MODE == 0) ao[i] = ((const LAS unsigned*)(lds + TAB_OFF + j * TAB_UNIT))[R] + C; else ao[i] = (unsigned)((u.start + u.m0 + min(R, u.count - 1)) * DE + C); } };
    const float* bsrc = nullptr; int b_j = -1;
    auto b_setup = [&](int j) { const MoeUnit u = unit_of(j); b_j = j; const int tc = (lane & 31) * 4;
      if (PROBE & 1) { if (MODE == 0) bsrc = p.w_gate + (size_t)((u.tile * NS + u.sl) & 255) * D * 128 + (size_t)(8 * wid + (lane >> 5)) * 128 + tc; else bsrc = p.w_down + (size_t)((u.tile * NS + u.sl) & 1023) * DE * 128 + (size_t)(8 * wid + (lane >> 5)) * 128 + tc; }
      else if (MODE == 0) { const int jj = tc & 63; bsrc = (jj < 32 ? p.w_gate : p.w_up) + (size_t)u.e * D * DE + (size_t)(8 * wid + (lane >> 5)) * DE + u.sl * 64 + (tc >> 6) * 32 + (jj & 31); }
      else bsrc = p.w_down + (size_t)u.e * DE * D + (size_t)(8 * wid + (lane >> 5)) * D + u.sl * 128 + tc; };
    u32x4 ar0[NFM]; float4 br0[4], br1[4];
    f32x4 acc[NFM][4];
#pragma unroll
    for (int i = 0; i < NFM; ++i)
#pragma unroll
      for (int n = 0; n < 4; ++n) acc[i][n] = (f32x4){0.f, 0.f, 0.f, 0.f};
#define A_ISSUE(AR, pos_) do { const int pos = min((pos_), total - 1); const int j_ = pos / NK, kt_ = pos % NK; if (j_ != a_j) a_setup(j_); \
      _Pragma("unroll") for (int i = 0; i < NFM; ++i) AR[i] = *(const u32x4*)(abase + ao[i] + kt_ * BK); } while (0)
#define B_ISSUE(BR, pos_) do { const int pos = min((pos_), total - 1); const int j_ = pos / NK, kt_ = pos % NK; if (j_ != b_j) b_setup(j_); \
      _Pragma("unroll") for (int q = 0; q < 4; ++q) BR[q] = *(const float4*)(bsrc + (size_t)(kt_ * BK + 2 * q) * LDB); } while (0)
#define A_WRITE(AR, buf) do { int t_ = tid; asm volatile("" : "+v"(t_)); const int w_i = t_ >> 6, l_i = t_ & 63; \
      _Pragma("unroll") for (int i = 0; i < NFM; ++i) *(LAS u32x4*)(lds + (buf) * MSTAGE + w_i * 1024 + i * 8192 + l_i * 16) = AR[i]; } while (0)
#define B_WRITE(BR, buf) do { int t_ = tid; asm volatile("" : "+v"(t_)); const int w_i = t_ >> 6, l_i = t_ & 63; \
      _Pragma("unroll") for (int q = 0; q < 4; ++q) { u32x2 w_; w_.x = pk_bf16(BR[q].x, BR[q].y); w_.y = pk_bf16(BR[q].z, BR[q].w); \
      const int tc_ = (l_i & 31) * 4, ic_ = MODE == 1 ? ((tc_ & 64) | (((tc_ >> 2) & 3) << 4) | (((tc_ >> 4) & 3) << 2)) : tc_;     \
      *(LAS u32x2*)(lds + (buf) * MSTAGE + MA_B + trw(8 * w_i + 2 * q + (l_i >> 5), ic_)) = w_; } } while (0)
    int c_j = 0; MoeUnit cu = unit_of(0); int nvf = max(0, min(NFM, ((cu.count + 15) / 16 - wm + 3) >> 2));
    auto compute_nf = [&](int buf, auto nfc) {
      constexpr int NF = decltype(nfc)::value;
      ldsp sb = lds + buf * MSTAGE;
      int t_ = tid; asm volatile("" : "+v"(t_));
      const int wn_ = (t_ >> 6) & 1, wm_ = t_ >> 7, fr_ = t_ & 15, fq_ = (t_ >> 4) & 3, q_ = fr_ >> 2, pp_ = fr_ & 3;
      const int lp0 = (fq_ >> 1) * 512 + (fq_ & 1) * 256 + ((fq_ & 1) << 7) + q_ * 32 + pp_ * 8;
      const int trb0 = MA_B + wn_ * 4 * 2080 + lp0, trb1 = MA_B + wn_ * 4 * 2080 + (lp0 ^ 128);
      const int afb = lds_byte(wm_ * 16 + fr_, fq_ * 8);
#pragma unroll
      for (int ks = 0; ks < 2; ++ks) {
        bf16x8 Bf[4];
#pragma unroll
        for (int n = 0; n < 4; ++n) {
          const s16x4 lo = __builtin_amdgcn_ds_read_tr16_b64_v4i16((LAS s16x4*)(sb + trb0 + n * 2080 + ks * 1024));
          const s16x4 hi = __builtin_amdgcn_ds_read_tr16_b64_v4i16((LAS s16x4*)(sb + trb1 + n * 2080 + ks * 1024));
          Bf[n] = __builtin_shufflevector(lo, hi, 0, 1, 2, 3, 4, 5, 6, 7); }
        bf16x8 At[NF];
#pragma unroll
        for (int i = 0; i < NF; ++i) At[i] = *(const LAS bf16x8*)(sb + afb + i * 8192 + ks * 1024);
#pragma unroll
        for (int i = 0; i < NF; ++i)
#pragma unroll
          for (int n = 0; n < 4; ++n) acc[i][n] = __builtin_amdgcn_mfma_f32_16x16x32_bf16(Bf[n], At[i], acc[i][n], 0, 0, 0);
        __builtin_amdgcn_sched_barrier(0);
      }
    };
    auto compute = [&](int buf) {
      if (nvf <= 4) compute_nf(buf, std::integral_constant<int, 4>()); else compute_nf(buf, std::integral_constant<int, 5>()); };
    auto epilogue = [&]() {
      int fr2 = fr, fq2 = fq; asm volatile("" : "+v"(fr2), "+v"(fq2));
#pragma unroll
      for (int i = 0; i < NFM; ++i) { const int r = (wm + 4 * i) * 16 + fr2;
        if (r < cu.count) {
          if (MODE == 0) { bf16_t* dst = ((PROBE & 1) ? (bf16_t*)p.convtmp : p.hb) + (size_t)(cu.start + cu.m0 + r) * DE + cu.sl * 64 + wn * 32 + fq2 * 4;
            const float rs = ((const LAS float*)(lds + TAB_OFF + c_j * TAB_UNIT + MROWS * 4))[r];
#pragma unroll
            for (int n = 0; n < 2; ++n) { const f32x4 g = acc[i][n] * rs, uu = acc[i][n + 2] * rs;
              const unsigned lo = pk_bf16(siluf_(g[0]) * uu[0], siluf_(g[1]) * uu[1]), hi = pk_bf16(siluf_(g[2]) * uu[2], siluf_(g[3]) * uu[3]);
              __hip_atomic_store((unsigned long long*)(dst + n * 16), ((unsigned long long)hi << 32) | lo, __ATOMIC_RELAXED, __HIP_MEMORY_SCOPE_AGENT); } }
          else { const int ts2 = ((const LAS int*)(lds + TAB_OFF + c_j * TAB_UNIT))[r]; const float gate = ((const LAS float*)(lds + TAB_OFF + c_j * TAB_UNIT + MROWS * 4))[r];
            bf16_t* dst = p.y + (size_t)ts2 * D + cu.sl * 128 + wn * 64 + fq2 * 16;
            u32x4 w0, w1;
            w0.x = pk_bf16(acc[i][0][0] * gate, acc[i][0][1] * gate); w0.y = pk_bf16(acc[i][0][2] * gate, acc[i][0][3] * gate); w0.z = pk_bf16(acc[i][1][0] * gate, acc[i][1][1] * gate); w0.w = pk_bf16(acc[i][1][2] * gate, acc[i][1][3] * gate);
            w1.x = pk_bf16(acc[i][2][0] * gate, acc[i][2][1] * gate); w1.y = pk_bf16(acc[i][2][2] * gate, acc[i][2][3] * gate); w1.z = pk_bf16(acc[i][3][0] * gate, acc[i][3][1] * gate); w1.w = pk_bf16(acc[i][3][2] * gate, acc[i][3][3] * gate);
            if (!(PROBE & 16)) { *(u32x4*)dst = w0; *(u32x4*)(dst + 8) = w1; } else asm volatile("" :: "v"(w0.x), "v"(w1.x)); }
        }
#pragma unroll
        for (int n = 0; n < 4; ++n) acc[i][n] = (f32x4){0.f, 0.f, 0.f, 0.f};
      }
    };
    A_ISSUE(ar0, 0); B_ISSUE(br0, 0); A_WRITE(ar0, 0); B_WRITE(br0, 0);
    B_ISSUE(br1, 1); A_ISSUE(ar0, 1); B_ISSUE(br0, 2);
    __syncthreads();
#define STEP(s, BRW, ARW) do { \
      if (!(PROBE & 4)) A_WRITE(ar0, ((s) + 1) & 1); if (!(PROBE & 32)) B_WRITE(BRW, ((s) + 1) & 1); else asm volatile("" :: "v"(BRW[0].x), "v"(BRW[1].x), "v"(BRW[2].x), "v"(BRW[3].x)); \
      if (!(PROBE & 4)) A_ISSUE(ar0, (s) + 2); if (!(PROBE & 8)) B_ISSUE(BRW, (s) + 3); \
      if (!(PROBE & 2)) compute((s) & 1); \
      int sig_ = -1; \
      if (((s) + 1) % NK == 0) { epilogue(); __builtin_amdgcn_s_waitcnt(0x0F70); sig_ = cu.tile; if ((s) + 1 < total) { c_j = ((s) + 1) / NK; cu = unit_of(c_j); nvf = max(0, min(NFM, ((cu.count + 15) / 16 - wm + 3) >> 2)); } } \
      asm volatile("s_waitcnt lgkmcnt(0)" ::: "memory"); __builtin_amdgcn_s_barrier(); \
      if (MODE == 0 && !PROBE && sig_ >= 0 && threadIdx.x == 0) __hip_atomic_fetch_add(p.moe_done + sig_, 1u, __ATOMIC_RELAXED, __HIP_MEMORY_SCOPE_AGENT);     \
      } while (0)
    for (int s = 0; s < total; s += 2) { STEP(s, br1, ar1); STEP(s + 1, br0, ar0); }
    asm volatile("s_waitcnt vmcnt(0)" ::: "memory");
#undef STEP
#undef A_ISSUE
#undef B_ISSUE
#undef A_WRITE
#undef B_WRITE
  }
}
__device__ __forceinline__ void phase_final(const P& p, int bid, int nb) {
  const int lane = threadIdx.x & 63, w = (bid * NTHR + threadIdx.x) >> 6, nw = nb * (NTHR / 64);
  for (int r = w; r < T; r += nw) {
    const u32x2* src = (const u32x2*)(p.h16 + (size_t)r * D);
    const u32x2* y0 = (const u32x2*)(p.y + (size_t)(2 * r) * D); const u32x2* y1 = (const u32x2*)(p.y + (size_t)(2 * r + 1) * D);
    float4 v[8]; float ss = 0.f;
#pragma unroll
    for (int i = 0; i < 8; ++i) { const u32x2 hv = src[i * 64 + lane]; v[i].x = __uint_as_float(hv.x << 16); v[i].y = __uint_as_float(hv.x & 0xffff0000u); v[i].z = __uint_as_float(hv.y << 16); v[i].w = __uint_as_float(hv.y & 0xffff0000u);
      const u32x2 a = y0[i * 64 + lane], b = y1[i * 64 + lane];
      v[i].x += __uint_as_float(a.x << 16) + __uint_as_float(b.x << 16); v[i].y += __uint_as_float(a.x & 0xffff0000u) + __uint_as_float(b.x & 0xffff0000u);
      v[i].z += __uint_as_float(a.y << 16) + __uint_as_float(b.y << 16); v[i].w += __uint_as_float(a.y & 0xffff0000u) + __uint_as_float(b.y & 0xffff0000u);
      ss += v[i].x * v[i].x + v[i].y * v[i].y + v[i].z * v[i].z + v[i].w * v[i].w; }
    ss = wave_sum(ss);
    const float rs = rsqrtf(ss * (1.f / D) + EPS);
#pragma unroll
    for (int i = 0; i < 8; ++i) { const float4 gg = ((const float4*)p.final_g)[i * 64 + lane];
      float4 o; o.x = v[i].x * rs * gg.x; o.y = v[i].y * rs * gg.y; o.z = v[i].z * rs * gg.z; o.w = v[i].w * rs * gg.w;
      ((float4*)(p.out + (size_t)r * D))[i * 64 + lane] = o; }
  }
}

namespace pg8 {
#define PG8_LAS __attribute__((address_space(3)))
typedef unsigned short bf16_t;
typedef short bf16x8 __attribute__((ext_vector_type(8)));
typedef float f32x4 __attribute__((ext_vector_type(4)));
constexpr int BM = 256, BK = 64, HALF = 128, HTB = HALF * BK * 2, STAGE_BYTES = 8 * HTB;
__device__ __forceinline__ int lds_byte(int r, int c) { const int st = (r >> 4) * 2 + (c >> 5), rr = r & 15, cc = c & 31, ob = rr * 64 + cc * 2; return st * 1024 + (ob ^ (((ob >> 9) & 1) << 5)); }
__device__ __forceinline__ void stage_rc(int b, int& R, int& C) { const int st = b / 1024, sb = b % 1024, swz = sb ^ (((sb >> 9) & 1) << 5); R = (st >> 1) * 16 + swz / 64; C = (st & 1) * 32 + (swz % 64) / 2; }
__device__ __forceinline__ int perm32(int rho) { const int n = rho >> 4, i = rho & 15; return 8 * (i >> 2) + 4 * n + (i & 3); }
struct Unit { int pm, pn; };
struct Gemm { const bf16_t* A; const bf16_t* Bt; int M, N, K; };
struct ColMajorOrder { int nM, nwg, G, c;
  __device__ __forceinline__ bool next(int i, Unit& u) const { const int L = i * G + c; if (L >= nwg) return false; u.pm = L % nM; u.pn = L / nM; return true; }
  __device__ __forceinline__ void a_ready(const Unit&) const {}
  __device__ __forceinline__ void done(const Unit&) const {} };
template <class Epi, class Sched, bool ALIGN_EPI = false, bool SP2 = false>
__device__ __forceinline__ void gemm_phase(PG8_LAS unsigned char* lds, const Gemm g, const Sched& S, const Epi& E) {
    const int tid = threadIdx.x, wid = __builtin_amdgcn_readfirstlane(tid >> 6), lane = tid & 63, wr = wid >> 2, wc = wid & 3, fr = lane & 15, fq = lane >> 4;
    const int K = g.K, nt = K / BK;
    unsigned voffA[2], voffB[2];
#pragma unroll
    for (int i = 0; i < 2; ++i) { int R, C; stage_rc(tid * 16 + i * 8192, R, C); const int Rb = Epi::PERM ? ((R & ~31) + perm32(R & 31)) : R;
        voffA[i] = (unsigned)(R * K + C) * 2u; voffB[i] = (unsigned)(Rb * K + C) * 2u; }
    const size_t kstep = (size_t)(BK * 2);
    const size_t hstep = (size_t)HALF * K * 2;
    const size_t tstep = 2 * hstep;
    const unsigned ldsw = (unsigned)wid * 1024u;
    const int aoff = lds_byte(wr * 64 + fr, fq * 8), boff = lds_byte(wc * 32 + fr, fq * 8);
#define PG8_SA(b, h) (((b) * 2 + (h)) * HTB)
#define PG8_SB(b, h) ((4 + (b) * 2 + (h)) * HTB)
#define PG8_STAGE(bufoff, gbase, voff) do { _Pragma("unroll") for (int _i = 0; _i < 2; ++_i) \
        __builtin_amdgcn_global_load_lds((const unsigned*)((const char*)(gbase) + (voff)[_i]), (PG8_LAS unsigned*)(lds + (bufoff) + ldsw + _i * 8192), 16, 0, 0); } while (0)
#define PG8_LDA(dst, b, h) do { _Pragma("unroll") for (int m = 0; m < 4; ++m) _Pragma("unroll") for (int k = 0; k < 2; ++k) dst[m][k] = *(const PG8_LAS bf16x8*)(lds + PG8_SA(b, h) + aoff + m * 2048 + k * 1024); } while (0)
#define PG8_LDB(dst, b, h) do { _Pragma("unroll") for (int n = 0; n < 2; ++n) _Pragma("unroll") for (int k = 0; k < 2; ++k) dst[n][k] = *(const PG8_LAS bf16x8*)(lds + PG8_SB(b, h) + boff + n * 2048 + k * 1024); } while (0)
#define PG8_MMA(ai, bj, At, Bt) do { __builtin_amdgcn_s_setprio(1); _Pragma("unroll") for (int m = 0; m < 4; ++m) _Pragma("unroll") for (int n = 0; n < 2; ++n) _Pragma("unroll") for (int k = 0; k < 2; ++k) \
        acc[ai][bj][m][n] = __builtin_amdgcn_mfma_f32_16x16x32_bf16(Bt[n][k], At[m][k], acc[ai][bj][m][n], 0, 0, 0); __builtin_amdgcn_s_setprio(0); } while (0)
#define PG8_WAIT_V(n) asm volatile("s_waitcnt vmcnt(" #n ")" ::: "memory")
#define PG8_WAIT_L(n) asm volatile("s_waitcnt lgkmcnt(" #n ")" ::: "memory")
#define PG8_BAR __builtin_amdgcn_s_barrier()
#define PG8_SCHED __builtin_amdgcn_sched_barrier(0)
    Unit cur, nxt; int ui = 0;
    if (!S.next(0, cur)) return;
    f32x4 acc[2][2][4][2];
#pragma unroll
    for (int a = 0; a < 2; ++a)
#pragma unroll
        for (int b = 0; b < 2; ++b)
#pragma unroll
            for (int m = 0; m < 4; ++m)
#pragma unroll
                for (int n = 0; n < 2; ++n) acc[a][b][m][n] = (f32x4){0.f, 0.f, 0.f, 0.f};
    bf16x8 At[4][2], B0[2][2], B1[2][2];
    const char* cA = (const char*)g.A + (size_t)cur.pm * tstep; const char* cB = (const char*)g.Bt + (size_t)cur.pn * tstep;
    S.a_ready(cur);
    if constexpr (SP2) {
        PG8_STAGE(PG8_SB(0, 0), cB, voffB); PG8_STAGE(PG8_SB(0, 1), cB + hstep, voffB); PG8_STAGE(PG8_SA(0, 0), cA, voffA); PG8_STAGE(PG8_SA(0, 1), cA + hstep, voffA);
        if (wr == 1) PG8_BAR;
        PG8_WAIT_V(2); PG8_BAR;
        PG8_STAGE(PG8_SB(1, 0), cB + kstep, voffB); PG8_STAGE(PG8_SA(1, 0), cA + kstep, voffA); PG8_STAGE(PG8_SB(1, 1), cB + hstep + kstep, voffB);
        PG8_WAIT_V(6); PG8_BAR;
    } else {
        PG8_STAGE(PG8_SB(0, 0), cB, voffB); PG8_STAGE(PG8_SA(0, 0), cA, voffA); PG8_STAGE(PG8_SB(0, 1), cB + hstep, voffB); PG8_STAGE(PG8_SA(0, 1), cA + hstep, voffA);
        if (wr == 1) PG8_BAR;
        PG8_WAIT_V(4); PG8_BAR;
        PG8_STAGE(PG8_SB(1, 0), cB + kstep, voffB); PG8_STAGE(PG8_SA(1, 0), cA + kstep, voffA); PG8_STAGE(PG8_SB(1, 1), cB + hstep + kstep, voffB);
        PG8_WAIT_V(6); PG8_BAR;
    }
    for (;;) {
        const bool has_next = S.next(ui + 1, nxt);
        const char* nA = has_next ? (const char*)g.A + (size_t)nxt.pm * tstep : cA; const char* nB = has_next ? (const char*)g.Bt + (size_t)nxt.pn * tstep : cB;
        for (int t = 0; t < nt; t += 2) {
            const bool last = (t == nt - 2);
            const char* a1 = cA + (size_t)(t + 1) * kstep;
            const char* a2 = last ? nA : cA + (size_t)(t + 2) * kstep; const char* b2 = last ? nB : cB + (size_t)(t + 2) * kstep;
            const char* a3 = a2 + kstep; const char* b3 = b2 + kstep;
            if (last && has_next) S.a_ready(nxt);
            if constexpr (SP2) {
            PG8_LDB(B0, 0, 0); PG8_LDB(B1, 0, 1); PG8_SCHED; PG8_LDA(At, 0, 0); PG8_STAGE(PG8_SA(1, 1), a1 + hstep, voffA);
            PG8_WAIT_V(8); PG8_WAIT_L(0); PG8_BAR; PG8_MMA(0, 0, At, B0); PG8_MMA(0, 1, At, B1); PG8_BAR; PG8_SCHED;
            PG8_LDA(At, 0, 1); PG8_STAGE(PG8_SB(0, 0), b2, voffB); PG8_STAGE(PG8_SB(0, 1), b2 + hstep, voffB); PG8_STAGE(PG8_SA(0, 0), a2, voffA);
            PG8_WAIT_V(8); PG8_WAIT_L(0); PG8_BAR; PG8_MMA(1, 0, At, B0); PG8_MMA(1, 1, At, B1); PG8_BAR; PG8_SCHED;
            PG8_LDB(B0, 1, 0); PG8_LDB(B1, 1, 1); PG8_SCHED; PG8_LDA(At, 1, 0); PG8_STAGE(PG8_SA(0, 1), a2 + hstep, voffA);
            PG8_WAIT_V(8); PG8_WAIT_L(0); PG8_BAR; PG8_MMA(0, 0, At, B0); PG8_MMA(0, 1, At, B1); PG8_BAR; PG8_SCHED;
            PG8_LDA(At, 1, 1); PG8_STAGE(PG8_SB(1, 0), b3, voffB); PG8_STAGE(PG8_SB(1, 1), b3 + hstep, voffB); PG8_STAGE(PG8_SA(1, 0), a3, voffA);
            PG8_WAIT_V(8); PG8_WAIT_L(0); PG8_BAR; PG8_MMA(1, 0, At, B0); PG8_MMA(1, 1, At, B1); PG8_BAR; PG8_SCHED;
            } else {
            PG8_LDB(B0, 0, 0); PG8_SCHED; PG8_LDA(At, 0, 0); PG8_STAGE(PG8_SA(1, 1), a1 + hstep, voffA);
            PG8_WAIT_L(8); PG8_BAR; PG8_WAIT_L(0); PG8_MMA(0, 0, At, B0); PG8_BAR; PG8_SCHED;
            PG8_LDB(B1, 0, 1); PG8_STAGE(PG8_SB(0, 0), b2, voffB);
            PG8_BAR; PG8_WAIT_L(0); PG8_MMA(0, 1, At, B1); PG8_BAR;
            PG8_LDA(At, 0, 1); PG8_STAGE(PG8_SA(0, 0), a2, voffA);
            PG8_BAR; PG8_WAIT_L(0); PG8_MMA(1, 0, At, B0); PG8_BAR; PG8_SCHED;
            PG8_STAGE(PG8_SB(0, 1), b2 + hstep, voffB);
            PG8_WAIT_V(6); PG8_BAR; PG8_MMA(1, 1, At, B1); PG8_BAR;
            PG8_LDB(B0, 1, 0); PG8_SCHED; PG8_LDA(At, 1, 0); PG8_STAGE(PG8_SA(0, 1), a2 + hstep, voffA);
            PG8_WAIT_L(8); PG8_BAR; PG8_WAIT_L(0); PG8_MMA(0, 0, At, B0); PG8_BAR; PG8_SCHED;
            PG8_LDB(B1, 1, 1); PG8_STAGE(PG8_SB(1, 0), b3, voffB);
            PG8_BAR; PG8_WAIT_L(0); PG8_MMA(0, 1, At, B1); PG8_BAR;
            PG8_LDA(At, 1, 1); PG8_STAGE(PG8_SA(1, 0), a3, voffA);
            PG8_BAR; PG8_WAIT_L(0); PG8_MMA(1, 0, At, B0); PG8_BAR; PG8_SCHED;
            PG8_STAGE(PG8_SB(1, 1), b3 + hstep, voffB);
            PG8_WAIT_V(6); PG8_BAR; PG8_MMA(1, 1, At, B1); PG8_BAR;
            }
        }
        if constexpr (ALIGN_EPI) { if (wr == 0) PG8_BAR; }
        if constexpr (!Epi::AFTER_DRAIN) { E(acc, cur, wr, wc, fr, fq); S.done(cur); }
        if (!has_next) break;
#pragma unroll
        for (int a = 0; a < 2; ++a)
#pragma unroll
            for (int b = 0; b < 2; ++b)
#pragma unroll
                for (int m = 0; m < 4; ++m)
#pragma unroll
                    for (int n = 0; n < 2; ++n) acc[a][b][m][n] = (f32x4){0.f, 0.f, 0.f, 0.f};
        cur = nxt; cA = nA; cB = nB; ++ui;
        if constexpr (ALIGN_EPI) { if (wr == 1) PG8_BAR; }
    }
    PG8_WAIT_V(0);
    if constexpr (!ALIGN_EPI) { if (wr == 0) PG8_BAR; }
    PG8_BAR;
    if constexpr (Epi::AFTER_DRAIN) { E.fused(acc, cur, wr, wc, fr, fq, lds, wid, lane); S.done(cur); }
#undef PG8_SA
#undef PG8_SB
#undef PG8_STAGE
#undef PG8_LDA
#undef PG8_LDB
#undef PG8_MMA
#undef PG8_WAIT_V
#undef PG8_WAIT_L
#undef PG8_BAR
#undef PG8_SCHED
}
}

#define EPI_DRAIN() asm volatile("s_waitcnt vmcnt(0)" ::: "memory")
struct Epi1 {
  static constexpr bool PERM = false, AFTER_DRAIN = false; P p;
  __device__ __forceinline__ void operator()(const f32x4 (&acc)[2][2][4][2], const pg8::Unit& u, int wr, int wc, int fr, int fq) const {
    const int pn = u.pn;
    if (pn <= 4) {
      bf16_t* dst; int ld, c0; float* ssq; int sst;
      if (pn < 3) { dst = p.qlat; ld = QL; c0 = pn * 256; ssq = p.ssq_q + pn * 4 + wc; sst = 12; } else { dst = p.kvlat; ld = KVL; c0 = (pn - 3) * 256; ssq = p.ssq_kv + (pn - 3) * 4 + wc; sst = 8; }
#pragma unroll
      for (int ai = 0; ai < 2; ++ai)
#pragma unroll
        for (int m = 0; m < 4; ++m) { const int row = u.pm * 256 + ai * 128 + wr * 64 + m * 16 + fr; float s = 0.f;
#pragma unroll
          for (int bj = 0; bj < 2; ++bj)
#pragma unroll
            for (int n = 0; n < 2; ++n) { const f32x4 a = acc[ai][bj][m][n]; s += a[0] * a[0] + a[1] * a[1] + a[2] * a[2] + a[3] * a[3];
              u32x2 w; w.x = pk_bf16(a[0], a[1]); w.y = pk_bf16(a[2], a[3]); *(u32x2*)(dst + (size_t)row * ld + c0 + bj * 128 + wc * 32 + n * 16 + fq * 4) = w; }
          s += __shfl_xor(s, 16); s += __shfl_xor(s, 32);
          if (fq == 0) ssq[(size_t)row * sst] = s; }
    } else if (pn <= 12) {
#pragma unroll
      for (int n = 0; n < 2; ++n) { const int ch = (pn - 5) * 128 + wc * 32 + n * 16 + fq * 4; const float4 ba = *(const float4*)(p.b_glu + ch), bg = *(const float4*)(p.b_glu + 1024 + ch);
#pragma unroll
        for (int ai = 0; ai < 2; ++ai)
#pragma unroll
          for (int m = 0; m < 4; ++m) { const int row = u.pm * 256 + ai * 128 + wr * 64 + m * 16 + fr; const f32x4 a = acc[ai][0][m][n], g = acc[ai][1][m][n];
            u32x2 w; w.x = pk_bf16((a[0] + ba.x) * sigmoidf_(g[0] + bg.x), (a[1] + ba.y) * sigmoidf_(g[1] + bg.y));
            w.y = pk_bf16((a[2] + ba.z) * sigmoidf_(g[2] + bg.z), (a[3] + ba.w) * sigmoidf_(g[3] + bg.w));
            *(u32x2*)(p.cglu + (size_t)row * CC + ch) = w; } }
    } else if (wc == 0) {
#pragma unroll
      for (int ai = 0; ai < 2; ++ai)
#pragma unroll
        for (int m = 0; m < 4; ++m) { const int row = u.pm * 256 + ai * 128 + wr * 64 + m * 16 + fr; const int pos = row & (S - 1);
#pragma unroll
          for (int n = 0; n < 2; ++n) { const int j = n * 16 + fq * 4; const f32x4 x1 = acc[ai][0][m][n], x2 = acc[ai][1][m][n];
            const float4 cs0 = *(const float4*)(p.ropetab + (pos * 32 + j) * 2), cs1 = *(const float4*)(p.ropetab + (pos * 32 + j) * 2 + 4);
            u32x2 lo, hi;
            lo.x = pk_bf16(x1[0] * cs0.x - x2[0] * cs0.y, x1[1] * cs0.z - x2[1] * cs0.w); lo.y = pk_bf16(x1[2] * cs1.x - x2[2] * cs1.y, x1[3] * cs1.z - x2[3] * cs1.w);
            hi.x = pk_bf16(x2[0] * cs0.x + x1[0] * cs0.y, x2[1] * cs0.z + x1[1] * cs0.w); hi.y = pk_bf16(x2[2] * cs1.x + x1[2] * cs1.y, x2[3] * cs1.z + x1[3] * cs1.w);
            *(u32x2*)(p.krope + (size_t)row * RD + j) = lo; *(u32x2*)(p.krope + (size_t)row * RD + 32 + j) = hi; } }
    }
    EPI_DRAIN();
  }
};
struct Epi2q {
  static constexpr bool PERM = false, AFTER_DRAIN = false; P p;
  __device__ __forceinline__ void operator()(const f32x4 (&acc)[2][2][4][2], const pg8::Unit& u, int wr, int wc, int fr, int fq) const {
    const int pn = u.pn;
#pragma unroll
    for (int ai = 0; ai < 2; ++ai)
#pragma unroll
      for (int m = 0; m < 4; ++m) { const int row = u.pm * 256 + ai * 128 + wr * 64 + m * 16 + fr;
        float sq = 0.f;
#pragma unroll
        for (int i = 0; i < 12; i += 4) { const float4 v = *(const float4*)(p.ssq_q + (size_t)row * 12 + i); sq += v.x + v.y + v.z + v.w; }
        const float rs = rsqrtf(sq * (1.f / QL) + EPS);
        if (pn < 4) {
#pragma unroll
          for (int bj = 0; bj < 2; ++bj)
#pragma unroll
            for (int n = 0; n < 2; ++n) { const f32x4 a = acc[ai][bj][m][n]; u32x2 w; w.x = pk_bf16(a[0] * rs, a[1] * rs); w.y = pk_bf16(a[2] * rs, a[3] * rs);
              *(u32x2*)(p.q + (size_t)row * QW + (2 * pn + bj) * 192 + wc * 32 + n * 16 + fq * 4) = w; }
        } else { const int pos = row & (S - 1); bf16_t* dst = p.q + (size_t)row * QW + ((pn - 4) * 4 + wc) * 192 + 128;
#pragma unroll
          for (int n = 0; n < 2; ++n) { const int j = n * 16 + fq * 4; const f32x4 x1 = acc[ai][0][m][n] * rs, x2 = acc[ai][1][m][n] * rs;
            const float4 cs0 = *(const float4*)(p.ropetab + (pos * 32 + j) * 2), cs1 = *(const float4*)(p.ropetab + (pos * 32 + j) * 2 + 4);
            u32x2 lo, hi;
            lo.x = pk_bf16(x1[0] * cs0.x - x2[0] * cs0.y, x1[1] * cs0.z - x2[1] * cs0.w); lo.y = pk_bf16(x1[2] * cs1.x - x2[2] * cs1.y, x1[3] * cs1.z - x2[3] * cs1.w);
            hi.x = pk_bf16(x2[0] * cs0.x + x1[0] * cs0.y, x2[1] * cs0.z + x1[1] * cs0.w); hi.y = pk_bf16(x2[2] * cs1.x + x1[2] * cs1.y, x2[3] * cs1.z + x1[3] * cs1.w);
            *(u32x2*)(dst + j) = lo; *(u32x2*)(dst + 32 + j) = hi; } }
      }
    EPI_DRAIN();
  }
};
struct Epi2kv {
  static constexpr bool PERM = false, AFTER_DRAIN = false; P p;
  __device__ __forceinline__ void operator()(const f32x4 (&acc)[2][2][4][2], const pg8::Unit& u, int wr, int wc, int fr, int fq) const {
#pragma unroll
    for (int ai = 0; ai < 2; ++ai)
#pragma unroll
      for (int m = 0; m < 4; ++m) { const int row = u.pm * 256 + ai * 128 + wr * 64 + m * 16 + fr;
        const float4 v0 = *(const float4*)(p.ssq_kv + (size_t)row * 8), v1 = *(const float4*)(p.ssq_kv + (size_t)row * 8 + 4);
        const float rs = rsqrtf((v0.x + v0.y + v0.z + v0.w + v1.x + v1.y + v1.z + v1.w) * (1.f / KVL) + EPS);
#pragma unroll
        for (int bj = 0; bj < 2; ++bj)
#pragma unroll
          for (int n = 0; n < 2; ++n) { const f32x4 a = acc[ai][bj][m][n]; u32x2 w; w.x = pk_bf16(a[0] * rs, a[1] * rs); w.y = pk_bf16(a[2] * rs, a[3] * rs);
            *(u32x2*)(p.kv + (size_t)row * KVW + u.pn * 256 + bj * 128 + wc * 32 + n * 16 + fq * 4) = w; } }
    EPI_DRAIN();
  }
};
struct Epi3 {
  static constexpr bool PERM = true, AFTER_DRAIN = false; P p;
  __device__ __forceinline__ void operator()(const f32x4 (&acc)[2][2][4][2], const pg8::Unit& u, int wr, int wc, int fr, int fq) const {
    float4 g2[2][2];
#pragma unroll
    for (int bj = 0; bj < 2; ++bj)
#pragma unroll
      for (int n = 0; n < 2; ++n) g2[bj][n] = *(const float4*)(p.ln2_g + u.pn * 256 + bj * 128 + wc * 32 + fq * 8 + n * 4);
#pragma unroll
    for (int ai = 0; ai < 2; ++ai)
#pragma unroll
      for (int m = 0; m < 4; ++m) { const int row = u.pm * 256 + ai * 128 + wr * 64 + m * 16 + fr; float s = 0.f;
#pragma unroll
        for (int bj = 0; bj < 2; ++bj) { const size_t o_ = (size_t)row * D + u.pn * 256 + bj * 128 + wc * 32 + fq * 8;
          const float4 x0 = *(const float4*)(p.x + o_), x1 = *(const float4*)(p.x + o_ + 4); const f32x4 a0 = acc[ai][bj][m][0], a1 = acc[ai][bj][m][1];
          const float h0 = x0.x + a0[0], h1 = x0.y + a0[1], h2 = x0.z + a0[2], h3 = x0.w + a0[3], h4 = x1.x + a1[0], h5 = x1.y + a1[1], h6 = x1.z + a1[2], h7 = x1.w + a1[3];
          s += (h0 * h0 + h1 * h1) + (h2 * h2 + h3 * h3) + (h4 * h4 + h5 * h5) + (h6 * h6 + h7 * h7);
          *(u32x4*)(p.h16 + o_) = (u32x4){pk_bf16(h0, h1), pk_bf16(h2, h3), pk_bf16(h4, h5), pk_bf16(h6, h7)};
          const float4 ga = g2[bj][0], gb = g2[bj][1];
          *(u32x4*)(p.hn + o_) = (u32x4){pk_bf16(h0 * ga.x, h1 * ga.y), pk_bf16(h2 * ga.z, h3 * ga.w), pk_bf16(h4 * gb.x, h5 * gb.y), pk_bf16(h6 * gb.z, h7 * gb.w)}; }
        s += __shfl_xor(s, 16); s += __shfl_xor(s, 32);
        if (fq == 0) p.ssq_h[(size_t)row * 32 + u.pn * 4 + wc] = s; }
    EPI_DRAIN();
  }
};
__device__ __forceinline__ void phase_gemm1_pg8(const P& p, ldsp lds, int bid, int nb) {
  pg8::Gemm g; g.A = p.xn; g.Bt = p.WinT; g.M = T; g.N = NP1; g.K = D;
  pg8::ColMajorOrder S_; S_.nM = T / 256; S_.nwg = (T / 256) * (NP1 / 256); S_.G = nb; S_.c = bid;
  Epi1 E; E.p = p; pg8::gemm_phase<Epi1, pg8::ColMajorOrder, true, true>(lds, g, S_, E);
}
__device__ __forceinline__ void phase_gemm2_pg8(const P& p, ldsp lds, int bid, int nb) {
  { pg8::Gemm g; g.A = p.qlat; g.Bt = p.WuqT; g.M = T; g.N = QW; g.K = QL;
    pg8::ColMajorOrder S_; S_.nM = T / 256; S_.nwg = (T / 256) * (QW / 256); S_.G = nb; S_.c = bid;
    Epi2q E; E.p = p; pg8::gemm_phase<Epi2q, pg8::ColMajorOrder, true, true>(lds, g, S_, E); }
  { pg8::Gemm g; g.A = p.kvlat; g.Bt = p.WukvT; g.M = T; g.N = KVW; g.K = KVL;
    pg8::ColMajorOrder S_; S_.nM = T / 256; S_.nwg = (T / 256) * (KVW / 256); S_.G = nb; S_.c = (bid + 192) % nb;
    Epi2kv E; E.p = p; pg8::gemm_phase<Epi2kv, pg8::ColMajorOrder, true, true>(lds, g, S_, E); }
}
__device__ __forceinline__ void phase_gemm3_pg8(const P& p, ldsp lds, int bid, int nb) {
  pg8::Gemm g; g.A = p.mix; g.Bt = p.WoT; g.M = T; g.N = D; g.K = D;
  pg8::ColMajorOrder S_; S_.nM = T / 256; S_.nwg = (T / 256) * (D / 256); S_.G = nb; S_.c = bid;
  Epi3 E; E.p = p; pg8::gemm_phase<Epi3, pg8::ColMajorOrder, true, true>(lds, g, S_, E);
}
#define XB_TMO      128
#define XB_XCNT(j)  (256  + 64 * (j))
#define XB_XSUB(j)  (1280 + 64 * (j))
#define XB_XGEN(j)  (2304 + 64 * (j))
#define XB_TOP      3328
#define XB_TOPGEN   3392
#define XCD_BAR_WORDS 3456
#define XB_SPIN_CAP (1u << 20)
__device__ __forceinline__ unsigned xb_ld(unsigned* p)              { return __hip_atomic_load(p, __ATOMIC_RELAXED, __HIP_MEMORY_SCOPE_AGENT); }
__device__ __forceinline__ unsigned xb_add(unsigned* p, unsigned v) { return __hip_atomic_fetch_add(p, v, __ATOMIC_RELAXED, __HIP_MEMORY_SCOPE_AGENT); }
__device__ __forceinline__ unsigned xb_xcc_id() { return (unsigned)__builtin_amdgcn_s_getreg((3 << 11) | 20) & 0xFu; }
#define XB_SPIN(cond, bar) do { unsigned _sp = 0; while (cond) { __builtin_amdgcn_s_sleep(1); \
    if ((++_sp & 255u) == 0u) { if (xb_ld(&(bar)[XB_TMO])) break; if (_sp > XB_SPIN_CAP) { atomicAdd(&(bar)[XB_TMO], 1u); break; } } } } while (0)
struct XcdBarrier { unsigned* bar; unsigned x; volatile LAS unsigned* st; };
__device__ __forceinline__ XcdBarrier xcd_barrier_post(unsigned* bar, volatile LAS unsigned* st) {
  XcdBarrier b; b.bar = bar; b.x = xb_xcc_id(); b.st = st;
  if (threadIdx.x == 0) (void)xb_add(&bar[XB_XCNT(b.x)], 1u);
  return b;
}
__device__ __forceinline__ void xcd_barrier_complete(unsigned* bar, unsigned x, unsigned& nloc, unsigned& nx) {
  const unsigned G = gridDim.x * gridDim.y * gridDim.z;
  unsigned sum, cnt, mine, sp = 0u;
  for (;;) {
    sum = 0u; cnt = 0u; mine = 0u;
#pragma unroll
    for (unsigned j = 0; j < 16; ++j) { const unsigned c = xb_ld(&bar[XB_XCNT(j)]); sum += c; cnt += (c > 0u) ? 1u : 0u; mine = (j == x) ? c : mine; }
    if (sum == G) break;
    __builtin_amdgcn_s_sleep(1);
    if ((++sp & 255u) == 0u) { if (xb_ld(&bar[XB_TMO])) break; if (sp > XB_SPIN_CAP) { atomicAdd(&bar[XB_TMO], 1u); break; } }
  }
  nloc = mine > 0u ? mine : 1u; nx = cnt > 0u ? cnt : 1u;
}
__device__ __forceinline__ void xcd_barrier(const XcdBarrier& b) {
  asm volatile("s_waitcnt vmcnt(0)" ::: "memory");
  __syncthreads();
  if (threadIdx.x == 0) {
    unsigned* bar = b.bar;
    __builtin_amdgcn_s_waitcnt(0);
    unsigned nloc = b.st[0], nx = b.st[1];
    if (nloc == 0u) { xcd_barrier_complete(bar, b.x, nloc, nx); b.st[0] = nloc; b.st[1] = nx; }
    const unsigned old = xb_add(&bar[XB_XSUB(b.x)], 1u);
    const unsigned gen = old / nloc;
    if (old + 1u == (gen + 1u) * nloc) {
      __builtin_amdgcn_fence(__ATOMIC_RELEASE, "agent");
      asm volatile("s_waitcnt vmcnt(0)" ::: "memory");
      const unsigned og = xb_add(&bar[XB_TOP], 1u);
      const unsigned tg = og / nx;
      if (og + 1u == (tg + 1u) * nx) xb_add(&bar[XB_TOPGEN], 1u);
      else XB_SPIN(xb_ld(&bar[XB_TOPGEN]) == tg, bar);
      __builtin_amdgcn_fence(__ATOMIC_ACQUIRE, "agent");
      xb_add(&bar[XB_XGEN(b.x)], 1u);
      asm volatile("s_waitcnt vmcnt(0)" ::: "memory");
    } else {
      XB_SPIN(xb_ld(&bar[XB_XGEN(b.x)]) == gen, bar);
      __builtin_amdgcn_fence(__ATOMIC_ACQUIRE, "agent");
      asm volatile("s_waitcnt vmcnt(0)" ::: "memory");
    }
  }
  __syncthreads();
}

__global__ __launch_bounds__(NTHR, 2) void mega_fwd(P p) {
  extern __shared__ __attribute__((aligned(16))) unsigned char smem[];
  ldsp lds = (ldsp)smem;
  volatile LAS unsigned* st = (volatile LAS unsigned*)(lds + LDS_BYTES - 16);
  if (threadIdx.x == 0) { st[0] = 0u; st[1] = 0u; st[2] = 0u; st[3] = 0u; }
  __syncthreads();
  const XcdBarrier bar = xcd_barrier_post(p.bar, st);
  const int bid = blockIdx.x, nb = gridDim.x;
  phase_prep(p, lds, bid, nb); rmsnorm_rows_dev(p.x, p.ln1_g, p.xn, bid, nb);
  xcd_barrier(bar);
  phase_gemm1_pg8(p, lds, bid, nb);
  xcd_barrier(bar);
  phase_gemm2_pg8(p, lds, bid, nb); phase_conv(p, lds, bid, nb);
  xcd_barrier(bar);
  phase_attn(p, lds, bid, nb);
  xcd_barrier(bar);
  phase_gemm3_pg8(p, lds, bid, nb);
  xcd_barrier(bar);
  phase_route2(p, lds, bid, nb);
  xcd_barrier(bar);
  moe_stream<0>(p, lds, bid, nb);
  moe_stream<1>(p, lds, bid, nb);
  xcd_barrier(bar);
  phase_final(p, bid, nb);
}

static size_t carve(size_t& off, size_t bytes) { const size_t o = off; off += (bytes + 255) & ~(size_t)255; return o; }

extern "C" void kernel_launch(void* const* d_in, const int* in_sizes, int n_in, void* d_out, int out_size, void* d_ws, size_t ws_size, hipStream_t stream) {
  P p{};
  const float** pin = (const float**)&p.x;
  for (int i = 0; i < 22; ++i) pin[i] = (const float*)d_in[i];
  p.out = (float*)d_out;
  char* ws = (char*)d_ws; size_t off = 0;
  p.cnt = (int*)(ws + carve(off, NE * 32 * 4));
  p.bar = (unsigned*)(ws + carve(off, XCD_BAR_WORDS * 4));
  p.moe_done = (unsigned*)(ws + carve(off, 1024));
  p.ssq_h = (float*)(ws + carve(off, (size_t)T * 32 * 4));
  p.rstd_h = (float*)(ws + carve(off, (size_t)T * 4));
  p.h16 = (bf16_t*)(ws + carve(off, (size_t)T * D * 2));
  p.xn = (bf16_t*)(ws + carve(off, (size_t)T * D * 2));
  p.qlat = (bf16_t*)(ws + carve(off, (size_t)T * QL * 2));
  p.kvlat = (bf16_t*)(ws + carve(off, (size_t)T * KVL * 2));
  p.krope = (bf16_t*)(ws + carve(off, (size_t)T * RD * 2));
  p.cglu = (bf16_t*)(ws + carve(off, (size_t)T * CC * 2));
  p.q = (bf16_t*)(ws + carve(off, (size_t)T * QW * 2));
  p.kv = (bf16_t*)(ws + carve(off, (size_t)T * KVW * 2));
  p.mix = (bf16_t*)(ws + carve(off, (size_t)T * D * 2));
  p.hn = (bf16_t*)(ws + carve(off, (size_t)T * D * 2));
  p.hb = (bf16_t*)(ws + carve(off, (size_t)MAXTILES * 256 * DE * 2));
  p.y = (bf16_t*)(ws + carve(off, (size_t)2 * T * D * 2));
  p.ssq_q = (float*)(ws + carve(off, (size_t)T * 12 * 4));
  p.ssq_kv = (float*)(ws + carve(off, (size_t)T * 8 * 4));
  p.h = (float*)(ws + carve(off, (size_t)T * D * 4));
  p.rlog = (float*)(ws + carve(off, (size_t)RSLABS * T * RLD * 4));
  p.convtmp = (float*)(ws + carve(off, (size_t)T * CC * 4));
  p.ropetab = (float*)(ws + carve(off, (size_t)S * 32 * 2 * 4));
  p.list_gate = (float*)(ws + carve(off, (size_t)NE * LCAP * 4));
  p.list_tok = (int*)(ws + carve(off, (size_t)NE * LCAP * 4));
  p.WinT = (bf16_t*)(ws + carve(off, (size_t)NP1 * D * 2));
  p.WuqT = (bf16_t*)(ws + carve(off, (size_t)QW * QL * 2));
  p.WukvT = (bf16_t*)(ws + carve(off, (size_t)KVW * KVL * 2));
  p.WoT = (bf16_t*)(ws + carve(off, (size_t)D * D * 2));
  p.WrT = (bf16_t*)(ws + carve(off, (size_t)256 * D * 2));
  if (off > ws_size) { fprintf(stderr, "kernel_launch: workspace too small (%zu > %zu)\n", off, ws_size); return; }

  static int grid = 0;
  if (grid == 0) {
    int dev = 0, cus = 0, per_cu = 0;
    (void)hipGetDevice(&dev); (void)hipDeviceGetAttribute(&cus, hipDeviceAttributeMultiprocessorCount, dev);
    (void)hipFuncSetAttribute((const void*)mega_fwd, hipFuncAttributeMaxDynamicSharedMemorySize, LDS_BYTES);
    if (hipOccupancyMaxActiveBlocksPerMultiprocessor(&per_cu, (const void*)mega_fwd, NTHR, LDS_BYTES) != hipSuccess || per_cu < 1) { fprintf(stderr, "kernel_launch: occupancy query failed (%d)\n", per_cu); per_cu = 1; }
    (void)hipGetLastError();
    grid = cus * per_cu;
    fprintf(stderr, "kernel_launch: %d CUs x %d = grid %d\n", cus, per_cu, grid);
  }
  (void)hipMemsetAsync(p.bar, 0, XCD_BAR_WORDS * 4, stream);
  mega_fwd<<<grid, NTHR, LDS_BYTES, stream>>>(p);
}
```

```cpp
#include <hip/hip_runtime.h>
#include <cstdint>
#include <cstdio>
#include <type_traits>

typedef unsigned short bf16_t;

constexpr int T = 8192, D = 2048, S = 2048, NB = 4, H = 8;
constexpr int QL = 768, KVL = 512, RD = 64, CC = 1024, INC = 3392;
constexpr int QW = 1536  , KVW = 2048  ;
constexpr int NE = 64, DE = 512, NG = 8, EPG = 8, NRL = 72  ;
constexpr int CW = 31;
constexpr float EPS = 1e-6f;
constexpr int RSLABS = 8, RLD = 128;
constexpr int LCAP = T;
constexpr int MAXTILES = 128;

__device__ __forceinline__ float bf2f(bf16_t v) { return __uint_as_float(((unsigned)v) << 16); }
__device__ __forceinline__ bf16_t f2bf(float f) { unsigned u = __float_as_uint(f); u += 0x7fffu + ((u >> 16) & 1u); return (bf16_t)(u >> 16); }
__device__ __forceinline__ float sigmoidf_(float x) { return __builtin_amdgcn_rcpf(1.f + __builtin_amdgcn_exp2f(-1.4426950408889634f * x)); }
__device__ __forceinline__ float siluf_(float x) { return x * sigmoidf_(x); }

struct P {
  const float *x, *ln1_g, *w_in, *b_glu, *q_norm_g, *w_uq, *kv_norm_g, *w_ukv, *w_dw, *b_dw, *conv_ln_g, *conv_ln_b, *w_o, *ln2_g,
      *w_group, *b_group, *w_router, *b_router, *w_gate, *w_up, *w_down, *final_g;
  float* out;
  bf16_t *xn, *qlat, *kvlat, *krope, *cglu, *q, *kv, *mix, *hn, *hb, *y;
  float *ssq_q, *ssq_kv, *h, *rlog, *convtmp, *ropetab, *list_gate;
  int *cnt, *list_tok;
  bf16_t *WinT, *WuqT, *WukvT, *WoT, *WrT;
  unsigned* bar;
  unsigned* moe_done;
  float *ssq_h, *rstd_h;
  bf16_t* h16;
};

__device__ __forceinline__ float wave_sum(float v) {
#pragma unroll
  for (int o = 32; o > 0; o >>= 1) v += __shfl_xor(v, o);
  return v;
}
#define LAS __attribute__((address_space(3)))
typedef LAS unsigned char* ldsp;
typedef short bf16x8 __attribute__((ext_vector_type(8)));
typedef short s16x4 __attribute__((ext_vector_type(4)));
typedef float f32x4 __attribute__((ext_vector_type(4)));
typedef unsigned u32x2 __attribute__((ext_vector_type(2)));
typedef unsigned u32x4 __attribute__((ext_vector_type(4)));
constexpr int NTHR = 512, BM = 256, BK = 64, TILE_B = BM * BK * 2, STAGE_B = 2 * TILE_B, LDS_BYTES = 150528;
constexpr int NP1 = 3584;

__device__ __forceinline__ unsigned pk_bf16(float lo, float hi) { unsigned r; asm("v_cvt_pk_bf16_f32 %0, %1, %2" : "=v"(r) : "v"(lo), "v"(hi)); return r; }
__device__ __forceinline__ int lds_byte(int r, int c) { const int st = (r >> 4) * 2 + (c >> 5), ob = (r & 15) * 64 + (c & 31) * 2; return st * 1024 + (ob ^ (((ob >> 9) & 1) << 5)); }
__device__ __forceinline__ void stage_rc(int b, int& R, int& C) { const int st = b >> 10, sb = b & 1023, swz = sb ^ (((sb >> 9) & 1) << 5); R = (st >> 1) * 16 + swz / 64; C = (st & 1) * 32 + (swz % 64) / 2; }
__device__ __forceinline__ int trf(int k) { return ((k & 3) << 2) | ((k >> 2) & 3); }
__device__ __forceinline__ int tr_byte(int k, int n) { return (n >> 7) * 16384 + 256 * k + 16 * ((((n & 127) >> 3)) ^ trf(k)) + (n & 7) * 2; }

struct ColSrc { const float* src; int ld; int c; };
template <int WHICH> __device__ __forceinline__ ColSrc colmap(const P& p, int q) {
  ColSrc r; r.src = nullptr; r.ld = 0; r.c = -1;
  if (WHICH == 0) { r.src = p.w_in; r.ld = INC;
    if (q < 1280) r.c = q;
    else if (q < 3328) { const int pl = q - 1280, t = pl >> 8, j = pl & 255; r.c = 1344 + (j >> 7) * 1024 + t * 128 + (j & 127); }
    else { const int j = q - 3328; if (j < 32) r.c = 1280 + j; else if (j >= 128 && j < 160) r.c = 1280 + 32 + (j - 128); } }
  else if (WHICH == 1) { r.src = p.w_uq; r.ld = QW;
    if (q < 1024) { const int t = q >> 8, j = q & 255; r.c = (2 * t + (j >> 7)) * 192 + (j & 127); }
    else { const int t = (q - 1024) >> 8, j = q & 255, bj = j >> 7, wcc = (j >> 5) & 3, d = j & 31; r.c = (t * 4 + wcc) * 192 + 128 + bj * 32 + d; } }
  else if (WHICH == 2) { r.src = p.w_ukv; r.ld = KVW; r.c = q; }
  else if (WHICH == 3) { r.src = p.w_o; r.ld = D; r.c = q; }
  else { if (q < NG) { r.src = p.w_group; r.ld = NG; r.c = q; } else if (q < NRL) { r.src = p.w_router; r.ld = NE; r.c = q - NG; } }
  return r;
}
struct PrepDesc { bf16_t* dst; const float* gain; int K, kt, pt, which; };
__device__ __forceinline__ ColSrc colmap_rt(const P& p, int which, int q) {
  switch (which) { case 0: return colmap<0>(p, q); case 1: return colmap<1>(p, q); case 2: return colmap<2>(p, q); case 3: return colmap<3>(p, q); default: return colmap<4>(p, q); }
}
constexpr int PU0 = (D / 64) * (NP1 / 64), PU1 = (QL / 64) * (QW / 64), PU2 = (KVL / 64) * (KVW / 64), PU3 = (D / 64) * (D / 64), PU4 = (D / 64) * (256 / 64), PUT = PU0 + PU1 + PU2 + PU3 + PU4;
__device__ __forceinline__ PrepDesc prep_desc(const P& p, int u) {
  PrepDesc d; int v = u;
  if (v < PU0) { d.dst = p.WinT; d.gain = nullptr; d.K = D; d.kt = v % (D / 64); d.pt = v / (D / 64); d.which = 0; return d; } v -= PU0;
  if (v < PU1) { d.dst = p.WuqT; d.gain = p.q_norm_g; d.K = QL; d.kt = v % (QL / 64); d.pt = v / (QL / 64); d.which = 1; return d; } v -= PU1;
  if (v < PU2) { d.dst = p.WukvT; d.gain = p.kv_norm_g; d.K = KVL; d.kt = v % (KVL / 64); d.pt = v / (KVL / 64); d.which = 2; return d; } v -= PU2;
  if (v < PU3) { d.dst = p.WoT; d.gain = nullptr; d.K = D; d.kt = v % (D / 64); d.pt = v / (D / 64); d.which = 3; return d; } v -= PU3;
  d.dst = p.WrT; d.gain = nullptr; d.K = D; d.kt = v % (D / 64); d.pt = v / (D / 64); d.which = 4; return d;
}
__device__ __forceinline__ void phase_prep(const P& p, ldsp lds, int bid, int nb) {
  const int t = threadIdx.x, nl = t & 63, ksub = t >> 6, pl = t >> 3, kc = t & 7;
  for (int u0 = bid; u0 < PUT; u0 += 4 * nb) {
    float v[4][8];
#pragma unroll
    for (int b = 0; b < 4; ++b) { const int u = u0 + b * nb;
#pragma unroll
      for (int kk = 0; kk < 8; ++kk) v[b][kk] = 0.f;
      if (u < PUT) { const PrepDesc d = prep_desc(p, u); const ColSrc cs = colmap_rt(p, d.which, d.pt * 64 + nl);
        if (cs.c >= 0) {
#pragma unroll
          for (int kk = 0; kk < 8; ++kk) { const int k = d.kt * 64 + kk * 8 + ksub; float x = cs.src[(size_t)k * cs.ld + cs.c]; if (d.gain) x *= d.gain[k]; v[b][kk] = x; } } } }
#pragma unroll
    for (int b = 0; b < 4; ++b) { LAS float* tl = (LAS float*)(lds + b * 16640);
#pragma unroll
      for (int kk = 0; kk < 8; ++kk) tl[(kk * 8 + ksub) * 65 + nl] = v[b][kk]; }
    __syncthreads();
#pragma unroll
    for (int b = 0; b < 4; ++b) { const int u = u0 + b * nb;
      if (u < PUT) { const PrepDesc d = prep_desc(p, u); const LAS float* tl = (const LAS float*)(lds + b * 16640);
        u32x4 w;
        w.x = pk_bf16(tl[(kc * 8 + 0) * 65 + pl], tl[(kc * 8 + 1) * 65 + pl]); w.y = pk_bf16(tl[(kc * 8 + 2) * 65 + pl], tl[(kc * 8 + 3) * 65 + pl]);
        w.z = pk_bf16(tl[(kc * 8 + 4) * 65 + pl], tl[(kc * 8 + 5) * 65 + pl]); w.w = pk_bf16(tl[(kc * 8 + 6) * 65 + pl], tl[(kc * 8 + 7) * 65 + pl]);
        *(u32x4*)(d.dst + (size_t)(d.pt * 64 + pl) * d.K + d.kt * 64 + kc * 8) = w; } }
    __syncthreads();
  }
  for (int i = bid * NTHR + threadIdx.x; i < S * 32; i += nb * NTHR) { const int pos = i >> 5, f = i & 31;
    const float ang = (float)pos * powf(10000.f, -(float)f / 32.f); p.ropetab[2 * i] = cosf(ang); p.ropetab[2 * i + 1] = sinf(ang); }
  if (bid == 0) for (int i = threadIdx.x; i < NE * 32; i += NTHR) p.cnt[i] = 0;
  if (bid == (nb > 1 ? 1 : 0) && threadIdx.x < 256) p.moe_done[threadIdx.x] = 0u;
}
__device__ __forceinline__ void rmsnorm_rows_dev(const float* __restrict__ in, const float* __restrict__ g, bf16_t* __restrict__ out, int bid, int nb) {
  const int lane = threadIdx.x & 63, w = (bid * NTHR + threadIdx.x) >> 6, nw = nb * (NTHR / 64);
  for (int r = w; r < T; r += 2 * nw) {
    const int r1 = min(r + nw, T - 1); const bool has1 = r + nw < T;
    const float4* s0 = (const float4*)(in + (size_t)r * D); const float4* s1 = (const float4*)(in + (size_t)r1 * D);
    float4 v0[8], v1[8]; float q0 = 0.f, q1 = 0.f;
#pragma unroll
    for (int i = 0; i < 8; ++i) { v0[i] = s0[i * 64 + lane]; v1[i] = s1[i * 64 + lane]; }
#pragma unroll
    for (int i = 0; i < 8; ++i) { q0 += v0[i].x * v0[i].x + v0[i].y * v0[i].y + v0[i].z * v0[i].z + v0[i].w * v0[i].w; q1 += v1[i].x * v1[i].x + v1[i].y * v1[i].y + v1[i].z * v1[i].z + v1[i].w * v1[i].w; }
    q0 = wave_sum(q0); q1 = wave_sum(q1);
    const float rs0 = rsqrtf(q0 * (1.f / D) + EPS), rs1 = rsqrtf(q1 * (1.f / D) + EPS);
#pragma unroll
    for (int i = 0; i < 8; ++i) { const float4 gg = ((const float4*)g)[i * 64 + lane];
      u32x2 o; o.x = pk_bf16(v0[i].x * rs0 * gg.x, v0[i].y * rs0 * gg.y); o.y = pk_bf16(v0[i].z * rs0 * gg.z, v0[i].w * rs0 * gg.w);
      ((u32x2*)(out + (size_t)r * D))[i * 64 + lane] = o;
      if (has1) { u32x2 o1; o1.x = pk_bf16(v1[i].x * rs1 * gg.x, v1[i].y * rs1 * gg.y); o1.y = pk_bf16(v1[i].z * rs1 * gg.z, v1[i].w * rs1 * gg.w);
        ((u32x2*)(out + (size_t)r1 * D))[i * 64 + lane] = o1; } }
  }
}

namespace att {
typedef float f32x16 __attribute__((ext_vector_type(16)));
constexpr int KVBLK = 64, SHM_V = 64 * 128 * 2, SHM_KN = 64 * 128 * 2, SHM_KR = 64 * 64 * 2, SHM_BUF = SHM_V + SHM_KN + SHM_KR;
constexpr float SCALE = 0.07216878364870322f, THR = 8.f;
#define KSWZ(row, colB) ((row) * 256 + ((colB) ^ (((row) & 7) << 4)))
#define KRSWZ(row, colB) ((row) * 128 + ((colB) ^ ((((row) >> 1) & 7) << 4)))
#define SBAR() __builtin_amdgcn_sched_barrier(0)
__device__ __forceinline__ int crow(int r, int hi) { return (r & 3) + 8 * (r >> 2) + 4 * hi; }
__device__ __forceinline__ unsigned cvtpk(float lo, float hi) { unsigned r; asm volatile("v_cvt_pk_bf16_f32 %0, %1, %2" : "=v"(r) : "v"(lo), "v"(hi)); return r; }
__device__ __forceinline__ void partialSM(f32x16& p0, f32x16& p1, float& m_reg, float& mn, float& alpha) {
  constexpr float C = SCALE * 1.4426950408889634f;
  float pmax = p0[0];
#pragma unroll
  for (int r = 1; r < 16; ++r) pmax = fmaxf(pmax, p0[r]);
#pragma unroll
  for (int r = 0; r < 16; ++r) pmax = fmaxf(pmax, p1[r]);
  { auto rr = __builtin_amdgcn_permlane32_swap(__float_as_uint(pmax), __float_as_uint(pmax), false, false);
    pmax = fmaxf(__uint_as_float(rr[0]), __uint_as_float(rr[1])); }
  if (__builtin_expect(__all(pmax - m_reg <= THR / SCALE), 1)) { mn = m_reg; alpha = 1.f; }
  else { mn = fmaxf(m_reg, pmax); alpha = __builtin_amdgcn_exp2f((m_reg - mn) * C); m_reg = mn; }
  const float mnC = -mn * C;
#pragma unroll
  for (int r = 0; r < 16; ++r) p0[r] = fmaf(p0[r], C, mnC);
#pragma unroll
  for (int r = 0; r < 16; ++r) p1[r] = fmaf(p1[r], C, mnC);
#pragma unroll
  for (int r = 0; r < 16; ++r) p0[r] = __builtin_amdgcn_exp2f(p0[r]);
}
__device__ __forceinline__ void finishSM(f32x16& p0, f32x16& p1, float alpha, float& l_reg, bf16x8& pa0, bf16x8& pa1, bf16x8& pa2, bf16x8& pa3) {
#pragma unroll
  for (int r = 0; r < 16; ++r) p1[r] = __builtin_amdgcn_exp2f(p1[r]);
  float ps = 0;
#pragma unroll
  for (int r = 0; r < 16; ++r) ps += p0[r];
#pragma unroll
  for (int r = 0; r < 16; ++r) ps += p1[r];
  { auto rr = __builtin_amdgcn_permlane32_swap(__float_as_uint(ps), __float_as_uint(ps), false, false);
    ps = __uint_as_float(rr[0]) + __uint_as_float(rr[1]); }
  l_reg = l_reg * alpha + ps;
#define PK4(P_, BASE, OUT) do { unsigned a0 = cvtpk(P_[BASE + 0], P_[BASE + 1]), a1 = cvtpk(P_[BASE + 2], P_[BASE + 3]);   \
    unsigned b0 = cvtpk(P_[BASE + 4], P_[BASE + 5]), b1 = cvtpk(P_[BASE + 6], P_[BASE + 7]);                              \
    auto r0 = __builtin_amdgcn_permlane32_swap(a0, b0, false, false); auto r1 = __builtin_amdgcn_permlane32_swap(a1, b1, false, false); \
    u32x4 w = {r0[0], r1[0], r0[1], r1[1]}; OUT = *reinterpret_cast<bf16x8*>(&w); } while (0)
  PK4(p0, 0, pa0); PK4(p0, 8, pa1); PK4(p1, 0, pa2); PK4(p1, 8, pa3);
#undef PK4
}
__device__ __forceinline__ void qkt(f32x16& p0, f32x16& p1, ldsp Kn, ldsp Kr, const bf16x8 (&qr)[8], ldsp qrl, int r32, int hi) {
  asm volatile("" : "+v"(r32), "+v"(hi));
  p0 = f32x16{}; p1 = f32x16{};
#pragma unroll
  for (int d0 = 0; d0 < 8; ++d0) { const int cb = (d0 * 16 + hi * 8) * 2;
    const bf16x8 b0 = *(const LAS bf16x8*)(Kn + KSWZ(r32, cb)); const bf16x8 b1 = *(const LAS bf16x8*)(Kn + KSWZ(32 + r32, cb));
    p0 = __builtin_amdgcn_mfma_f32_32x32x16_bf16(b0, qr[d0], p0, 0, 0, 0); p1 = __builtin_amdgcn_mfma_f32_32x32x16_bf16(b1, qr[d0], p1, 0, 0, 0); }
#pragma unroll
  for (int d0 = 0; d0 < 4; ++d0) { const int cb = (d0 * 16 + hi * 8) * 2;
    const bf16x8 b0 = *(const LAS bf16x8*)(Kr + KRSWZ(r32, cb)); const bf16x8 b1 = *(const LAS bf16x8*)(Kr + KRSWZ(32 + r32, cb));
    const bf16x8 qf = *(const LAS bf16x8*)(qrl + KSWZ(r32, cb + 128));
    p0 = __builtin_amdgcn_mfma_f32_32x32x16_bf16(b0, qf, p0, 0, 0, 0); p1 = __builtin_amdgcn_mfma_f32_32x32x16_bf16(b1, qf, p1, 0, 0, 0); }
}
__device__ __forceinline__ int v_st(int k, int c) { const int kk = (k & ~0xC) | ((k & 4) << 1) | ((k & 8) >> 1); return ((kk >> 3) * 4 + (c >> 5)) * 512 + ((kk & 7) * 32 + (c & 31)) * 2; }
__device__ __forceinline__ int v_rd_base(int lane) { return ((lane & 3) << 3) | (((lane >> 2) & 3) << 6) | (((lane >> 4) & 1) << 5) | (((lane >> 5) & 1) << 8); }
__device__ __forceinline__ s16x4 trr(ldsp vb, int off) { return __builtin_amdgcn_ds_read_tr16_b64_v4i16((LAS s16x4*)(vb + off)); }
__device__ __forceinline__ void pv_one(f32x16& od, ldsp vb, int d0, bf16x8 pa0, bf16x8 pa1, bf16x8 pa2, bf16x8 pa3) {
#define VOFF(ks, half) (d0 * 512 + (ks) * 4096 + (half) * 2048)
  const s16x4 l0 = trr(vb, VOFF(0, 0)), h0 = trr(vb, VOFF(0, 1)), l1 = trr(vb, VOFF(1, 0)), h1 = trr(vb, VOFF(1, 1));
  const s16x4 l2 = trr(vb, VOFF(2, 0)), h2 = trr(vb, VOFF(2, 1)), l3 = trr(vb, VOFF(3, 0)), h3 = trr(vb, VOFF(3, 1));
#undef VOFF
#define PK(L, H_) (bf16x8){L[0], L[1], L[2], L[3], H_[0], H_[1], H_[2], H_[3]}
  od = __builtin_amdgcn_mfma_f32_32x32x16_bf16(pa0, PK(l0, h0), od, 0, 0, 0);
  od = __builtin_amdgcn_mfma_f32_32x32x16_bf16(pa1, PK(l1, h1), od, 0, 0, 0);
  od = __builtin_amdgcn_mfma_f32_32x32x16_bf16(pa2, PK(l2, h2), od, 0, 0, 0);
  od = __builtin_amdgcn_mfma_f32_32x32x16_bf16(pa3, PK(l3, h3), od, 0, 0, 0);
  SBAR();
#undef PK
}
__device__ __forceinline__ void pv_all(f32x16 (&o)[4], ldsp vb, bf16x8 pa0, bf16x8 pa1, bf16x8 pa2, bf16x8 pa3) {
  pv_one(o[0], vb, 0, pa0, pa1, pa2, pa3); pv_one(o[1], vb, 1, pa0, pa1, pa2, pa3); pv_one(o[2], vb, 2, pa0, pa1, pa2, pa3); pv_one(o[3], vb, 3, pa0, pa1, pa2, pa3);
}
__device__ __forceinline__ void attn_unit(const bf16_t* __restrict__ Qb, const bf16_t* __restrict__ Kh, const bf16_t* __restrict__ Krp, bf16_t* __restrict__ Ob, ldsp lds) {
  int tid = threadIdx.x; asm volatile("" : "+v"(tid));
  const int wid = tid >> 6, lane = tid & 63, r32 = lane & 31, hi = lane >> 5;
  LAS float* ws = (LAS float*)(lds + 2 * SHM_BUF) + wid * 64; LAS float* li_l = ws; LAS float* al_l = ws + 32;
  float m_reg = -1e30f, l_reg = 0; f32x16 o[4] = {}; bf16x8 qr[8];
  const bf16_t* Qw = Qb + (size_t)(wid * 32 + r32) * QW + hi * 8;
#pragma unroll
  for (int d0 = 0; d0 < 8; ++d0) qr[d0] = *(const bf16x8*)(Qw + d0 * 16);
  ldsp qrl = lds + 2 * SHM_BUF + 2048 + wid * 8192;
#pragma unroll
  for (int d0 = 0; d0 < 8; ++d0) *(LAS bf16x8*)(qrl + KSWZ(r32, (d0 * 16 + hi * 8) * 2)) = *(const bf16x8*)(Qw + 64 + d0 * 16);
  const int sr = tid >> 4, sc = (tid & 15) * 8, vst0 = v_st(sr, sc), vst1 = v_st(32 + sr, sc);
  const int rr_ = tid >> 3, rc_ = (tid & 7) * 8;
  const int vrb = v_rd_base(lane);
  bf16x8 vs0, vs1, ks0, ks1, krs;
#define VB(b) (lds + (b) * SHM_BUF)
#define KNB(b) (lds + (b) * SHM_BUF + SHM_V)
#define KRB(b) (lds + (b) * SHM_BUF + SHM_V + SHM_KN)
#define SLOAD(k0) do { const bf16_t* kp0 = Kh + (size_t)((k0) + sr) * KVW + sc; const bf16_t* kp1 = Kh + (size_t)((k0) + 32 + sr) * KVW + sc; \
    vs0 = *(const bf16x8*)(kp0 + 128); vs1 = *(const bf16x8*)(kp1 + 128); ks0 = *(const bf16x8*)kp0; ks1 = *(const bf16x8*)kp1; \
    krs = *(const bf16x8*)(Krp + (size_t)((k0) + rr_) * RD + rc_); } while (0)
#define SWRITE(b) do { *(LAS bf16x8*)(VB(b) + vst0) = vs0; *(LAS bf16x8*)(VB(b) + vst1) = vs1; \
    *(LAS bf16x8*)(KNB(b) + KSWZ(sr, sc * 2)) = ks0; *(LAS bf16x8*)(KNB(b) + KSWZ(32 + sr, sc * 2)) = ks1; \
    *(LAS bf16x8*)(KRB(b) + KRSWZ(rr_, rc_ * 2)) = krs; } while (0)
#define RESC(a) do { if (__any((a) < 1.f)) { if (hi == 0) al_l[r32] = (a); asm volatile("s_waitcnt lgkmcnt(0)" ::: "memory"); \
    _Pragma("unroll") for (int d = 0; d < 4; ++d) _Pragma("unroll") for (int r = 0; r < 16; ++r) o[d][r] *= al_l[crow(r, hi)]; } } while (0)
  f32x16 pA0, pA1, pB0, pB1; float mnA, mnB, alA, alB; bf16x8 pa0, pa1, pa2, pa3; constexpr int NT = S / KVBLK;
  SLOAD(0); SWRITE(0); __syncthreads();
  qkt(pA0, pA1, KNB(0), KRB(0), qr, qrl, r32, hi); partialSM(pA0, pA1, m_reg, mnA, alA);
  SLOAD(KVBLK); SWRITE(1); __syncthreads();
  for (int j = 1; j + 1 < NT; j += 2) {
    SBAR(); qkt(pB0, pB1, KNB(1), KRB(1), qr, qrl, r32, hi);
    finishSM(pA0, pA1, alA, l_reg, pa0, pa1, pa2, pa3); SBAR();
    SLOAD((j + 1) * KVBLK); SBAR();
    pv_all(o, VB(0) + vrb, pa0, pa1, pa2, pa3); partialSM(pB0, pB1, m_reg, mnB, alB);
    __syncthreads(); SWRITE(0);
    RESC(alB); __syncthreads();
    SBAR(); qkt(pA0, pA1, KNB(0), KRB(0), qr, qrl, r32, hi);
    finishSM(pB0, pB1, alB, l_reg, pa0, pa1, pa2, pa3); SBAR();
    SLOAD((j + 2) * KVBLK); SBAR();
    pv_all(o, VB(1) + vrb, pa0, pa1, pa2, pa3); partialSM(pA0, pA1, m_reg, mnA, alA);
    __syncthreads(); SWRITE(1);
    RESC(alA); __syncthreads();
  }
  SBAR(); qkt(pB0, pB1, KNB(1), KRB(1), qr, qrl, r32, hi);
  finishSM(pA0, pA1, alA, l_reg, pa0, pa1, pa2, pa3); SBAR();
  pv_all(o, VB(0) + vrb, pa0, pa1, pa2, pa3); partialSM(pB0, pB1, m_reg, mnB, alB);
  __syncthreads(); RESC(alB);
  finishSM(pB0, pB1, alB, l_reg, pa0, pa1, pa2, pa3); SBAR();
  pv_all(o, VB(1) + vrb, pa0, pa1, pa2, pa3);
  if (hi == 0) li_l[r32] = l_reg; asm volatile("s_waitcnt lgkmcnt(0)" ::: "memory");
  float rli[16];
#pragma unroll
  for (int r = 0; r < 16; ++r) rli[r] = __builtin_amdgcn_rcpf(li_l[crow(r, hi)]);
  bf16_t* Ow = Ob + (size_t)(wid * 32) * D;
#pragma unroll
  for (int r = 0; r < 16; ++r) { const int orow = crow(r, hi);
#pragma unroll
    for (int d0 = 0; d0 < 4; ++d0) Ow[(size_t)orow * D + d0 * 32 + r32] = f2bf(o[d0][r] * rli[r]); }
  __syncthreads();
#undef VB
#undef KNB
#undef KRB
#undef SLOAD
#undef SWRITE
#undef RESC
}
}
__device__ __forceinline__ void phase_attn(const P& p, ldsp lds, int bid, int nb) {
  for (int u = bid; u < NB * H * (S / 256); u += nb) {
    const int qb = u & 7, h = (u >> 3) & 7, b = u >> 6;
    const size_t row0 = (size_t)b * S + qb * 256;
    att::attn_unit(p.q + row0 * QW + h * 192, p.kv + (size_t)b * S * KVW + h * 256, p.krope + (size_t)b * S * RD, p.mix + row0 * D + h * 128, lds);
  }
}


typedef float f32x2 __attribute__((ext_vector_type(2)));
__device__ __forceinline__ float half32_sum(float v) {
  v += __builtin_bit_cast(float, __builtin_amdgcn_ds_swizzle(__builtin_bit_cast(int, v), 0x401F));
  v += __builtin_bit_cast(float, __builtin_amdgcn_update_dpp(0, __builtin_bit_cast(int, v), 0x128, 0xf, 0xf, false));
  v += __builtin_bit_cast(float, __builtin_amdgcn_update_dpp(0, __builtin_bit_cast(int, v), 0x124, 0xf, 0xf, false));
  v += __builtin_bit_cast(float, __builtin_amdgcn_update_dpp(0, __builtin_bit_cast(int, v), 0x122, 0xf, 0xf, false));
  v += __builtin_bit_cast(float, __builtin_amdgcn_update_dpp(0, __builtin_bit_cast(int, v), 0x121, 0xf, 0xf, false));
  return v;
}
__device__ __forceinline__ void phase_conv(const P& p, ldsp lds, int bid, int nb) {
  constexpr int TOK = 32;
  LAS float* red = (LAS float*)lds;
  for (int u = bid; u < T / TOK; u += nb) {
    int tid = threadIdx.x; asm volatile("" : "+v"(tid));
    const int wid = tid >> 6, lane = tid & 63, ch = tid * 2;
    const int t0 = u * TOK, b = t0 / S, s0 = t0 % S;
    f32x2 w[CW];
#pragma unroll
    for (int j = 0; j < CW; ++j) w[j] = *(const f32x2*)(p.w_dw + j * CC + ch);
    const f32x2 bd = *(const f32x2*)(p.b_dw + ch);
    f32x2 a[TOK];
#pragma unroll
    for (int i = 0; i < TOK; ++i) a[i] = bd;
    constexpr int RCH = 8;
#pragma unroll
    for (int r0 = 0; r0 < TOK + 30; r0 += RCH) {
      unsigned raw[RCH];
#pragma unroll
      for (int q = 0; q < RCH; ++q) { const int s = s0 - 15 + r0 + q; const int scl = min(max(s, 0), S - 1);
        raw[q] = (r0 + q < TOK + 30) ? *(const unsigned*)(p.cglu + ((size_t)b * S + scl) * CC + ch) : 0u; }
#pragma unroll
      for (int q = 0; q < RCH; ++q) { const int rr = r0 + q; if (rr < TOK + 30) { const int s = s0 - 15 + rr; const bool ok = (s >= 0 && s < S);
          f32x2 v; v.x = ok ? __uint_as_float(raw[q] << 16) : 0.f; v.y = ok ? __uint_as_float(raw[q] & 0xffff0000u) : 0.f;
#pragma unroll
          for (int i = 0; i < TOK; ++i) { const int j = rr - i; if (j >= 0 && j < CW) a[i] = __builtin_elementwise_fma(w[j], v, a[i]); } } }
      __builtin_amdgcn_sched_barrier(0);
    }
#pragma unroll
    for (int h = 0; h < TOK; h += 16) {
      float hs[16];
#pragma unroll
      for (int i = 0; i < 16; ++i) { const float sm = a[h + i].x + a[h + i].y; const f32x2 sq2 = a[h + i] * a[h + i]; const float sq = sq2.x + sq2.y;
        auto rr2 = __builtin_amdgcn_permlane32_swap(__float_as_uint(sm), __float_as_uint(sq), false, false);
        hs[i] = __uint_as_float(rr2[0]) + __uint_as_float(rr2[1]); }
#pragma unroll
      for (int i = 0; i < 16; ++i) hs[i] = half32_sum(hs[i]);
      if ((lane & 31) == 0) {
#pragma unroll
        for (int i = 0; i < 16; ++i) red[wid * 2 * TOK + (lane >> 5) * TOK + h + i] = hs[i]; }
      __builtin_amdgcn_sched_barrier(0);
    }
    __syncthreads();
    if (tid < 2 * TOK) { float t = 0.f;
#pragma unroll
      for (int w8 = 0; w8 < 8; ++w8) t += red[w8 * 2 * TOK + tid];
      red[16 * TOK + tid] = t; }
    __syncthreads();
    const f32x2 lg = *(const f32x2*)(p.conv_ln_g + ch), lb = *(const f32x2*)(p.conv_ln_b + ch);
#pragma unroll
    for (int i = 0; i < TOK; ++i) { const float mu = red[16 * TOK + i] * (1.f / CC), var = red[16 * TOK + TOK + i] * (1.f / CC) - mu * mu; const float rs = rsqrtf(fmaxf(var, 0.f) + EPS);
      const f32x2 y = (a[i] - mu) * (rs * lg) + lb;
      *(unsigned*)(p.mix + (size_t)(t0 + i) * D + CC + ch) = pk_bf16(siluf_(y.x), siluf_(y.y)); }
    __syncthreads();
  }
}
__device__ __forceinline__ void phase_route2(const P& p, ldsp lds, int bid, int nb) {
  constexpr int RS = 4096 + 16;
  const int tid = threadIdx.x, wid = tid >> 6, lane = tid & 63, fr = lane & 15, fq = lane >> 4;
  for (int u = bid; u < T / 32; u += nb) {
    const int t0 = u * 32;
    __syncthreads();
#pragma unroll
    for (int i = 0; i < 16; ++i) { const int c = i * 512 + tid, r = c >> 8, pc = c & 255;
      *(LAS u32x4*)(lds + r * RS + pc * 16) = *(const u32x4*)(p.hn + (size_t)(t0 + r) * D + pc * 8); }
    __syncthreads();
    f32x4 acc[2][5];
#pragma unroll
    for (int m = 0; m < 2; ++m)
#pragma unroll
      for (int n = 0; n < 5; ++n) acc[m][n] = (f32x4){0.f, 0.f, 0.f, 0.f};
#pragma unroll 2
    for (int ks = 0; ks < 8; ++ks) { const int k0 = wid * 256 + ks * 32 + fq * 8;
      bf16x8 Bf[5];
#pragma unroll
      for (int n = 0; n < 5; ++n) Bf[n] = *(const bf16x8*)(p.WrT + (size_t)(n * 16 + fr) * D + k0);
      const bf16x8 A0 = *(const LAS bf16x8*)(lds + fr * RS + k0 * 2), A1 = *(const LAS bf16x8*)(lds + (16 + fr) * RS + k0 * 2);
#pragma unroll
      for (int n = 0; n < 5; ++n) { acc[0][n] = __builtin_amdgcn_mfma_f32_16x16x32_bf16(Bf[n], A0, acc[0][n], 0, 0, 0); acc[1][n] = __builtin_amdgcn_mfma_f32_16x16x32_bf16(Bf[n], A1, acc[1][n], 0, 0, 0); } }
    __syncthreads();
    LAS float* part = (LAS float*)lds;
#pragma unroll
    for (int m = 0; m < 2; ++m)
#pragma unroll
      for (int n = 0; n < 5; ++n) *(LAS f32x4*)(part + (wid * 32 + m * 16 + fr) * 80 + n * 16 + fq * 4) = acc[m][n];
    __syncthreads();
    LAS float* lg_ = part + 8 * 32 * 80;
    for (int o = tid; o < 32 * 80; o += NTHR) { float s = 0.f;
#pragma unroll
      for (int w = 0; w < 8; ++w) s += part[w * 2560 + o];
      lg_[o] = s; }
    __syncthreads();
    if (tid < 32) { const int t = t0 + tid; const LAS float* L_ = lg_ + tid * 80;
      float sq = 0.f;
#pragma unroll
      for (int i = 0; i < 32; i += 4) { const float4 v = *(const float4*)(p.ssq_h + (size_t)t * 32 + i); sq += (v.x + v.y) + (v.z + v.w); }
      const float rs = rsqrtf(sq * (1.f / D) + EPS); p.rstd_h[t] = rs;
      float lg[NG];
#pragma unroll
      for (int j = 0; j < NG; ++j) lg[j] = L_[j] * rs + p.b_group[j];
      int gs = 0; float gm = lg[0];
#pragma unroll
      for (int j = 1; j < NG; ++j) if (lg[j] > gm) { gm = lg[j]; gs = j; }
      float gsum = 0.f;
#pragma unroll
      for (int j = 0; j < NG; ++j) gsum += __expf(lg[j] - gm);
      const float pg = 1.f / gsum;
      float el[EPG];
#pragma unroll
      for (int j = 0; j < EPG; ++j) el[j] = L_[NG + gs * EPG + j] * rs + p.b_router[gs * EPG + j];
      int i1 = 0; float m1 = el[0];
#pragma unroll
      for (int j = 1; j < EPG; ++j) if (el[j] > m1) { m1 = el[j]; i1 = j; }
      int i2 = -1; float m2 = -1e30f;
#pragma unroll
      for (int j = 0; j < EPG; ++j) if (j != i1 && el[j] > m2) { m2 = el[j]; i2 = j; }
      const float e2 = __expf(m2 - m1); const float w1 = 1.f / (1.f + e2), w2 = e2 / (1.f + e2);
      const int ea = gs * EPG + i1, eb = gs * EPG + i2;
      const int pa = atomicAdd(&p.cnt[ea * 32], 1); p.list_tok[ea * LCAP + pa] = t * 2; p.list_gate[ea * LCAP + pa] = pg * w1;
      const int pb = atomicAdd(&p.cnt[eb * 32], 1); p.list_tok[eb * LCAP + pb] = t * 2 + 1; p.list_gate[eb * LCAP + pb] = pg * w2;
    }
  }
}
__device__ __forceinline__ int trw(int k, int c) { return (c >> 4) * 2080 + (k >> 4) * 512 + (((k & 15) * 32) ^ (((k >> 3) & 1) << 7)) + (c & 15) * 2; }
struct MoeUnit { int e, m0, count, sl, start, tile; };
template <int MODE, int PROBE = 0>
__device__ __forceinline__ void moe_stream(const P& p, ldsp lds, int bid, int nb) {
  constexpr int NS = MODE == 0 ? 8 : 16, NK = MODE == 0 ? D / BK : DE / BK, MROWS = 320, NFM = 5, MA_B = MROWS * 128, MSTAGE = MA_B + 16640 + 256;
  constexpr int TAB_OFF = 2 * MSTAGE + 1024, TAB_UNIT = MROWS * 8, CAP = (LDS_BYTES - 16 - TAB_OFF) / TAB_UNIT;
  LAS int* ts = (LAS int*)(lds + 2 * MSTAGE);
  LAS int* stt = ts + 80; LAS int* cntl = ts + 160;
  __syncthreads();
  if (threadIdx.x < NE) cntl[threadIdx.x] = p.cnt[threadIdx.x * 32];
  __syncthreads();
  if (threadIdx.x == 0) { int s = 0, r = 0; for (int e = 0; e < NE; ++e) { const int c = cntl[e]; ts[e] = s; stt[e] = r; s += (c + MROWS - 1) / MROWS; r += c; } ts[NE] = s; stt[NE] = r; }
  __syncthreads();
  const int ntile = ts[NE];
  int xcd, slot, nslots, nloc;
  if ((nb & 7) == 0) { xcd = bid & 7; slot = bid >> 3; nslots = nb >> 3; nloc = ((ntile - xcd + 7) >> 3) * NS; }
  else { xcd = 0; slot = bid; nslots = nb; nloc = ntile * NS; }
  int nu_all = nloc > slot ? (nloc - slot + nslots - 1) / nslots : 0, doff = 0;
  if (MODE == 1) {
    const int nlu = nloc / 2, ubase = nlu / nslots, urem = nlu % nslots, Tt = (4 * nlu + nloc + nslots - 1) / nslots;
    int rem = nloc; nu_all = 0;
    for (int k = 0; k < nslots; ++k) { const int sidx = (k + urem) % nslots, U = sidx < urem ? ubase + 1 : ubase; const int d = min(max(0, Tt - 4 * U), rem);
      if (sidx == slot) { doff = nloc - rem; nu_all = d; } rem -= d; }
  }
  int tid = threadIdx.x; asm volatile("" : "+v"(tid));
  const int wid = tid >> 6, lane = tid & 63, wm = wid >> 1, wn = wid & 1, fr = lane & 15, fq = lane >> 4;
  const bf16_t* abase = MODE == 0 ? p.hn : p.hb;
  constexpr int LDB = (PROBE & 1) ? 128 : (MODE == 0 ? DE : D);
  for (int c0 = 0; c0 < nu_all; c0 += CAP) {
    const int nu = min(CAP, nu_all - c0), total = nu * NK;
    auto unit_of = [&](int j) { MoeUnit u; const int l = MODE == 0 ? slot + (c0 + j) * nslots : doff + c0 + j; const int tile = ((nb & 7) == 0) ? (l / NS) * 8 + xcd : l / NS; u.sl = l % NS; u.tile = tile;
      int e = 0;
#pragma unroll 1
      for (int s = 32; s > 0; s >>= 1) if (e + s < NE && ts[e + s] <= tile) e += s;
      u.e = e; u.m0 = (tile - ts[e]) * MROWS; u.count = min(MROWS, cntl[e] - u.m0); u.start = stt[e]; return u; };
    __syncthreads();
    for (int j = 0; j < nu; ++j) { const MoeUnit u = unit_of(j);
      for (int r = threadIdx.x; r < MROWS; r += NTHR) { const int rr = min(r, u.count - 1);
        if (MODE == 0) { const int tk = p.list_tok[u.e * LCAP + u.m0 + rr] >> 1; ((LAS unsigned*)(lds + TAB_OFF + j * TAB_UNIT))[r] = (unsigned)(tk * D); ((LAS float*)(lds + TAB_OFF + j * TAB_UNIT + MROWS * 4))[r] = p.rstd_h[tk]; }
        else { ((LAS int*)(lds + TAB_OFF + j * TAB_UNIT))[r] = p.list_tok[u.e * LCAP + u.m0 + rr]; ((LAS float*)(lds + TAB_OFF + j * TAB_UNIT + MROWS * 4))[r] = p.list_gate[u.e * LCAP + u.m0 + rr]; } } }
    asm volatile("s_waitcnt vmcnt(0)" ::: "memory");
    __syncthreads();
    unsigned ao[NFM]; int a_j = -1, a_tile = -1;
    auto a_setup = [&](int j) { const MoeUnit u = unit_of(j); a_j = j;
      if (MODE == 1 && u.tile != a_tile) {
        if (wid == 0) { unsigned sp = 0; while (__hip_atomic_load(p.moe_done + u.tile, __ATOMIC_RELAXED, __HIP_MEMORY_SCOPE_AGENT) < 8u) { __builtin_amdgcn_s_sleep(8); if (++sp > (1u << 22)) break; }
          __builtin_amdgcn_fence(__ATOMIC_ACQUIRE, "agent"); asm volatile("s_waitcnt vmcnt(0)" ::: "memory"); }
        __syncthreads(); a_tile = u.tile; }
#pragma unroll
      for (int i = 0; i < NFM; ++i) { int R, C; stage_rc(wid * 1024 + i * 8192 + lane * 16, R, C);
        if (MODE == 0) ao[i] = ((const LAS unsigned*)(lds + TAB_OFF + j * TAB_UNIT))[R] + C; else ao[i] = (unsigned)((u.start + u.m0 + min(R, u.count - 1)) * DE + C); } };
    const float* bsrc = nullptr; int b_j = -1;
    auto b_setup = [&](int j) { const MoeUnit u = unit_of(j); b_j = j; const int tc = (lane & 31) * 4;
      if (PROBE & 1) { if (MODE == 0) bsrc = p.w_gate + (size_t)((u.tile * NS + u.sl) & 255) * D * 128 + (size_t)(8 * wid + (lane >> 5)) * 128 + tc; else bsrc = p.w_down + (size_t)((u.tile * NS + u.sl) & 1023) * DE * 128 + (size_t)(8 * wid + (lane >> 5)) * 128 + tc; }
      else if (MODE == 0) { const int jj = tc & 63; bsrc = (jj < 32 ? p.w_gate : p.w_up) + (size_t)u.e * D * DE + (size_t)(8 * wid + (lane >> 5)) * DE + u.sl * 64 + (tc >> 6) * 32 + (jj & 31); }
      else bsrc = p.w_down + (size_t)u.e * DE * D + (size_t)(8 * wid + (lane >> 5)) * D + u.sl * 128 + tc; };
    u32x4 ar0[NFM]; float4 br0[4], br1[4];
    f32x4 acc[NFM][4];
#pragma unroll
    for (int i = 0; i < NFM; ++i)
#pragma unroll
      for (int n = 0; n < 4; ++n) acc[i][n] = (f32x4){0.f, 0.f, 0.f, 0.f};
#define A_ISSUE(AR, pos_) do { const int pos = min((pos_), total - 1); const int j_ = pos / NK, kt_ = pos % NK; if (j_ != a_j) a_setup(j_); \
      _Pragma("unroll") for (int i = 0; i < NFM; ++i) AR[i] = *(const u32x4*)(abase + ao[i] + kt_ * BK); } while (0)
#define B_ISSUE(BR, pos_) do { const int pos = min((pos_), total - 1); const int j_ = pos / NK, kt_ = pos % NK; if (j_ != b_j) b_setup(j_); \
      _Pragma("unroll") for (int q = 0; q < 4; ++q) BR[q] = *(const float4*)(bsrc + (size_t)(kt_ * BK + 2 * q) * LDB); } while (0)
#define A_WRITE(AR, buf) do { int t_ = tid; asm volatile("" : "+v"(t_)); const int w_i = t_ >> 6, l_i = t_ & 63; \
      _Pragma("unroll") for (int i = 0; i < NFM; ++i) *(LAS u32x4*)(lds + (buf) * MSTAGE + w_i * 1024 + i * 8192 + l_i * 16) = AR[i]; } while (0)
#define B_WRITE(BR, buf) do { int t_ = tid; asm volatile("" : "+v"(t_)); const int w_i = t_ >> 6, l_i = t_ & 63; \
      _Pragma("unroll") for (int q = 0; q < 4; ++q) { u32x2 w_; w_.x = pk_bf16(BR[q].x, BR[q].y); w_.y = pk_bf16(BR[q].z, BR[q].w); \
      const int tc_ = (l_i & 31) * 4, ic_ = MODE == 1 ? ((tc_ & 64) | (((tc_ >> 2) & 3) << 4) | (((tc_ >> 4) & 3) << 2)) : tc_;     \
      *(LAS u32x2*)(lds + (buf) * MSTAGE + MA_B + trw(8 * w_i + 2 * q + (l_i >> 5), ic_)) = w_; } } while (0)
    int c_j = 0; MoeUnit cu = unit_of(0); int nvf = max(0, min(NFM, ((cu.count + 15) / 16 - wm + 3) >> 2));
    auto compute_nf = [&](int buf, auto nfc) {
      constexpr int NF = decltype(nfc)::value;
      ldsp sb = lds + buf * MSTAGE;
      int t_ = tid; asm volatile("" : "+v"(t_));
      const int wn_ = (t_ >> 6) & 1, wm_ = t_ >> 7, fr_ = t_ & 15, fq_ = (t_ >> 4) & 3, q_ = fr_ >> 2, pp_ = fr_ & 3;
      const int lp0 = (fq_ >> 1) * 512 + (fq_ & 1) * 256 + ((fq_ & 1) << 7) + q_ * 32 + pp_ * 8;
      const int trb0 = MA_B + wn_ * 4 * 2080 + lp0, trb1 = MA_B + wn_ * 4 * 2080 + (lp0 ^ 128);
      const int afb = lds_byte(wm_ * 16 + fr_, fq_ * 8);
#pragma unroll
      for (int ks = 0; ks < 2; ++ks) {
        bf16x8 Bf[4];
#pragma unroll
        for (int n = 0; n < 4; ++n) {
          const s16x4 lo = __builtin_amdgcn_ds_read_tr16_b64_v4i16((LAS s16x4*)(sb + trb0 + n * 2080 + ks * 1024));
          const s16x4 hi = __builtin_amdgcn_ds_read_tr16_b64_v4i16((LAS s16x4*)(sb + trb1 + n * 2080 + ks * 1024));
          Bf[n] = __builtin_shufflevector(lo, hi, 0, 1, 2, 3, 4, 5, 6, 7); }
        bf16x8 At[NF];
#pragma unroll
        for (int i = 0; i < NF; ++i) At[i] = *(const LAS bf16x8*)(sb + afb + i * 8192 + ks * 1024);
#pragma unroll
        for (int i = 0; i < NF; ++i)
#pragma unroll
          for (int n = 0; n < 4; ++n) acc[i][n] = __builtin_amdgcn_mfma_f32_16x16x32_bf16(Bf[n], At[i], acc[i][n], 0, 0, 0);
        __builtin_amdgcn_sched_barrier(0);
      }
    };
    auto compute = [&](int buf) {
      if (nvf <= 4) compute_nf(buf, std::integral_constant<int, 4>()); else compute_nf(buf, std::integral_constant<int, 5>()); };
    auto epilogue = [&]() {
      int fr2 = fr, fq2 = fq; asm volatile("" : "+v"(fr2), "+v"(fq2));
#pragma unroll
      for (int i = 0; i < NFM; ++i) { const int r = (wm + 4 * i) * 16 + fr2;
        if (r < cu.count) {
          if (MODE == 0) { bf16_t* dst = ((PROBE & 1) ? (bf16_t*)p.convtmp : p.hb) + (size_t)(cu.start + cu.m0 + r) * DE + cu.sl * 64 + wn * 32 + fq2 * 4;
            const float rs = ((const LAS float*)(lds + TAB_OFF + c_j * TAB_UNIT + MROWS * 4))[r];
#pragma unroll
            for (int n = 0; n < 2; ++n) { const f32x4 g = acc[i][n] * rs, uu = acc[i][n + 2] * rs;
              const unsigned lo = pk_bf16(siluf_(g[0]) * uu[0], siluf_(g[1]) * uu[1]), hi = pk_bf16(siluf_(g[2]) * uu[2], siluf_(g[3]) * uu[3]);
              __hip_atomic_store((unsigned long long*)(dst + n * 16), ((unsigned long long)hi << 32) | lo, __ATOMIC_RELAXED, __HIP_MEMORY_SCOPE_AGENT); } }
          else { const int ts2 = ((const LAS int*)(lds + TAB_OFF + c_j * TAB_UNIT))[r]; const float gate = ((const LAS float*)(lds + TAB_OFF + c_j * TAB_UNIT + MROWS * 4))[r];
            bf16_t* dst = p.y + (size_t)ts2 * D + cu.sl * 128 + wn * 64 + fq2 * 16;
            u32x4 w0, w1;
            w0.x = pk_bf16(acc[i][0][0] * gate, acc[i][0][1] * gate); w0.y = pk_bf16(acc[i][0][2] * gate, acc[i][0][3] * gate); w0.z = pk_bf16(acc[i][1][0] * gate, acc[i][1][1] * gate); w0.w = pk_bf16(acc[i][1][2] * gate, acc[i][1][3] * gate);
            w1.x = pk_bf16(acc[i][2][0] * gate, acc[i][2][1] * gate); w1.y = pk_bf16(acc[i][2][2] * gate, acc[i][2][3] * gate); w1.z = pk_bf16(acc[i][3][0] * gate, acc[i][3][1] * gate); w1.w = pk_bf16(acc[i][3][2] * gate, acc[i][3][3] * gate);
            if (!(PROBE & 16)) { *(u32x4*)dst = w0; *(u32x4*)(dst + 8) = w1; } else asm volatile("" :: "v"(w0.x), "v"(w1.x)); }
        }
#pragma unroll
        for (int n = 0; n < 4; ++n) acc[i][n] = (f32x4){0.f, 0.f, 0.f, 0.f};
      }
    };
    A_ISSUE(ar0, 0); B_ISSUE(br0, 0); A_WRITE(ar0, 0); B_WRITE(br0, 0);
    B_ISSUE(br1, 1); A_ISSUE(ar0, 1); B_ISSUE(br0, 2);
    __syncthreads();
#define STEP(s, BRW, ARW) do { \
      if (!(PROBE & 4)) A_WRITE(ar0, ((s) + 1) & 1); if (!(PROBE & 32)) B_WRITE(BRW, ((s) + 1) & 1); else asm volatile("" :: "v"(BRW[0].x), "v"(BRW[1].x), "v"(BRW[2].x), "v"(BRW[3].x)); \
      if (!(PROBE & 4)) A_ISSUE(ar0, (s) + 2); if (!(PROBE & 8)) B_ISSUE(BRW, (s) + 3); \
      if (!(PROBE & 2)) compute((s) & 1); \
      int sig_ = -1; \
      if (((s) + 1) % NK == 0) { epilogue(); __builtin_amdgcn_s_waitcnt(0x0F70); sig_ = cu.tile; if ((s) + 1 < total) { c_j = ((s) + 1) / NK; cu = unit_of(c_j); nvf = max(0, min(NFM, ((cu.count + 15) / 16 - wm + 3) >> 2)); } } \
      asm volatile("s_waitcnt lgkmcnt(0)" ::: "memory"); __builtin_amdgcn_s_barrier(); \
      if (MODE == 0 && !PROBE && sig_ >= 0 && threadIdx.x == 0) __hip_atomic_fetch_add(p.moe_done + sig_, 1u, __ATOMIC_RELAXED, __HIP_MEMORY_SCOPE_AGENT);     \
      } while (0)
    for (int s = 0; s < total; s += 2) { STEP(s, br1, ar1); STEP(s + 1, br0, ar0); }
    asm volatile("s_waitcnt vmcnt(0)" ::: "memory");
#undef STEP
#undef A_ISSUE
#undef B_ISSUE
#undef A_WRITE
#undef B_WRITE
  }
}
__device__ __forceinline__ void phase_final(const P& p, int bid, int nb) {
  int tidf = threadIdx.x; asm volatile("" : "+v"(tidf));
  const int lane = tidf & 63, w = (bid * NTHR + tidf) >> 6, nw = nb * (NTHR / 64);
  for (int r = w; r < T; r += nw) {
    const u32x2* src = (const u32x2*)(p.h16 + (size_t)r * D);
    const u32x2* y0 = (const u32x2*)(p.y + (size_t)(2 * r) * D); const u32x2* y1 = (const u32x2*)(p.y + (size_t)(2 * r + 1) * D);
    float4 v[8]; float ss = 0.f;
#pragma unroll
    for (int i = 0; i < 8; ++i) { const u32x2 hv = src[i * 64 + lane]; v[i].x = __uint_as_float(hv.x << 16); v[i].y = __uint_as_float(hv.x & 0xffff0000u); v[i].z = __uint_as_float(hv.y << 16); v[i].w = __uint_as_float(hv.y & 0xffff0000u);
      const u32x2 a = y0[i * 64 + lane], b = y1[i * 64 + lane];
      v[i].x += __uint_as_float(a.x << 16) + __uint_as_float(b.x << 16); v[i].y += __uint_as_float(a.x & 0xffff0000u) + __uint_as_float(b.x & 0xffff0000u);
      v[i].z += __uint_as_float(a.y << 16) + __uint_as_float(b.y << 16); v[i].w += __uint_as_float(a.y & 0xffff0000u) + __uint_as_float(b.y & 0xffff0000u);
      ss += v[i].x * v[i].x + v[i].y * v[i].y + v[i].z * v[i].z + v[i].w * v[i].w; }
    ss = wave_sum(ss);
    const float rs = rsqrtf(ss * (1.f / D) + EPS);
#pragma unroll
    for (int i = 0; i < 8; ++i) { const float4 gg = ((const float4*)p.final_g)[i * 64 + lane];
      float4 o; o.x = v[i].x * rs * gg.x; o.y = v[i].y * rs * gg.y; o.z = v[i].z * rs * gg.z; o.w = v[i].w * rs * gg.w;
      ((float4*)(p.out + (size_t)r * D))[i * 64 + lane] = o; }
  }
}

namespace pg8 {
#define PG8_LAS __attribute__((address_space(3)))
typedef unsigned short bf16_t;
typedef short bf16x8 __attribute__((ext_vector_type(8)));
typedef float f32x4 __attribute__((ext_vector_type(4)));
constexpr int BM = 256, BK = 64, HALF = 128, HTB = HALF * BK * 2, STAGE_BYTES = 8 * HTB;
__device__ __forceinline__ int lds_byte(int r, int c) { const int st = (r >> 4) * 2 + (c >> 5), rr = r & 15, cc = c & 31, ob = rr * 64 + cc * 2; return st * 1024 + (ob ^ (((ob >> 9) & 1) << 5)); }
__device__ __forceinline__ void stage_rc(int b, int& R, int& C) { const int st = b / 1024, sb = b % 1024, swz = sb ^ (((sb >> 9) & 1) << 5); R = (st >> 1) * 16 + swz / 64; C = (st & 1) * 32 + (swz % 64) / 2; }
__device__ __forceinline__ int perm32(int rho) { const int n = rho >> 4, i = rho & 15; return 8 * (i >> 2) + 4 * n + (i & 3); }
struct Unit { int pm, pn; };
struct Gemm { const bf16_t* A; const bf16_t* Bt; int M, N, K; };
struct ColMajorOrder { int nM, nwg, G, c;
  __device__ __forceinline__ bool next(int i, Unit& u) const { const int L = i * G + c; if (L >= nwg) return false; u.pm = L % nM; u.pn = L / nM; return true; }
  __device__ __forceinline__ void a_ready(const Unit&) const {}
  __device__ __forceinline__ void done(const Unit&) const {} };
template <class Epi, class Sched, bool ALIGN_EPI = false, bool SP2 = false>
__device__ __forceinline__ void gemm_phase(PG8_LAS unsigned char* lds, const Gemm g, const Sched& S, const Epi& E) {
    const int tid = threadIdx.x, wid = __builtin_amdgcn_readfirstlane(tid >> 6), lane = tid & 63, wr = wid >> 2, wc = wid & 3, fr = lane & 15, fq = lane >> 4;
    const int K = g.K, nt = K / BK;
    unsigned voffA[2], voffB[2];
#pragma unroll
    for (int i = 0; i < 2; ++i) { int R, C; stage_rc(tid * 16 + i * 8192, R, C); const int Rb = Epi::PERM ? ((R & ~31) + perm32(R & 31)) : R;
        voffA[i] = (unsigned)(R * K + C) * 2u; voffB[i] = (unsigned)(Rb * K + C) * 2u; }
    const size_t kstep = (size_t)(BK * 2);
    const size_t hstep = (size_t)HALF * K * 2;
    const size_t tstep = 2 * hstep;
    const unsigned ldsw = (unsigned)wid * 1024u;
    const int aoff = lds_byte(wr * 64 + fr, fq * 8), boff = lds_byte(wc * 32 + fr, fq * 8);
#define PG8_SA(b, h) (((b) * 2 + (h)) * HTB)
#define PG8_SB(b, h) ((4 + (b) * 2 + (h)) * HTB)
#define PG8_STAGE(bufoff, gbase, voff) do { _Pragma("unroll") for (int _i = 0; _i < 2; ++_i) \
        __builtin_amdgcn_global_load_lds((const unsigned*)((const char*)(gbase) + (voff)[_i]), (PG8_LAS unsigned*)(lds + (bufoff) + ldsw + _i * 8192), 16, 0, 0); } while (0)
#define PG8_LDA(dst, b, h) do { _Pragma("unroll") for (int m = 0; m < 4; ++m) _Pragma("unroll") for (int k = 0; k < 2; ++k) dst[m][k] = *(const PG8_LAS bf16x8*)(lds + PG8_SA(b, h) + aoff + m * 2048 + k * 1024); } while (0)
#define PG8_LDB(dst, b, h) do { _Pragma("unroll") for (int n = 0; n < 2; ++n) _Pragma("unroll") for (int k = 0; k < 2; ++k) dst[n][k] = *(const PG8_LAS bf16x8*)(lds + PG8_SB(b, h) + boff + n * 2048 + k * 1024); } while (0)
#define PG8_MMA(ai, bj, At, Bt) do { __builtin_amdgcn_s_setprio(1); _Pragma("unroll") for (int m = 0; m < 4; ++m) _Pragma("unroll") for (int n = 0; n < 2; ++n) _Pragma("unroll") for (int k = 0; k < 2; ++k) \
        acc[ai][bj][m][n] = __builtin_amdgcn_mfma_f32_16x16x32_bf16(Bt[n][k], At[m][k], acc[ai][bj][m][n], 0, 0, 0); __builtin_amdgcn_s_setprio(0); } while (0)
#define PG8_WAIT_V(n) asm volatile("s_waitcnt vmcnt(" #n ")" ::: "memory")
#define PG8_WAIT_L(n) asm volatile("s_waitcnt lgkmcnt(" #n ")" ::: "memory")
#define PG8_BAR __builtin_amdgcn_s_barrier()
#define PG8_SCHED __builtin_amdgcn_sched_barrier(0)
    Unit cur, nxt; int ui = 0;
    if (!S.next(0, cur)) return;
    f32x4 acc[2][2][4][2];
#pragma unroll
    for (int a = 0; a < 2; ++a)
#pragma unroll
        for (int b = 0; b < 2; ++b)
#pragma unroll
            for (int m = 0; m < 4; ++m)
#pragma unroll
                for (int n = 0; n < 2; ++n) acc[a][b][m][n] = (f32x4){0.f, 0.f, 0.f, 0.f};
    bf16x8 At[4][2], B0[2][2], B1[2][2];
    const char* cA = (const char*)g.A + (size_t)cur.pm * tstep; const char* cB = (const char*)g.Bt + (size_t)cur.pn * tstep;
    S.a_ready(cur);
    if constexpr (SP2) {
        PG8_STAGE(PG8_SB(0, 0), cB, voffB); PG8_STAGE(PG8_SB(0, 1), cB + hstep, voffB); PG8_STAGE(PG8_SA(0, 0), cA, voffA); PG8_STAGE(PG8_SA(0, 1), cA + hstep, voffA);
        if (wr == 1) PG8_BAR;
        PG8_WAIT_V(2); PG8_BAR;
        PG8_STAGE(PG8_SB(1, 0), cB + kstep, voffB); PG8_STAGE(PG8_SA(1, 0), cA + kstep, voffA); PG8_STAGE(PG8_SB(1, 1), cB + hstep + kstep, voffB);
        PG8_WAIT_V(6); PG8_BAR;
    } else {
        PG8_STAGE(PG8_SB(0, 0), cB, voffB); PG8_STAGE(PG8_SA(0, 0), cA, voffA); PG8_STAGE(PG8_SB(0, 1), cB + hstep, voffB); PG8_STAGE(PG8_SA(0, 1), cA + hstep, voffA);
        if (wr == 1) PG8_BAR;
        PG8_WAIT_V(4); PG8_BAR;
        PG8_STAGE(PG8_SB(1, 0), cB + kstep, voffB); PG8_STAGE(PG8_SA(1, 0), cA + kstep, voffA); PG8_STAGE(PG8_SB(1, 1), cB + hstep + kstep, voffB);
        PG8_WAIT_V(6); PG8_BAR;
    }
    for (;;) {
        const bool has_next = S.next(ui + 1, nxt);
        const char* nA = has_next ? (const char*)g.A + (size_t)nxt.pm * tstep : cA; const char* nB = has_next ? (const char*)g.Bt + (size_t)nxt.pn * tstep : cB;
        for (int t = 0; t < nt; t += 2) {
            const bool last = (t == nt - 2);
            const char* a1 = cA + (size_t)(t + 1) * kstep;
            const char* a2 = last ? nA : cA + (size_t)(t + 2) * kstep; const char* b2 = last ? nB : cB + (size_t)(t + 2) * kstep;
            const char* a3 = a2 + kstep; const char* b3 = b2 + kstep;
            if (last && has_next) S.a_ready(nxt);
            if constexpr (SP2) {
            PG8_LDB(B0, 0, 0); PG8_LDB(B1, 0, 1); PG8_SCHED; PG8_LDA(At, 0, 0); PG8_STAGE(PG8_SA(1, 1), a1 + hstep, voffA);
            PG8_WAIT_V(8); PG8_WAIT_L(0); PG8_BAR; PG8_MMA(0, 0, At, B0); PG8_MMA(0, 1, At, B1); PG8_BAR; PG8_SCHED;
            PG8_LDA(At, 0, 1); PG8_STAGE(PG8_SB(0, 0), b2, voffB); PG8_STAGE(PG8_SB(0, 1), b2 + hstep, voffB); PG8_STAGE(PG8_SA(0, 0), a2, voffA);
            PG8_WAIT_V(8); PG8_WAIT_L(0); PG8_BAR; PG8_MMA(1, 0, At, B0); PG8_MMA(1, 1, At, B1); PG8_BAR; PG8_SCHED;
            PG8_LDB(B0, 1, 0); PG8_LDB(B1, 1, 1); PG8_SCHED; PG8_LDA(At, 1, 0); PG8_STAGE(PG8_SA(0, 1), a2 + hstep, voffA);
            PG8_WAIT_V(8); PG8_WAIT_L(0); PG8_BAR; PG8_MMA(0, 0, At, B0); PG8_MMA(0, 1, At, B1); PG8_BAR; PG8_SCHED;
            PG8_LDA(At, 1, 1); PG8_STAGE(PG8_SB(1, 0), b3, voffB); PG8_STAGE(PG8_SB(1, 1), b3 + hstep, voffB); PG8_STAGE(PG8_SA(1, 0), a3, voffA);
            PG8_WAIT_V(8); PG8_WAIT_L(0); PG8_BAR; PG8_MMA(1, 0, At, B0); PG8_MMA(1, 1, At, B1); PG8_BAR; PG8_SCHED;
            } else {
            PG8_LDB(B0, 0, 0); PG8_SCHED; PG8_LDA(At, 0, 0); PG8_STAGE(PG8_SA(1, 1), a1 + hstep, voffA);
            PG8_WAIT_L(8); PG8_BAR; PG8_WAIT_L(0); PG8_MMA(0, 0, At, B0); PG8_BAR; PG8_SCHED;
            PG8_LDB(B1, 0, 1); PG8_STAGE(PG8_SB(0, 0), b2, voffB);
            PG8_BAR; PG8_WAIT_L(0); PG8_MMA(0, 1, At, B1); PG8_BAR;
            PG8_LDA(At, 0, 1); PG8_STAGE(PG8_SA(0, 0), a2, voffA);
            PG8_BAR; PG8_WAIT_L(0); PG8_MMA(1, 0, At, B0); PG8_BAR; PG8_SCHED;
            PG8_STAGE(PG8_SB(0, 1), b2 + hstep, voffB);
            PG8_WAIT_V(6); PG8_BAR; PG8_MMA(1, 1, At, B1); PG8_BAR;
            PG8_LDB(B0, 1, 0); PG8_SCHED; PG8_LDA(At, 1, 0); PG8_STAGE(PG8_SA(0, 1), a2 + hstep, voffA);
            PG8_WAIT_L(8); PG8_BAR; PG8_WAIT_L(0); PG8_MMA(0, 0, At, B0); PG8_BAR; PG8_SCHED;
            PG8_LDB(B1, 1, 1); PG8_STAGE(PG8_SB(1, 0), b3, voffB);
            PG8_BAR; PG8_WAIT_L(0); PG8_MMA(0, 1, At, B1); PG8_BAR;
            PG8_LDA(At, 1, 1); PG8_STAGE(PG8_SA(1, 0), a3, voffA);
            PG8_BAR; PG8_WAIT_L(0); PG8_MMA(1, 0, At, B0); PG8_BAR; PG8_SCHED;
            PG8_STAGE(PG8_SB(1, 1), b3 + hstep, voffB);
            PG8_WAIT_V(6); PG8_BAR; PG8_MMA(1, 1, At, B1); PG8_BAR;
            }
        }
        if constexpr (ALIGN_EPI) { if (wr == 0) PG8_BAR; }
        if constexpr (!Epi::AFTER_DRAIN) { E(acc, cur, wr, wc, fr, fq); S.done(cur); }
        if (!has_next) break;
#pragma unroll
        for (int a = 0; a < 2; ++a)
#pragma unroll
            for (int b = 0; b < 2; ++b)
#pragma unroll
                for (int m = 0; m < 4; ++m)
#pragma unroll
                    for (int n = 0; n < 2; ++n) acc[a][b][m][n] = (f32x4){0.f, 0.f, 0.f, 0.f};
        cur = nxt; cA = nA; cB = nB; ++ui;
        if constexpr (ALIGN_EPI) { if (wr == 1) PG8_BAR; }
    }
    PG8_WAIT_V(0);
    if constexpr (!ALIGN_EPI) { if (wr == 0) PG8_BAR; }
    PG8_BAR;
    if constexpr (Epi::AFTER_DRAIN) { E.fused(acc, cur, wr, wc, fr, fq, lds, wid, lane); S.done(cur); }
#undef PG8_SA
#undef PG8_SB
#undef PG8_STAGE
#undef PG8_LDA
#undef PG8_LDB
#undef PG8_MMA
#undef PG8_WAIT_V
#undef PG8_WAIT_L
#undef PG8_BAR
#undef PG8_SCHED
}
}

#define EPI_DRAIN() asm volatile("s_waitcnt vmcnt(0)" ::: "memory")
struct Epi1 {
  static constexpr bool PERM = false, AFTER_DRAIN = false; P p;
  __device__ __forceinline__ void operator()(const f32x4 (&acc)[2][2][4][2], const pg8::Unit& u, int wr, int wc, int fr, int fq) const {
    const int pn = u.pn;
    if (pn <= 4) {
      bf16_t* dst; int ld, c0; float* ssq; int sst;
      if (pn < 3) { dst = p.qlat; ld = QL; c0 = pn * 256; ssq = p.ssq_q + pn * 4 + wc; sst = 12; } else { dst = p.kvlat; ld = KVL; c0 = (pn - 3) * 256; ssq = p.ssq_kv + (pn - 3) * 4 + wc; sst = 8; }
#pragma unroll
      for (int ai = 0; ai < 2; ++ai)
#pragma unroll
        for (int m = 0; m < 4; ++m) { const int row = u.pm * 256 + ai * 128 + wr * 64 + m * 16 + fr; float s = 0.f;
#pragma unroll
          for (int bj = 0; bj < 2; ++bj)
#pragma unroll
            for (int n = 0; n < 2; ++n) { const f32x4 a = acc[ai][bj][m][n]; s += a[0] * a[0] + a[1] * a[1] + a[2] * a[2] + a[3] * a[3];
              u32x2 w; w.x = pk_bf16(a[0], a[1]); w.y = pk_bf16(a[2], a[3]); *(u32x2*)(dst + (size_t)row * ld + c0 + bj * 128 + wc * 32 + n * 16 + fq * 4) = w; }
          s += __shfl_xor(s, 16); s += __shfl_xor(s, 32);
          if (fq == 0) ssq[(size_t)row * sst] = s; }
    } else if (pn <= 12) {
#pragma unroll
      for (int n = 0; n < 2; ++n) { const int ch = (pn - 5) * 128 + wc * 32 + n * 16 + fq * 4; const float4 ba = *(const float4*)(p.b_glu + ch), bg = *(const float4*)(p.b_glu + 1024 + ch);
#pragma unroll
        for (int ai = 0; ai < 2; ++ai)
#pragma unroll
          for (int m = 0; m < 4; ++m) { const int row = u.pm * 256 + ai * 128 + wr * 64 + m * 16 + fr; const f32x4 a = acc[ai][0][m][n], g = acc[ai][1][m][n];
            u32x2 w; w.x = pk_bf16((a[0] + ba.x) * sigmoidf_(g[0] + bg.x), (a[1] + ba.y) * sigmoidf_(g[1] + bg.y));
            w.y = pk_bf16((a[2] + ba.z) * sigmoidf_(g[2] + bg.z), (a[3] + ba.w) * sigmoidf_(g[3] + bg.w));
            *(u32x2*)(p.cglu + (size_t)row * CC + ch) = w; } }
    } else if (wc == 0) {
#pragma unroll
      for (int ai = 0; ai < 2; ++ai)
#pragma unroll
        for (int m = 0; m < 4; ++m) { const int row = u.pm * 256 + ai * 128 + wr * 64 + m * 16 + fr; const int pos = row & (S - 1);
#pragma unroll
          for (int n = 0; n < 2; ++n) { const int j = n * 16 + fq * 4; const f32x4 x1 = acc[ai][0][m][n], x2 = acc[ai][1][m][n];
            const float4 cs0 = *(const float4*)(p.ropetab + (pos * 32 + j) * 2), cs1 = *(const float4*)(p.ropetab + (pos * 32 + j) * 2 + 4);
            u32x2 lo, hi;
            lo.x = pk_bf16(x1[0] * cs0.x - x2[0] * cs0.y, x1[1] * cs0.z - x2[1] * cs0.w); lo.y = pk_bf16(x1[2] * cs1.x - x2[2] * cs1.y, x1[3] * cs1.z - x2[3] * cs1.w);
            hi.x = pk_bf16(x2[0] * cs0.x + x1[0] * cs0.y, x2[1] * cs0.z + x1[1] * cs0.w); hi.y = pk_bf16(x2[2] * cs1.x + x1[2] * cs1.y, x2[3] * cs1.z + x1[3] * cs1.w);
            *(u32x2*)(p.krope + (size_t)row * RD + j) = lo; *(u32x2*)(p.krope + (size_t)row * RD + 32 + j) = hi; } }
    }
    EPI_DRAIN();
  }
};
struct Epi2q {
  static constexpr bool PERM = false, AFTER_DRAIN = false; P p;
  __device__ __forceinline__ void operator()(const f32x4 (&acc)[2][2][4][2], const pg8::Unit& u, int wr, int wc, int fr, int fq) const {
    const int pn = u.pn;
#pragma unroll
    for (int ai = 0; ai < 2; ++ai)
#pragma unroll
      for (int m = 0; m < 4; ++m) { const int row = u.pm * 256 + ai * 128 + wr * 64 + m * 16 + fr;
        float sq = 0.f;
#pragma unroll
        for (int i = 0; i < 12; i += 4) { const float4 v = *(const float4*)(p.ssq_q + (size_t)row * 12 + i); sq += v.x + v.y + v.z + v.w; }
        const float rs = rsqrtf(sq * (1.f / QL) + EPS);
        if (pn < 4) {
#pragma unroll
          for (int bj = 0; bj < 2; ++bj)
#pragma unroll
            for (int n = 0; n < 2; ++n) { const f32x4 a = acc[ai][bj][m][n]; u32x2 w; w.x = pk_bf16(a[0] * rs, a[1] * rs); w.y = pk_bf16(a[2] * rs, a[3] * rs);
              *(u32x2*)(p.q + (size_t)row * QW + (2 * pn + bj) * 192 + wc * 32 + n * 16 + fq * 4) = w; }
        } else { const int pos = row & (S - 1); bf16_t* dst = p.q + (size_t)row * QW + ((pn - 4) * 4 + wc) * 192 + 128;
#pragma unroll
          for (int n = 0; n < 2; ++n) { const int j = n * 16 + fq * 4; const f32x4 x1 = acc[ai][0][m][n] * rs, x2 = acc[ai][1][m][n] * rs;
            const float4 cs0 = *(const float4*)(p.ropetab + (pos * 32 + j) * 2), cs1 = *(const float4*)(p.ropetab + (pos * 32 + j) * 2 + 4);
            u32x2 lo, hi;
            lo.x = pk_bf16(x1[0] * cs0.x - x2[0] * cs0.y, x1[1] * cs0.z - x2[1] * cs0.w); lo.y = pk_bf16(x1[2] * cs1.x - x2[2] * cs1.y, x1[3] * cs1.z - x2[3] * cs1.w);
            hi.x = pk_bf16(x2[0] * cs0.x + x1[0] * cs0.y, x2[1] * cs0.z + x1[1] * cs0.w); hi.y = pk_bf16(x2[2] * cs1.x + x1[2] * cs1.y, x2[3] * cs1.z + x1[3] * cs1.w);
            *(u32x2*)(dst + j) = lo; *(u32x2*)(dst + 32 + j) = hi; } }
      }
    EPI_DRAIN();
  }
};
struct Epi2kv {
  static constexpr bool PERM = false, AFTER_DRAIN = false; P p;
  __device__ __forceinline__ void operator()(const f32x4 (&acc)[2][2][4][2], const pg8::Unit& u, int wr, int wc, int fr, int fq) const {
#pragma unroll
    for (int ai = 0; ai < 2; ++ai)
#pragma unroll
      for (int m = 0; m < 4; ++m) { const int row = u.pm * 256 + ai * 128 + wr * 64 + m * 16 + fr;
        const float4 v0 = *(const float4*)(p.ssq_kv + (size_t)row * 8), v1 = *(const float4*)(p.ssq_kv + (size_t)row * 8 + 4);
        const float rs = rsqrtf((v0.x + v0.y + v0.z + v0.w + v1.x + v1.y + v1.z + v1.w) * (1.f / KVL) + EPS);
#pragma unroll
        for (int bj = 0; bj < 2; ++bj)
#pragma unroll
          for (int n = 0; n < 2; ++n) { const f32x4 a = acc[ai][bj][m][n]; u32x2 w; w.x = pk_bf16(a[0] * rs, a[1] * rs); w.y = pk_bf16(a[2] * rs, a[3] * rs);
            *(u32x2*)(p.kv + (size_t)row * KVW + u.pn * 256 + bj * 128 + wc * 32 + n * 16 + fq * 4) = w; } }
    EPI_DRAIN();
  }
};
struct Epi3 {
  static constexpr bool PERM = true, AFTER_DRAIN = false; P p;
  __device__ __forceinline__ void operator()(const f32x4 (&acc)[2][2][4][2], const pg8::Unit& u, int wr, int wc, int fr, int fq) const {
    float4 g2[2][2];
#pragma unroll
    for (int bj = 0; bj < 2; ++bj)
#pragma unroll
      for (int n = 0; n < 2; ++n) g2[bj][n] = *(const float4*)(p.ln2_g + u.pn * 256 + bj * 128 + wc * 32 + fq * 8 + n * 4);
#pragma unroll
    for (int ai = 0; ai < 2; ++ai)
#pragma unroll
      for (int m = 0; m < 4; ++m) { const int row = u.pm * 256 + ai * 128 + wr * 64 + m * 16 + fr; float s = 0.f;
#pragma unroll
        for (int bj = 0; bj < 2; ++bj) { const size_t o_ = (size_t)row * D + u.pn * 256 + bj * 128 + wc * 32 + fq * 8;
          const float4 x0 = *(const float4*)(p.x + o_), x1 = *(const float4*)(p.x + o_ + 4); const f32x4 a0 = acc[ai][bj][m][0], a1 = acc[ai][bj][m][1];
          const float h0 = x0.x + a0[0], h1 = x0.y + a0[1], h2 = x0.z + a0[2], h3 = x0.w + a0[3], h4 = x1.x + a1[0], h5 = x1.y + a1[1], h6 = x1.z + a1[2], h7 = x1.w + a1[3];
          s += (h0 * h0 + h1 * h1) + (h2 * h2 + h3 * h3) + (h4 * h4 + h5 * h5) + (h6 * h6 + h7 * h7);
          *(u32x4*)(p.h16 + o_) = (u32x4){pk_bf16(h0, h1), pk_bf16(h2, h3), pk_bf16(h4, h5), pk_bf16(h6, h7)};
          const float4 ga = g2[bj][0], gb = g2[bj][1];
          *(u32x4*)(p.hn + o_) = (u32x4){pk_bf16(h0 * ga.x, h1 * ga.y), pk_bf16(h2 * ga.z, h3 * ga.w), pk_bf16(h4 * gb.x, h5 * gb.y), pk_bf16(h6 * gb.z, h7 * gb.w)}; }
        s += __shfl_xor(s, 16); s += __shfl_xor(s, 32);
        if (fq == 0) p.ssq_h[(size_t)row * 32 + u.pn * 4 + wc] = s; }
    EPI_DRAIN();
  }
};
__device__ __forceinline__ void phase_gemm1_pg8(const P& p, ldsp lds, int bid, int nb) {
  pg8::Gemm g; g.A = p.xn; g.Bt = p.WinT; g.M = T; g.N = NP1; g.K = D;
  pg8::ColMajorOrder S_; S_.nM = T / 256; S_.nwg = (T / 256) * (NP1 / 256); S_.G = nb; S_.c = bid;
  Epi1 E; E.p = p; pg8::gemm_phase<Epi1, pg8::ColMajorOrder, true, true>(lds, g, S_, E);
}
__device__ __forceinline__ void phase_gemm2_pg8(const P& p, ldsp lds, int bid, int nb) {
  { pg8::Gemm g; g.A = p.qlat; g.Bt = p.WuqT; g.M = T; g.N = QW; g.K = QL;
    pg8::ColMajorOrder S_; S_.nM = T / 256; S_.nwg = (T / 256) * (QW / 256); S_.G = nb; S_.c = bid;
    Epi2q E; E.p = p; pg8::gemm_phase<Epi2q, pg8::ColMajorOrder, true, true>(lds, g, S_, E); }
  { pg8::Gemm g; g.A = p.kvlat; g.Bt = p.WukvT; g.M = T; g.N = KVW; g.K = KVL;
    pg8::ColMajorOrder S_; S_.nM = T / 256; S_.nwg = (T / 256) * (KVW / 256); S_.G = nb; S_.c = (bid + 192) % nb;
    Epi2kv E; E.p = p; pg8::gemm_phase<Epi2kv, pg8::ColMajorOrder, true, true>(lds, g, S_, E); }
}
__device__ __forceinline__ void phase_gemm3_pg8(const P& p, ldsp lds, int bid, int nb) {
  pg8::Gemm g; g.A = p.mix; g.Bt = p.WoT; g.M = T; g.N = D; g.K = D;
  pg8::ColMajorOrder S_; S_.nM = T / 256; S_.nwg = (T / 256) * (D / 256); S_.G = nb; S_.c = bid;
  Epi3 E; E.p = p; pg8::gemm_phase<Epi3, pg8::ColMajorOrder, true, true>(lds, g, S_, E);
}
#define XB_TMO      128
#define XB_XCNT(j)  (256  + 64 * (j))
#define XB_XSUB(j)  (1280 + 64 * (j))
#define XB_XGEN(j)  (2304 + 64 * (j))
#define XB_TOP      3328
#define XB_TOPGEN   3392
#define XCD_BAR_WORDS 3456
#define XB_SPIN_CAP (1u << 20)
__device__ __forceinline__ unsigned xb_ld(unsigned* p)              { return __hip_atomic_load(p, __ATOMIC_RELAXED, __HIP_MEMORY_SCOPE_AGENT); }
__device__ __forceinline__ unsigned xb_add(unsigned* p, unsigned v) { return __hip_atomic_fetch_add(p, v, __ATOMIC_RELAXED, __HIP_MEMORY_SCOPE_AGENT); }
__device__ __forceinline__ unsigned xb_xcc_id() { return (unsigned)__builtin_amdgcn_s_getreg((3 << 11) | 20) & 0xFu; }
#define XB_SPIN(cond, bar) do { unsigned _sp = 0; while (cond) { __builtin_amdgcn_s_sleep(1); \
    if ((++_sp & 255u) == 0u) { if (xb_ld(&(bar)[XB_TMO])) break; if (_sp > XB_SPIN_CAP) { atomicAdd(&(bar)[XB_TMO], 1u); break; } } } } while (0)
struct XcdBarrier { unsigned* bar; unsigned x; volatile LAS unsigned* st; };
__device__ __forceinline__ XcdBarrier xcd_barrier_post(unsigned* bar, volatile LAS unsigned* st) {
  XcdBarrier b; b.bar = bar; b.x = xb_xcc_id(); b.st = st;
  if (threadIdx.x == 0) (void)xb_add(&bar[XB_XCNT(b.x)], 1u);
  return b;
}
__device__ __forceinline__ void xcd_barrier_complete(unsigned* bar, unsigned x, unsigned& nloc, unsigned& nx) {
  const unsigned G = gridDim.x * gridDim.y * gridDim.z;
  unsigned sum, cnt, mine, sp = 0u;
  for (;;) {
    sum = 0u; cnt = 0u; mine = 0u;
#pragma unroll
    for (unsigned j = 0; j < 16; ++j) { const unsigned c = xb_ld(&bar[XB_XCNT(j)]); sum += c; cnt += (c > 0u) ? 1u : 0u; mine = (j == x) ? c : mine; }
    if (sum == G) break;
    __builtin_amdgcn_s_sleep(1);
    if ((++sp & 255u) == 0u) { if (xb_ld(&bar[XB_TMO])) break; if (sp > XB_SPIN_CAP) { atomicAdd(&bar[XB_TMO], 1u); break; } }
  }
  nloc = mine > 0u ? mine : 1u; nx = cnt > 0u ? cnt : 1u;
}
__device__ __forceinline__ void xcd_barrier(const XcdBarrier& b) {
  asm volatile("s_waitcnt vmcnt(0)" ::: "memory");
  __syncthreads();
  if (threadIdx.x == 0) {
    unsigned* bar = b.bar;
    __builtin_amdgcn_s_waitcnt(0);
    unsigned nloc = b.st[0], nx = b.st[1];
    if (nloc == 0u) { xcd_barrier_complete(bar, b.x, nloc, nx); b.st[0] = nloc; b.st[1] = nx; }
    const unsigned old = xb_add(&bar[XB_XSUB(b.x)], 1u);
    const unsigned gen = old / nloc;
    if (old + 1u == (gen + 1u) * nloc) {
      __builtin_amdgcn_fence(__ATOMIC_RELEASE, "agent");
      asm volatile("s_waitcnt vmcnt(0)" ::: "memory");
      const unsigned og = xb_add(&bar[XB_TOP], 1u);
      const unsigned tg = og / nx;
      if (og + 1u == (tg + 1u) * nx) xb_add(&bar[XB_TOPGEN], 1u);
      else XB_SPIN(xb_ld(&bar[XB_TOPGEN]) == tg, bar);
      __builtin_amdgcn_fence(__ATOMIC_ACQUIRE, "agent");
      xb_add(&bar[XB_XGEN(b.x)], 1u);
      asm volatile("s_waitcnt vmcnt(0)" ::: "memory");
    } else {
      XB_SPIN(xb_ld(&bar[XB_XGEN(b.x)]) == gen, bar);
      __builtin_amdgcn_fence(__ATOMIC_ACQUIRE, "agent");
      asm volatile("s_waitcnt vmcnt(0)" ::: "memory");
    }
  }
  __syncthreads();
}

__global__ __launch_bounds__(NTHR, 2) void mega_fwd(P p) {
  extern __shared__ __attribute__((aligned(16))) unsigned char smem[];
  ldsp lds = (ldsp)smem;
  volatile LAS unsigned* st = (volatile LAS unsigned*)(lds + LDS_BYTES - 16);
  if (threadIdx.x == 0) { st[0] = 0u; st[1] = 0u; st[2] = 0u; st[3] = 0u; }
  __syncthreads();
  const XcdBarrier bar = xcd_barrier_post(p.bar, st);
  const int bid = blockIdx.x, nb = gridDim.x;
  phase_prep(p, lds, bid, nb); rmsnorm_rows_dev(p.x, p.ln1_g, p.xn, bid, nb);
  xcd_barrier(bar);
  phase_gemm1_pg8(p, lds, bid, nb);
  xcd_barrier(bar);
  phase_gemm2_pg8(p, lds, bid, nb); phase_conv(p, lds, bid, nb);
  xcd_barrier(bar);
  phase_attn(p, lds, bid, nb);
  xcd_barrier(bar);
  phase_gemm3_pg8(p, lds, bid, nb);
  xcd_barrier(bar);
  phase_route2(p, lds, bid, nb);
  xcd_barrier(bar);
  moe_stream<0>(p, lds, bid, nb);
  moe_stream<1>(p, lds, bid, nb);
  xcd_barrier(bar);
  phase_final(p, bid, nb);
}

static size_t carve(size_t& off, size_t bytes) { const size_t o = off; off += (bytes + 255) & ~(size_t)255; return o; }

extern "C" void kernel_launch(void* const* d_in, const int* in_sizes, int n_in, void* d_out, int out_size, void* d_ws, size_t ws_size, hipStream_t stream) {
  P p{};
  const float** pin = (const float**)&p.x;
  for (int i = 0; i < 22; ++i) pin[i] = (const float*)d_in[i];
  p.out = (float*)d_out;
  char* ws = (char*)d_ws; size_t off = 0;
  p.cnt = (int*)(ws + carve(off, NE * 32 * 4));
  p.bar = (unsigned*)(ws + carve(off, XCD_BAR_WORDS * 4));
  p.moe_done = (unsigned*)(ws + carve(off, 1024));
  p.ssq_h = (float*)(ws + carve(off, (size_t)T * 32 * 4));
  p.rstd_h = (float*)(ws + carve(off, (size_t)T * 4));
  p.h16 = (bf16_t*)(ws + carve(off, (size_t)T * D * 2));
  p.xn = (bf16_t*)(ws + carve(off, (size_t)T * D * 2));
  p.qlat = (bf16_t*)(ws + carve(off, (size_t)T * QL * 2));
  p.kvlat = (bf16_t*)(ws + carve(off, (size_t)T * KVL * 2));
  p.krope = (bf16_t*)(ws + carve(off, (size_t)T * RD * 2));
  p.cglu = (bf16_t*)(ws + carve(off, (size_t)T * CC * 2));
  p.q = (bf16_t*)(ws + carve(off, (size_t)T * QW * 2));
  p.kv = (bf16_t*)(ws + carve(off, (size_t)T * KVW * 2));
  p.mix = (bf16_t*)(ws + carve(off, (size_t)T * D * 2));
  p.hn = (bf16_t*)(ws + carve(off, (size_t)T * D * 2));
  p.hb = (bf16_t*)(ws + carve(off, (size_t)MAXTILES * 256 * DE * 2));
  p.y = (bf16_t*)(ws + carve(off, (size_t)2 * T * D * 2));
  p.ssq_q = (float*)(ws + carve(off, (size_t)T * 12 * 4));
  p.ssq_kv = (float*)(ws + carve(off, (size_t)T * 8 * 4));
  p.h = (float*)(ws + carve(off, (size_t)T * D * 4));
  p.rlog = (float*)(ws + carve(off, (size_t)RSLABS * T * RLD * 4));
  p.convtmp = (float*)(ws + carve(off, (size_t)T * CC * 4));
  p.ropetab = (float*)(ws + carve(off, (size_t)S * 32 * 2 * 4));
  p.list_gate = (float*)(ws + carve(off, (size_t)NE * LCAP * 4));
  p.list_tok = (int*)(ws + carve(off, (size_t)NE * LCAP * 4));
  p.WinT = (bf16_t*)(ws + carve(off, (size_t)NP1 * D * 2));
  p.WuqT = (bf16_t*)(ws + carve(off, (size_t)QW * QL * 2));
  p.WukvT = (bf16_t*)(ws + carve(off, (size_t)KVW * KVL * 2));
  p.WoT = (bf16_t*)(ws + carve(off, (size_t)D * D * 2));
  p.WrT = (bf16_t*)(ws + carve(off, (size_t)256 * D * 2));
  if (off > ws_size) { fprintf(stderr, "kernel_launch: workspace too small (%zu > %zu)\n", off, ws_size); return; }

  static int grid = 0;
  if (grid == 0) {
    int dev = 0, cus = 0, per_cu = 0;
    (void)hipGetDevice(&dev); (void)hipDeviceGetAttribute(&cus, hipDeviceAttributeMultiprocessorCount, dev);
    (void)hipFuncSetAttribute((const void*)mega_fwd, hipFuncAttributeMaxDynamicSharedMemorySize, LDS_BYTES);
    if (hipOccupancyMaxActiveBlocksPerMultiprocessor(&per_cu, (const void*)mega_fwd, NTHR, LDS_BYTES) != hipSuccess || per_cu < 1) { fprintf(stderr, "kernel_launch: occupancy query failed (%d)\n", per_cu); per_cu = 1; }
    (void)hipGetLastError();
    grid = cus * per_cu;
    fprintf(stderr, "kernel_launch: %d CUs x %d = grid %d\n", cus, per_cu, grid);
  }
  (void)hipMemsetAsync(p.bar, 0, XCD_BAR_WORDS * 4, stream);
  mega_fwd<<<grid, NTHR, LDS_BYTES, stream>>>(p);
}
```
